# Optimizing an MI355X kernel written in HIP

```python
import math
import jax
import jax.numpy as jnp
from jax import lax
import numpy as np

D_MODEL = 1024
BATCH = 16
SEQ = 2048
DEPTH = 4

GRID_W = 64
CTX_LEN = 256
N_MOD = 6

HEAD_DIM = 64
BRANCH_WIDTH = 512
N_BRANCH = 4

WA_HEADS = 8
WA_KV_HEADS = 2
WINDOW = 128
GA_HEADS = 8
GA_KV_HEADS = 2
Q_BLOCK = 128
ROPE_THETA = 10000.0

SSD_HEADS = 8
SSD_HEAD_DIM = 64
SSD_GROUPS = 2
SSD_STATE = 128
SSD_CONV = 3
SSD_CHUNK = 128
SSD_WIDTH = SSD_HEADS * SSD_HEAD_DIM
SSD_CONV_CH = SSD_WIDTH + 2 * SSD_GROUPS * SSD_STATE

S5_GROUP = 16
S5_WIDTH = 512
S5_GROUPS = S5_WIDTH // S5_GROUP
S5_STATE = 64

N_EXPERTS = 32
N_EXPERT_GROUPS = 8
TOP_K = 2
D_EXPERT = 512
MOE_BLOCK = 128

ALPHA = (2 * DEPTH) ** 0.25
BETA = (8 * DEPTH) ** -0.25
NORM_EPS = 1e-6
F32 = jnp.float32

IN_SIZES = (
    WA_HEADS * HEAD_DIM, WA_KV_HEADS * HEAD_DIM, WA_KV_HEADS * HEAD_DIM,
    GA_HEADS * HEAD_DIM, GA_KV_HEADS * HEAD_DIM, GA_KV_HEADS * HEAD_DIM,
    SSD_WIDTH, SSD_WIDTH, SSD_GROUPS * SSD_STATE, SSD_GROUPS * SSD_STATE,
    2 * SSD_HEADS,
    S5_WIDTH,
    N_BRANCH * D_MODEL,
)
D_IN = sum(IN_SIZES)

kernel_name = 'hybrid_prefix_dit_trunk'


def layer_norm(x):
    xf = x.astype(F32)
    mu = jnp.mean(xf, axis=-1, keepdims=True)
    var = jnp.mean(jnp.square(xf - mu), axis=-1, keepdims=True)
    return ((xf - mu) * lax.rsqrt(var + NORM_EPS)).astype(x.dtype)


def post_norm(v, g, b):
    return layer_norm(v) * g + b


def rms_norm(x, w):
    xf = x.astype(F32)
    y = xf * lax.rsqrt(jnp.mean(jnp.square(xf), axis=-1, keepdims=True) + NORM_EPS)
    return y.astype(x.dtype) * w


def split_heads(t, n_heads):
    return t.reshape(t.shape[:2] + (n_heads, HEAD_DIM))


def axial_rope_tables(n_tokens):
    rows = n_tokens // GRID_W
    row = jnp.repeat(jnp.arange(rows, dtype=F32), GRID_W)
    col = jnp.tile(jnp.arange(GRID_W, dtype=F32), rows)
    axis_dim = HEAD_DIM // 2
    inv_freq = ROPE_THETA ** (-jnp.arange(0, axis_dim, 2, dtype=F32) / axis_dim)
    ang_r = row[:, None] * inv_freq
    ang_c = col[:, None] * inv_freq
    ang = jnp.concatenate([ang_r, ang_r, ang_c, ang_c], axis=-1)
    return jnp.cos(ang), jnp.sin(ang)


def apply_axial_rope(t, cos, sin):
    axis_dim = HEAD_DIM // 2
    pair = axis_dim // 2
    tf = t.astype(F32)
    parts = []
    for a in range(2):
        seg = tf[..., a * axis_dim:(a + 1) * axis_dim]
        parts += [-seg[..., pair:], seg[..., :pair]]
    rotated = jnp.concatenate(parts, axis=-1)
    return (tf * cos[None, :, None, :] + rotated * sin[None, :, None, :]).astype(t.dtype)


def window_attention(q, k, v, k_ctx, v_ctx, sink):
    bsz, seq, n_heads, dh = q.shape
    n_kv = k.shape[2]
    grp = n_heads // n_kv
    span = Q_BLOCK + 2 * WINDOW
    pad = ((0, 0), (WINDOW, WINDOW), (0, 0), (0, 0))
    k_pad = jnp.pad(k, pad)
    v_pad = jnp.pad(v, pad)
    qg = q.reshape(bsz, seq, n_kv, grp, dh)
    sink_logit = jnp.broadcast_to(sink.astype(F32).reshape(1, n_kv, grp, 1, 1), (bsz, n_kv, grp, Q_BLOCK, 1))
    scale = dh ** -0.5
    offs_q = jnp.arange(Q_BLOCK)
    offs_k = jnp.arange(span) - WINDOW

    def block(i):
        start = i * Q_BLOCK
        qb = lax.dynamic_slice_in_dim(qg, start, Q_BLOCK, axis=1)
        kb = lax.dynamic_slice_in_dim(k_pad, start, span, axis=1)
        vb = lax.dynamic_slice_in_dim(v_pad, start, span, axis=1)
        q_pos = start + offs_q
        k_pos = start + offs_k
        valid = ((jnp.abs(q_pos[:, None] - k_pos[None, :]) <= WINDOW)
                 & (k_pos >= 0)[None, :] & (k_pos < seq)[None, :])
        s_loc = jnp.einsum('bqkgd,bskd->bkgqs', qb, kb).astype(F32) * scale
        s_loc = jnp.where(valid, s_loc, -jnp.inf)
        s_ctx = jnp.einsum('bqkgd,bckd->bkgqc', qb, k_ctx).astype(F32) * scale
        p = jax.nn.softmax(jnp.concatenate([s_loc, s_ctx, sink_logit], axis=-1), axis=-1).astype(v.dtype)
        return (jnp.einsum('bkgqs,bskd->bqkgd', p[..., :span], vb)
                + jnp.einsum('bkgqc,bckd->bqkgd', p[..., span:-1], v_ctx))

    out = lax.map(block, jnp.arange(seq // Q_BLOCK))
    return jnp.moveaxis(out, 0, 1).reshape(bsz, seq, n_heads * dh)


def dense_attention(q, k, v, k_ctx, v_ctx):
    bsz, seq, n_heads, dh = q.shape
    n_kv = k.shape[2]
    grp = n_heads // n_kv
    keys = jnp.concatenate([k, k_ctx], axis=1)
    vals = jnp.concatenate([v, v_ctx], axis=1)
    qg = q.reshape(bsz, seq, n_kv, grp, dh)
    scale = dh ** -0.5

    def block(i):
        qb = lax.dynamic_slice_in_dim(qg, i * Q_BLOCK, Q_BLOCK, axis=1)
        s = jnp.einsum('bqkgd,bskd->bkgqs', qb, keys).astype(F32) * scale
        p = jax.nn.softmax(s, axis=-1).astype(vals.dtype)
        return jnp.einsum('bkgqs,bskd->bqkgd', p, vals)

    out = lax.map(block, jnp.arange(seq // Q_BLOCK))
    return jnp.moveaxis(out, 0, 1).reshape(bsz, seq, n_heads * dh)


def context_attention(q, k, v, sink=None):
    bsz, n, n_heads, dh = q.shape
    n_kv = k.shape[2]
    grp = n_heads // n_kv
    qg = q.reshape(bsz, n, n_kv, grp, dh)
    s = jnp.einsum('bqkgd,bskd->bkgqs', qg, k).astype(F32) * dh ** -0.5
    if sink is not None:
        sink_logit = jnp.broadcast_to(sink.astype(F32).reshape(1, n_kv, grp, 1, 1), (bsz, n_kv, grp, n, 1))
        s = jnp.concatenate([s, sink_logit], axis=-1)
    p = jax.nn.softmax(s, axis=-1).astype(v.dtype)
    if sink is not None:
        p = p[..., :-1]
    return jnp.einsum('bkgqs,bskd->bqkgd', p, v).reshape(bsz, n, n_heads * dh)


def depthwise_conv(x, w, b):
    k = w.shape[0]
    y = lax.conv_general_dilated(x, w[:, None, :], window_strides=(1,), padding=[(k // 2, k // 2)],
                                 dimension_numbers=('NWC', 'WIO', 'NWC'), feature_group_count=x.shape[-1])
    return y + b


def segsum_exp(cs):
    t = cs.shape[-1]
    diff = cs[..., :, None] - cs[..., None, :]
    return jnp.exp(jnp.where(jnp.tril(jnp.ones((t, t), dtype=bool)), diff, -jnp.inf))


def ssd_scan(x, dt, a, bm, cm, init_state):
    bsz, seq, n_heads, p = x.shape
    g, n = bm.shape[2], bm.shape[3]
    j = n_heads // g
    nc = seq // SSD_CHUNK
    t = SSD_CHUNK
    xd = (x.astype(F32) * dt[..., None]).reshape(bsz, nc, t, g, j, p)
    da = (dt * a).reshape(bsz, nc, t, g, j).transpose(0, 3, 4, 1, 2)
    bc = bm.astype(F32).reshape(bsz, nc, t, g, n)
    cc = cm.astype(F32).reshape(bsz, nc, t, g, n)
    a_cs = jnp.cumsum(da, axis=-1)
    cb = jnp.einsum('bclgn,bcsgn->bgcls', cc, bc)
    y_diag = jnp.einsum('bgjcls,bcsgjp->bclgjp', cb[:, :, None] * segsum_exp(a_cs), xd)
    decay_to_end = jnp.exp(a_cs[..., -1:] - a_cs)
    states = jnp.einsum('bcsgn,bgjcs,bcsgjp->bcgjpn', bc, decay_to_end, xd)
    states = jnp.concatenate([init_state.astype(F32).reshape(bsz, 1, g, j, p, n), states], axis=1)
    chunk_cs = jnp.cumsum(jnp.pad(a_cs[..., -1], ((0, 0), (0, 0), (0, 0), (1, 0))), axis=-1)
    states = jnp.einsum('bgjzc,bcgjpn->bzgjpn', segsum_exp(chunk_cs), states)
    y_off = jnp.einsum('bclgn,bcgjpn,bgjcl->bclgjp', cc, states[:, :-1], jnp.exp(a_cs))
    y = (y_diag + y_off).reshape(bsz, seq, n_heads, p)
    return y, states[:, -1].reshape(bsz, n_heads, p, n)


def maybe_flip(t, rev):
    return jnp.flip(t, axis=1) if rev else t


def ssd_prepare(x, bm, cm, dt, conv_w, conv_b, dt_bias):
    xbc = jax.nn.silu(depthwise_conv(jnp.concatenate([x, bm, cm], axis=-1), conv_w, conv_b))
    x, bm, cm = jnp.split(xbc, [SSD_WIDTH, SSD_WIDTH + SSD_GROUPS * SSD_STATE], axis=-1)
    lead = x.shape[:2]
    return (x.reshape(lead + (SSD_HEADS, SSD_HEAD_DIM)),
            bm.reshape(lead + (SSD_GROUPS, SSD_STATE)),
            cm.reshape(lead + (SSD_GROUPS, SSD_STATE)),
            jax.nn.softplus(dt.astype(F32) + dt_bias.astype(F32)))


def ssd_gate_out(y, z, norm_w):
    g = y.reshape(z.shape[:2] + (SSD_WIDTH,)) * jax.nn.silu(z.astype(F32))
    return rms_norm(g, norm_w).astype(z.dtype)


def ssd_mixer(p_c, p_l, conv_w, conv_b, dt_bias, a_log, d_skip, norm_w, need_ctx):
    xc, bc, cc, dtc = ssd_prepare(p_c[0], p_c[2], p_c[3], p_c[4], conv_w, conv_b, dt_bias)
    xl, bl, cl, dtl = ssd_prepare(p_l[0], p_l[2], p_l[3], p_l[4], conv_w, conv_b, dt_bias)
    a = -jnp.exp(a_log.astype(F32))
    d = d_skip.astype(F32)[:, None]
    y_l = d * xl.astype(F32)
    y_c = d * xc.astype(F32) if need_ctx else None
    init = jnp.zeros((xc.shape[0], SSD_HEADS, SSD_HEAD_DIM, SSD_STATE), F32)
    for direction in range(2):
        rev = direction == 1
        hs = slice(direction * SSD_HEADS, (direction + 1) * SSD_HEADS)
        yc_d, s_ctx = ssd_scan(maybe_flip(xc, rev), maybe_flip(dtc[..., hs], rev), a[direction],
                               maybe_flip(bc, rev), maybe_flip(cc, rev), init)
        yl_d, _ = ssd_scan(maybe_flip(xl, rev), maybe_flip(dtl[..., hs], rev), a[direction],
                           maybe_flip(bl, rev), maybe_flip(cl, rev), s_ctx)
        y_l = y_l + maybe_flip(yl_d, rev)
        if need_ctx:
            y_c = y_c + maybe_flip(yc_d, rev)
    out_l = ssd_gate_out(y_l, p_l[1], norm_w)
    out_c = ssd_gate_out(y_c, p_c[1], norm_w) if need_ctx else None
    return out_c, out_l


def linear_recurrence_combine(left, right):
    a_l, b_l = left
    a_r, b_r = right
    return a_r * a_l, a_r * b_l + b_r


def s5_discretise(a_re, a_im, log_dt, b_cplx):
    a = lax.complex(jnp.minimum(a_re.astype(F32), -1e-4), a_im.astype(F32))
    dt = jnp.exp(log_dt.astype(F32))[:, None]
    a_bar = jnp.exp(a * dt)
    b_bar = ((a_bar - 1.0) / a)[..., None] * b_cplx
    return a_bar, b_bar


def s5_scan(bu, a_bar, init, reverse):
    n = bu.shape[1]
    a = jnp.broadcast_to(a_bar, (1, n) + a_bar.shape)
    a_cum, s = lax.associative_scan(linear_recurrence_combine, (a, bu), reverse=reverse, axis=1)
    if init is not None:
        s = s + a_cum * init[:, None]
    return s, (s[:, 0] if reverse else s[:, -1])


def s5_glu(y, w_glu, dtype):
    y = jax.nn.gelu(y.reshape(y.shape[:2] + (S5_WIDTH,))).astype(dtype)
    a, b = jnp.split(y @ w_glu, 2, axis=-1)
    return a * jax.nn.sigmoid(b)


def s5_mixer(u_c, u_l, a_re, a_im, log_dt, b_re, b_im, c_re, c_im, d_skip, w_glu, need_ctx):
    b_cplx = lax.complex(b_re.astype(F32), b_im.astype(F32))
    c_cplx = lax.complex(c_re.astype(F32), c_im.astype(F32))
    d_grp = d_skip.astype(F32).reshape(S5_GROUPS, S5_GROUP)
    uc = u_c.astype(F32).reshape(u_c.shape[:2] + (S5_GROUPS, S5_GROUP))
    ul = u_l.astype(F32).reshape(u_l.shape[:2] + (S5_GROUPS, S5_GROUP))
    y_l = d_grp * ul
    y_c = d_grp * uc if need_ctx else None
    for direction in range(2):
        rev = direction == 1
        a_bar, b_bar = s5_discretise(a_re[direction], a_im[direction], log_dt[direction], b_cplx)
        s_c, fin_c = s5_scan(jnp.einsum('blgs,gns->blgn', uc.astype(jnp.complex64), b_bar), a_bar, None, rev)
        s_l, _ = s5_scan(jnp.einsum('blgs,gns->blgn', ul.astype(jnp.complex64), b_bar), a_bar, fin_c, rev)
        y_l = y_l + jnp.real(jnp.einsum('blgn,gsn->blgs', s_l, c_cplx))
        if need_ctx:
            y_c = y_c + jnp.real(jnp.einsum('blgn,gsn->blgs', s_c, c_cplx))
    out_l = s5_glu(y_l, w_glu, u_l.dtype)
    out_c = s5_glu(y_c, w_glu, u_c.dtype) if need_ctx else None
    return out_c, out_l


def merge(branches, gate_logits, w_branch, w_out):
    ys = jnp.stack(branches, axis=2)
    g = jax.nn.sigmoid(gate_logits.reshape(gate_logits.shape[:2] + (N_BRANCH, D_MODEL)))
    m = jnp.einsum('blnw,nwd->blnd', ys, w_branch)
    return jnp.sum(g * m, axis=2) @ w_out


def token_mixer(h_c, h_l, cos, sin, w_in, wa_sink, ga_q_norm, ga_k_norm,
                ssd_conv_w, ssd_conv_b, ssd_dt_bias, ssd_a_log, ssd_d, ssd_norm_w,
                s5_a_re, s5_a_im, s5_log_dt, s5_b_re, s5_b_im, s5_c_re, s5_c_im, s5_d, s5_w_glu,
                w_branch, w_out, need_ctx):
    cuts = [int(v) for v in np.cumsum(IN_SIZES)[:-1]]
    (aq_c, ak_c, av_c, gq_c, gk_c, gv_c, sx_c, sz_c, sb_c, sc_c, sdt_c, su_c, gate_c) = jnp.split(h_c @ w_in, cuts, axis=-1)
    (aq_l, ak_l, av_l, gq_l, gk_l, gv_l, sx_l, sz_l, sb_l, sc_l, sdt_l, su_l, gate_l) = jnp.split(h_l @ w_in, cuts, axis=-1)

    ka_c = split_heads(ak_c, WA_KV_HEADS)
    va_c = split_heads(av_c, WA_KV_HEADS)
    ya_l = window_attention(apply_axial_rope(split_heads(aq_l, WA_HEADS), cos, sin),
                            apply_axial_rope(split_heads(ak_l, WA_KV_HEADS), cos, sin),
                            split_heads(av_l, WA_KV_HEADS), ka_c, va_c, wa_sink)
    kg_c = rms_norm(split_heads(gk_c, GA_KV_HEADS), ga_k_norm)
    vg_c = split_heads(gv_c, GA_KV_HEADS)
    yg_l = dense_attention(apply_axial_rope(rms_norm(split_heads(gq_l, GA_HEADS), ga_q_norm), cos, sin),
                           apply_axial_rope(rms_norm(split_heads(gk_l, GA_KV_HEADS), ga_k_norm), cos, sin),
                           split_heads(gv_l, GA_KV_HEADS), kg_c, vg_c)
    ys_c, ys_l = ssd_mixer((sx_c, sz_c, sb_c, sc_c, sdt_c), (sx_l, sz_l, sb_l, sc_l, sdt_l),
                           ssd_conv_w, ssd_conv_b, ssd_dt_bias, ssd_a_log, ssd_d, ssd_norm_w, need_ctx)
    y5_c, y5_l = s5_mixer(su_c, su_l, s5_a_re, s5_a_im, s5_log_dt, s5_b_re, s5_b_im,
                          s5_c_re, s5_c_im, s5_d, s5_w_glu, need_ctx)
    out_l = merge((ya_l, ys_l, yg_l, y5_l), gate_l, w_branch, w_out)
    if not need_ctx:
        return None, out_l
    ya_c = context_attention(split_heads(aq_c, WA_HEADS), ka_c, va_c, wa_sink)
    yg_c = context_attention(rms_norm(split_heads(gq_c, GA_HEADS), ga_q_norm), kg_c, vg_c)
    out_c = merge((ya_c, ys_c, yg_c, y5_c), gate_c, w_branch, w_out)
    return out_c, out_l


def expert_dispatch(h, expert_idx, gate_w, w_gate, w_up, w_down):
    n_tok, d = h.shape
    n_assign = n_tok * TOP_K
    n_blocks = -(-(n_assign + N_EXPERTS * (MOE_BLOCK - 1)) // MOE_BLOCK)
    cap = n_blocks * MOE_BLOCK
    flat_e = expert_idx.reshape(-1)
    flat_t = jnp.repeat(jnp.arange(n_tok, dtype=jnp.int32), TOP_K)
    flat_w = gate_w.reshape(-1)
    order = jnp.argsort(flat_e)
    e_s, t_s, w_s = flat_e[order], flat_t[order], flat_w[order]
    counts = jnp.bincount(flat_e, length=N_EXPERTS)
    padded = (counts + MOE_BLOCK - 1) // MOE_BLOCK * MOE_BLOCK
    first = jnp.cumsum(counts) - counts
    pad_end = jnp.cumsum(padded)
    dest = (pad_end - padded)[e_s] + jnp.arange(n_assign) - first[e_s]
    slot_tok = jnp.zeros((cap,), jnp.int32).at[dest].set(t_s)
    slot_w = jnp.zeros((cap,), h.dtype).at[dest].set(w_s.astype(h.dtype))
    block_expert = jnp.minimum(jnp.searchsorted(pad_end, jnp.arange(n_blocks) * MOE_BLOCK, side='right'),
                               N_EXPERTS - 1)
    x_blocks = h[slot_tok].reshape(n_blocks, MOE_BLOCK, d)

    def expert_block(args):
        xb, e = args
        return (jax.nn.silu(xb @ w_gate[e]) * (xb @ w_up[e])) @ w_down[e]

    y = lax.map(expert_block, (x_blocks, block_expert)).reshape(cap, d)
    return jnp.zeros_like(h).at[slot_tok].add(y * slot_w[:, None])


def moe(h, router_w, router_bias, w_gate, w_up, w_down):
    n_tok = h.shape[0]
    per_group = N_EXPERTS // N_EXPERT_GROUPS
    scores = jax.nn.sigmoid((h @ router_w).astype(F32))
    sel = (scores + router_bias.astype(F32)).reshape(n_tok, N_EXPERT_GROUPS, per_group)
    group_score = jnp.sum(lax.top_k(sel, 2)[0], axis=-1)
    grp = jnp.argmax(group_score, axis=-1).astype(jnp.int32)
    in_grp = jnp.take_along_axis(sel, grp[:, None, None], axis=1)[:, 0]
    local = lax.top_k(in_grp, TOP_K)[1]
    expert_idx = grp[:, None] * per_group + local
    w = jnp.take_along_axis(scores, expert_idx, axis=1)
    w = w / jnp.sum(w, axis=-1, keepdims=True)
    return expert_dispatch(h, expert_idx, w, w_gate, w_up, w_down)


def setup_inputs(seed: int = 0) -> dict:
    key = jax.random.key(seed)
    keys = jax.random.split(key, 40)
    counter = iter(range(40))

    def nrm(shape, scale):
        return jax.random.normal(keys[next(counter)], shape, F32) * scale

    def unif(shape, lo, hi):
        return jax.random.uniform(keys[next(counter)], shape, F32, lo, hi)

    L, D = DEPTH, D_MODEL
    inputs = {}
    inputs['x'] = nrm((BATCH, SEQ, D), 1.0)
    inputs['c'] = nrm((BATCH, D), 1.0)
    inputs['ctx'] = nrm((BATCH, CTX_LEN, D), 1.0)
    inputs['c_ctx'] = nrm((D,), 1.0)
    inputs['mod_w'] = nrm((L, D, N_MOD * D), 0.5 * D ** -0.5)
    inputs['mod_b'] = nrm((L, N_MOD * D), 0.02)
    inputs['w_in'] = nrm((L, D, D_IN), D ** -0.5)
    inputs['wa_sink'] = nrm((L, WA_HEADS), 0.5)
    inputs['ga_q_norm'] = 1.0 + nrm((L, HEAD_DIM), 0.02)
    inputs['ga_k_norm'] = 1.0 + nrm((L, HEAD_DIM), 0.02)
    inputs['ssd_conv_w'] = nrm((L, SSD_CONV, SSD_CONV_CH), SSD_CONV ** -0.5)
    inputs['ssd_conv_b'] = nrm((L, SSD_CONV_CH), 0.02)
    dt0 = jnp.exp(unif((L, 2 * SSD_HEADS), math.log(1e-3), math.log(1e-1)))
    inputs['ssd_dt_bias'] = dt0 + jnp.log(-jnp.expm1(-dt0))
    inputs['ssd_a_log'] = jnp.log(unif((L, 2, SSD_HEADS), 1.0, 16.0))
    inputs['ssd_d'] = 1.0 + nrm((L, SSD_HEADS), 0.1)
    inputs['ssd_norm_w'] = 1.0 + nrm((L, SSD_WIDTH), 0.02)
    inputs['s5_a_re'] = -0.5 + nrm((L, 2, S5_GROUPS, S5_STATE), 0.01)
    inputs['s5_a_im'] = jnp.pi * jnp.arange(S5_STATE, dtype=F32) + nrm((L, 2, S5_GROUPS, S5_STATE), 0.01)
    inputs['s5_log_dt'] = unif((L, 2, S5_GROUPS), math.log(1e-3), math.log(1e-1))
    inputs['s5_b_re'] = nrm((L, S5_GROUPS, S5_STATE, S5_GROUP), (2 * S5_GROUP) ** -0.5)
    inputs['s5_b_im'] = nrm((L, S5_GROUPS, S5_STATE, S5_GROUP), (2 * S5_GROUP) ** -0.5)
    inputs['s5_c_re'] = nrm((L, S5_GROUPS, S5_GROUP, S5_STATE), S5_STATE ** -0.5)
    inputs['s5_c_im'] = nrm((L, S5_GROUPS, S5_GROUP, S5_STATE), S5_STATE ** -0.5)
    inputs['s5_d'] = nrm((L, S5_WIDTH), 1.0)
    inputs['s5_w_glu'] = nrm((L, S5_WIDTH, 2 * S5_WIDTH), S5_WIDTH ** -0.5)
    inputs['w_branch'] = nrm((L, N_BRANCH, BRANCH_WIDTH, D), BETA * BRANCH_WIDTH ** -0.5)
    inputs['w_out'] = nrm((L, D, D), BETA * D ** -0.5)
    inputs['ln1_g'] = 1.0 + nrm((L, D), 0.02)
    inputs['ln1_b'] = nrm((L, D), 0.02)
    inputs['ln2_g'] = 1.0 + nrm((L, D), 0.02)
    inputs['ln2_b'] = nrm((L, D), 0.02)
    inputs['router_w'] = nrm((D, N_EXPERTS), D ** -0.5)
    inputs['router_bias'] = nrm((N_EXPERTS,), 0.01)
    inputs['moe_w_gate'] = nrm((L, N_EXPERTS, D, D_EXPERT), D ** -0.5)
    inputs['moe_w_up'] = nrm((L, N_EXPERTS, D, D_EXPERT), D ** -0.5)
    inputs['moe_w_down'] = nrm((L, N_EXPERTS, D_EXPERT, D), BETA * D_EXPERT ** -0.5)
    return inputs


def reference(x, c, ctx, c_ctx, mod_w, mod_b, w_in, wa_sink, ga_q_norm, ga_k_norm,
              ssd_conv_w, ssd_conv_b, ssd_dt_bias, ssd_a_log, ssd_d, ssd_norm_w,
              s5_a_re, s5_a_im, s5_log_dt, s5_b_re, s5_b_im, s5_c_re, s5_c_im, s5_d, s5_w_glu,
              w_branch, w_out, ln1_g, ln1_b, ln2_g, ln2_b, router_w, router_bias,
              moe_w_gate, moe_w_up, moe_w_down):
    bsz, seq, d = x.shape
    n_ctx = ctx.shape[1]
    cos, sin = axial_rope_tables(seq)
    cond_l = jax.nn.silu(c)
    cond_c = jax.nn.silu(c_ctx)
    xc = ctx
    for layer in range(DEPTH):
        need_ctx = layer < DEPTH - 1
        shift1, scale1, gate1, shift2, scale2, gate2 = jnp.split(
            (cond_l @ mod_w[layer] + mod_b[layer])[:, None, :], N_MOD, axis=-1)
        cshift1, cscale1, cgate1, cshift2, cscale2, cgate2 = jnp.split(
            cond_c @ mod_w[layer] + mod_b[layer], N_MOD, axis=-1)

        h_l = layer_norm(x) * (1 + scale1) + shift1
        h_c = layer_norm(xc) * (1 + cscale1) + cshift1
        mix_c, mix_l = token_mixer(h_c, h_l, cos, sin, w_in[layer], wa_sink[layer], ga_q_norm[layer], ga_k_norm[layer],
                                   ssd_conv_w[layer], ssd_conv_b[layer], ssd_dt_bias[layer], ssd_a_log[layer],
                                   ssd_d[layer], ssd_norm_w[layer],
                                   s5_a_re[layer], s5_a_im[layer], s5_log_dt[layer], s5_b_re[layer], s5_b_im[layer],
                                   s5_c_re[layer], s5_c_im[layer], s5_d[layer], s5_w_glu[layer],
                                   w_branch[layer], w_out[layer], need_ctx)
        x = post_norm(ALPHA * x + gate1 * mix_l, ln1_g[layer], ln1_b[layer])

        h_l = (layer_norm(x) * (1 + scale2) + shift2).reshape(bsz * seq, d)
        if need_ctx:
            xc = post_norm(ALPHA * xc + cgate1 * mix_c, ln1_g[layer], ln1_b[layer])
            h_c = (layer_norm(xc) * (1 + cscale2) + cshift2).reshape(bsz * n_ctx, d)
            ffn = moe(jnp.concatenate([h_c, h_l], axis=0), router_w, router_bias,
                      moe_w_gate[layer], moe_w_up[layer], moe_w_down[layer])
            xc = post_norm(ALPHA * xc + cgate2 * ffn[:bsz * n_ctx].reshape(bsz, n_ctx, d), ln2_g[layer], ln2_b[layer])
            ffn_l = ffn[bsz * n_ctx:]
        else:
            ffn_l = moe(h_l, router_w, router_bias, moe_w_gate[layer], moe_w_up[layer], moe_w_down[layer])
        x = post_norm(ALPHA * x + gate2 * ffn_l.reshape(bsz, seq, d), ln2_g[layer], ln2_b[layer])
    return x
```

```cpp
#include <hip/hip_runtime.h>
#include <cstdio>
#include <cstdint>

#ifndef MK_SPLIT
#define MK_SPLIT 0
#endif

#define DI __device__ __forceinline__
typedef unsigned short bf16;
typedef short bf16x8 __attribute__((ext_vector_type(8)));
typedef float f32x4 __attribute__((ext_vector_type(4)));
typedef float f32x2 __attribute__((ext_vector_type(2)));
typedef float f32x16 __attribute__((ext_vector_type(16)));
typedef unsigned u32x4 __attribute__((ext_vector_type(4)));
typedef unsigned u32x2 __attribute__((ext_vector_type(2)));
typedef __bf16 bf16x2_t __attribute__((ext_vector_type(2)));

DI unsigned pk2(float a, float b) { f32x2 v = {a, b}; bf16x2_t r = __builtin_convertvector(v, bf16x2_t); return __builtin_bit_cast(unsigned, r); }
DI bf16 f2bf(float a) { return (bf16)(pk2(a, 0.f) & 0xffffu); }
DI float bf2f(bf16 b) { return __uint_as_float(((unsigned)b) << 16); }
DI float bflo(unsigned u) { return __uint_as_float(u << 16); }
DI float bfhi(unsigned u) { return __uint_as_float(u & 0xffff0000u); }
DI float sigmoidf_(float x) { return 1.0f / (1.0f + __expf(-x)); }
DI float siluf_(float x) { return x / (1.0f + __expf(-x)); }
DI int crow(int reg, int h) { return (reg & 3) + 8 * (reg >> 2) + 4 * h; }
#define MFMA32(a, b, c) __builtin_amdgcn_mfma_f32_32x32x16_bf16((a), (b), (c), 0, 0, 0)
DI bf16x8 pack8(float a0, float a1, float a2, float a3, float a4, float a5, float a6, float a7) {
    u32x4 p; p.x = pk2(a0, a1); p.y = pk2(a2, a3); p.z = pk2(a4, a5); p.w = pk2(a6, a7); return __builtin_bit_cast(bf16x8, p);
}
DI float wave_sum(float v) {
#pragma unroll
    for (int m = 32; m >= 1; m >>= 1) v += __shfl_xor(v, m);
    return v;
}
#define XB_TMO      128
#define XB_XCNT(j)  (256  + 64 * (j))
#define XB_XSUB(j)  (1280 + 64 * (j))
#define XB_XGEN(j)  (2304 + 64 * (j))
#define XB_TOP      3328
#define XB_TOPGEN   3392
#define XCD_BAR_WORDS 3456
#define XB_SPIN_CAP (1u << 18)
#define LAS __attribute__((address_space(3)))

__device__ __forceinline__ unsigned xb_ld(unsigned* p)              { return __hip_atomic_load(p, __ATOMIC_RELAXED, __HIP_MEMORY_SCOPE_AGENT); }
__device__ __forceinline__ unsigned xb_add(unsigned* p, unsigned v) { return __hip_atomic_fetch_add(p, v, __ATOMIC_RELAXED, __HIP_MEMORY_SCOPE_AGENT); }
__device__ __forceinline__ unsigned xb_xcc_id() { return (unsigned)__builtin_amdgcn_s_getreg((3 << 11) | 20) & 0xFu; }
#define XB_SPIN(cond, bar) do { unsigned _sp = 0; while (cond) { __builtin_amdgcn_s_sleep(1); \
    if ((++_sp & 255u) == 0u) { if (xb_ld(&(bar)[XB_TMO])) break; if (_sp > XB_SPIN_CAP) { atomicAdd(&(bar)[XB_TMO], 1u); break; } } } } while (0)

struct XcdBarrier {
    unsigned* bar; unsigned x;
    volatile LAS unsigned* st;
};

__device__ __forceinline__ XcdBarrier xcd_barrier_post(unsigned* bar, volatile LAS unsigned* st) {
    XcdBarrier b; b.bar = bar; b.x = xb_xcc_id(); b.st = st;
    if (threadIdx.x == 0) (void)xb_add(&bar[XB_XCNT(b.x)], 1u);
    return b;
}
__device__ __forceinline__ void xcd_barrier_complete(unsigned* bar, unsigned x, unsigned& nloc, unsigned& nx) {
    const unsigned G = gridDim.x * gridDim.y * gridDim.z;
    unsigned sum, cnt, mine, sp = 0u;
    for (;;) {
        sum = 0u; cnt = 0u; mine = 0u;
#pragma unroll
        for (unsigned j = 0; j < 16; ++j) { const unsigned c = xb_ld(&bar[XB_XCNT(j)]); sum += c; cnt += (c > 0u) ? 1u : 0u; mine = (j == x) ? c : mine; }
        if (sum == G) break;
        __builtin_amdgcn_s_sleep(1);
        if ((++sp & 255u) == 0u) { if (xb_ld(&bar[XB_TMO])) break; if (sp > XB_SPIN_CAP) { atomicAdd(&bar[XB_TMO], 1u); break; } }
    }
    nloc = mine > 0u ? mine : 1u; nx = cnt > 0u ? cnt : 1u;
}

__device__ __forceinline__ void xcd_barrier(const XcdBarrier& b) {
    asm volatile("s_waitcnt vmcnt(0)" ::: "memory");
    __syncthreads();
    if (threadIdx.x == 0) {
        unsigned* bar = b.bar;
        __builtin_amdgcn_s_waitcnt(0);
        unsigned nloc = b.st[0], nx = b.st[1];
        if (nloc == 0u) { xcd_barrier_complete(bar, b.x, nloc, nx); b.st[0] = nloc; b.st[1] = nx; }
        const unsigned old = xb_add(&bar[XB_XSUB(b.x)], 1u);
        const unsigned gen = old / nloc;
        if (old + 1u == (gen + 1u) * nloc) {
            __builtin_amdgcn_fence(__ATOMIC_RELEASE, "agent");
            asm volatile("s_waitcnt vmcnt(0)" ::: "memory");
            const unsigned og = xb_add(&bar[XB_TOP], 1u);
            const unsigned tg = og / nx;
            if (og + 1u == (tg + 1u) * nx) xb_add(&bar[XB_TOPGEN], 1u);
            else XB_SPIN(xb_ld(&bar[XB_TOPGEN]) == tg, bar);
            __builtin_amdgcn_fence(__ATOMIC_ACQUIRE, "agent");
            xb_add(&bar[XB_XGEN(b.x)], 1u);
            asm volatile("s_waitcnt vmcnt(0)" ::: "memory");
        } else {
            XB_SPIN(xb_ld(&bar[XB_XGEN(b.x)]) == gen, bar);
            __builtin_amdgcn_fence(__ATOMIC_ACQUIRE, "agent");
            asm volatile("s_waitcnt vmcnt(0)" ::: "memory");
        }
    }
    __syncthreads();
}
namespace pg8 {
#define PG8_LAS __attribute__((address_space(3)))
typedef unsigned short bf16_t;
typedef short bf16x8 __attribute__((ext_vector_type(8)));
typedef float f32x4 __attribute__((ext_vector_type(4)));
typedef unsigned u32x4 __attribute__((ext_vector_type(4)));
constexpr int BM = 256, BK = 64, HALF = 128, HTB = HALF * BK * 2  , STAGE_BYTES = 8 * HTB, NXCD = 8, WGM = 8;

__host__ __device__ __forceinline__ int lds_byte(int r, int c) { const int st = (r >> 4) * 2 + (c >> 5), rr = r & 15, cc = c & 31, ob = rr * 64 + cc * 2; return st * 1024 + (ob ^ (((ob >> 9) & 1) << 5)); }
__host__ __device__ __forceinline__ void stage_rc(int b, int& R, int& C) { const int st = b / 1024, sb = b % 1024, swz = sb ^ (((sb >> 9) & 1) << 5); R = (st >> 1) * 16 + swz / 64; C = (st & 1) * 32 + (swz % 64) / 2; }
__host__ __device__ __forceinline__ int perm32(int rho) { const int n = rho >> 4, i = rho & 15; return 8 * (i >> 2) + 4 * n + (i & 3); }

struct Unit { int pm, pn; };
struct Gemm { const bf16_t* A; const bf16_t* Bt; int M, N, K; };

struct StaticOrder {
    int nM, nN, nwg, G, c;
    __host__ __device__ void init(int M, int N, int G_, int c_) { nM = M / BM; nN = N / BM; nwg = nM * nN; G = G_; c = c_; }
    __host__ __device__ bool next(int i, Unit& u) const {
        const long L = (long)i * G + c; if (L >= nwg) return false;
        int wgid = (int)L; { const int q = nwg / NXCD, r = nwg % NXCD, xcd = wgid % NXCD, off = wgid / NXCD; wgid = (xcd < r ? xcd * (q + 1) : r * (q + 1) + (xcd - r) * q) + off; }
        const int nig = WGM * nN, gid = wgid / nig, fm = gid * WGM, gsz = (nM - fm) < WGM ? (nM - fm) : WGM;
        u.pm = fm + ((wgid % nig) % gsz); u.pn = (wgid % nig) / gsz; return true;
    }
    __device__ __forceinline__ void a_ready(const Unit&) const {}
    __device__ __forceinline__ void done(const Unit&) const {}
};
template <int ACT> struct EpiStoreBf16 {
    static constexpr bool PERM = true, AFTER_DRAIN = false;
    bf16_t* O; int ldc; int colwrap;
    __device__ __forceinline__ void operator()(const f32x4 (&acc)[2][2][4][2], const Unit& u, int wr, int wc, int fr, int fq) const {
        const int row0 = u.pm * BM + wr * 64 + fr; const int colt = (u.pn * BM) % colwrap;
        const int col0 = colt + wc * 32 + 8 * fq;
#pragma unroll
        for (int ai = 0; ai < 2; ++ai)
#pragma unroll
            for (int m = 0; m < 4; ++m) { bf16_t* rowp = O + (size_t)(row0 + ai * HALF + m * 16) * ldc + col0;
#pragma unroll
                for (int bj = 0; bj < 2; ++bj) { f32x4 v0 = acc[ai][bj][m][0], v1 = acc[ai][bj][m][1];
                    if (ACT == 1) {
#pragma unroll
                        for (int j = 0; j < 4; ++j) { v0[j] = 1.0f / (1.0f + __expf(-v0[j])); v1[j] = 1.0f / (1.0f + __expf(-v1[j])); } }
                    u32x4 w; w.x = pk2(v0[0], v0[1]); w.y = pk2(v0[2], v0[3]); w.z = pk2(v1[0], v1[1]); w.w = pk2(v1[2], v1[3]);
                    *(u32x4*)(rowp + bj * HALF) = w; } }
    }
};
template <int ACT> struct EpiPair {
    static constexpr bool PERM = true, AFTER_DRAIN = false;
    bf16_t* O;
    __device__ __forceinline__ void operator()(const f32x4 (&acc)[2][2][4][2], const Unit& u, int wr, int wc, int fr, int fq) const {
        const int row0 = u.pm * BM + wr * 64 + fr; const int col0 = (u.pn & 3) * 128 + wc * 32 + 8 * fq;
#pragma unroll
        for (int ai = 0; ai < 2; ++ai)
#pragma unroll
            for (int m = 0; m < 4; ++m) { bf16_t* rowp = O + (size_t)(row0 + ai * HALF + m * 16) * 512 + col0;
                float o[8];
#pragma unroll
                for (int n = 0; n < 2; ++n)
#pragma unroll
                    for (int j = 0; j < 4; ++j) { const float a = acc[ai][0][m][n][j], b = acc[ai][1][m][n][j];
                        o[n * 4 + j] = (ACT == 0) ? (a / (1.0f + __expf(-a))) * b : a / (1.0f + __expf(-b)); }
                u32x4 w; w.x = pk2(o[0], o[1]); w.y = pk2(o[2], o[3]); w.z = pk2(o[4], o[5]); w.w = pk2(o[6], o[7]);
                *(u32x4*)rowp = w; }
    }
};
struct EpiF32 {
    static constexpr bool PERM = false, AFTER_DRAIN = false;
    float* C; int ldc;
    __device__ __forceinline__ void operator()(const f32x4 (&acc)[2][2][4][2], const Unit& u, int wr, int wc, int fr, int fq) const {
        const int row0 = u.pm * BM + wr * 64 + fr, col0 = u.pn * BM + wc * 32 + 4 * fq;
#pragma unroll
        for (int ai = 0; ai < 2; ++ai)
#pragma unroll
            for (int m = 0; m < 4; ++m) { float* rowp = C + (size_t)(row0 + ai * HALF + m * 16) * ldc + col0;
#pragma unroll
                for (int bj = 0; bj < 2; ++bj)
#pragma unroll
                    for (int n = 0; n < 2; ++n) *(f32x4*)(rowp + bj * HALF + n * 16) = acc[ai][bj][m][n]; }
    }
};
struct EpiMerge {
    static constexpr bool PERM = false, AFTER_DRAIN = false;
    const bf16_t* GATE;
    float* MRG;
    bf16_t* OUT;
    const float* SSQ;
    int MT;
    __device__ __forceinline__ void operator()(const f32x4 (&acc)[2][2][4][2], const Unit& u, int wr, int wc, int fr, int fq) const {
        const int nb = u.pn >> 2, pn = u.pn & 3, pm = u.pm - nb * MT;
        const int row0 = pm * BM + wr * 64 + fr, col0 = pn * BM + wc * 32 + 4 * fq;
#pragma unroll
        for (int ai = 0; ai < 2; ++ai)
#pragma unroll
            for (int m = 0; m < 4; ++m) { const int row = row0 + ai * HALF + m * 16;
                float rs = 1.0f;
                if (nb == 1) { const f32x4 s0 = *(const f32x4*)(SSQ + (size_t)row * 8), s1 = *(const f32x4*)(SSQ + (size_t)row * 8 + 4);
                    const float ss = ((s0[0] + s0[1]) + (s0[2] + s0[3])) + ((s1[0] + s1[1]) + (s1[2] + s1[3])); rs = rsqrtf(ss * (1.0f / 512.0f) + 1e-6f); }
                const bf16_t* gp = GATE + (size_t)row * 4096 + nb * 1024 + col0; float* mp = MRG + (size_t)row * 1024 + col0; bf16_t* op = OUT + (size_t)row * 1024 + col0;
#pragma unroll
                for (int bj = 0; bj < 2; ++bj)
#pragma unroll
                    for (int n = 0; n < 2; ++n) { const int co = bj * HALF + n * 16;
                        const u32x2 gw = *(const u32x2*)(gp + co);
                        f32x4 v = acc[ai][bj][m][n];
                        v[0] *= __uint_as_float(gw.x << 16) * rs; v[1] *= __uint_as_float(gw.x & 0xffff0000u) * rs; v[2] *= __uint_as_float(gw.y << 16) * rs; v[3] *= __uint_as_float(gw.y & 0xffff0000u) * rs;
                        if (nb != 0) v += *(const f32x4*)(mp + co);
                        if (nb == 3) { u32x2 w; w.x = pk2(v[0], v[1]); w.y = pk2(v[2], v[3]); *(u32x2*)(op + co) = w; }
                        else *(f32x4*)(mp + co) = v; } }
    }
};
struct MergeOrder {
    int G, c, ntiles, MT;
    __device__ bool next(int i, Unit& u) const { const int t = (i >> 2) * G + c; if (t >= ntiles) return false; const int n = i & 3; u.pm = n * MT + (t >> 2); u.pn = n * 4 + (t & 3); return true; }
    __device__ __forceinline__ void a_ready(const Unit&) const {}
    __device__ __forceinline__ void done(const Unit&) const {}
};
struct MoeOrder {
    int G, c, nunits; const PG8_LAS int* blk_e;
    __device__ bool next(int i, Unit& u) const { const int L = i * G + c; if (L >= nunits) return false; u.pm = L >> 2; u.pn = __builtin_amdgcn_readfirstlane(blk_e[L >> 2]) * 4 + (L & 3); return true; }
    __device__ __forceinline__ void a_ready(const Unit&) const {}
    __device__ __forceinline__ void done(const Unit&) const {}
};

template <class Epi, class Sched, bool STAMP = false>
__device__ __forceinline__ void gemm_phase(PG8_LAS unsigned char* lds, const Gemm g, const Sched& S, const Epi& E, unsigned long long* stamps, const int tid_in) {
    int tid_ = tid_in; asm volatile("" : "+v"(tid_));
    const int tid = tid_, wid = __builtin_amdgcn_readfirstlane(tid >> 6), lane = tid & 63, wr = wid >> 2, wc = wid & 3, fr = lane & 15, fq = lane >> 4;
    const int K = g.K, nt = K / BK;
    int ts_lo = 0, ts_hi = 0, nts = 0; const unsigned long long rt_entry = STAMP ? (unsigned long long)wall_clock64() : 0ull;
#define PG8_STAMP() do { if (STAMP && wid == 0 && nts < 64) { const unsigned long long _c = (unsigned long long)clock64(); \
        ts_lo = (lane == nts) ? (int)(unsigned)_c : ts_lo; ts_hi = (lane == nts) ? (int)(unsigned)(_c >> 32) : ts_hi; ++nts; } } while (0)
    PG8_STAMP();
    unsigned voffA[2], voffB[2];
#pragma unroll
    for (int i = 0; i < 2; ++i) { int R, C; stage_rc(tid * 16 + i * 8192, R, C); const int Rb = Epi::PERM ? ((R & ~31) + perm32(R & 31)) : R;
        voffA[i] = (unsigned)(R * K + C) * 2u; voffB[i] = (unsigned)(Rb * K + C) * 2u; }
    const size_t kstep = (size_t)(BK * 2);
    const size_t hstep = (size_t)HALF * K * 2;
    const size_t tstep = 2 * hstep;
    const unsigned ldsw = (unsigned)wid * 1024u;
    const int aoff = lds_byte(wr * 64 + fr, fq * 8), boff = lds_byte(wc * 32 + fr, fq * 8);
#define PG8_SA(b, h) (((b) * 2 + (h)) * HTB)
#define PG8_SB(b, h) ((4 + (b) * 2 + (h)) * HTB)
#define PG8_STAGE(bufoff, gbase, voff) do { _Pragma("unroll") for (int _i = 0; _i < 2; ++_i) \
        __builtin_amdgcn_global_load_lds((const unsigned*)((const char*)(gbase) + (voff)[_i]), (PG8_LAS unsigned*)(lds + (bufoff) + ldsw + _i * 8192), 16, 0, 0); } while (0)
#define PG8_LDA(dst, b, h) do { _Pragma("unroll") for (int m = 0; m < 4; ++m) _Pragma("unroll") for (int k = 0; k < 2; ++k) dst[m][k] = *(const PG8_LAS bf16x8*)(lds + PG8_SA(b, h) + aoff + m * 2048 + k * 1024); } while (0)
#define PG8_LDB(dst, b, h) do { _Pragma("unroll") for (int n = 0; n < 2; ++n) _Pragma("unroll") for (int k = 0; k < 2; ++k) dst[n][k] = *(const PG8_LAS bf16x8*)(lds + PG8_SB(b, h) + boff + n * 2048 + k * 1024); } while (0)
#define PG8_MMA(ai, bj, At, Bt) do { __builtin_amdgcn_s_setprio(1); _Pragma("unroll") for (int m = 0; m < 4; ++m) _Pragma("unroll") for (int n = 0; n < 2; ++n) _Pragma("unroll") for (int k = 0; k < 2; ++k) \
        acc[ai][bj][m][n] = __builtin_amdgcn_mfma_f32_16x16x32_bf16(Bt[n][k], At[m][k], acc[ai][bj][m][n], 0, 0, 0); __builtin_amdgcn_s_setprio(0); } while (0)
#define PG8_WAIT_V(n) asm volatile("s_waitcnt vmcnt(" #n ")" ::: "memory")
#define PG8_WAIT_L(n) asm volatile("s_waitcnt lgkmcnt(" #n ")" ::: "memory")
#define PG8_BAR __builtin_amdgcn_s_barrier()
#define PG8_SCHED __builtin_amdgcn_sched_barrier(0)
    Unit cur, nxt; int ui = 0;
    if (!S.next(0, cur)) return;
    f32x4 acc[2][2][4][2];
#pragma unroll
    for (int a = 0; a < 2; ++a)
#pragma unroll
        for (int b = 0; b < 2; ++b)
#pragma unroll
            for (int m = 0; m < 4; ++m)
#pragma unroll
                for (int n = 0; n < 2; ++n) acc[a][b][m][n] = (f32x4){0.f, 0.f, 0.f, 0.f};
    bf16x8 At[4][2], B0[2][2], B1[2][2];
    const char* cA = (const char*)g.A + (size_t)cur.pm * tstep; const char* cB = (const char*)g.Bt + (size_t)cur.pn * tstep;
    S.a_ready(cur);
    PG8_STAGE(PG8_SB(0, 0), cB, voffB); PG8_STAGE(PG8_SA(0, 0), cA, voffA); PG8_STAGE(PG8_SB(0, 1), cB + hstep, voffB); PG8_STAGE(PG8_SA(0, 1), cA + hstep, voffA);
    if (wr == 1) PG8_BAR;
    PG8_WAIT_V(4); PG8_BAR;
    PG8_STAGE(PG8_SB(1, 0), cB + kstep, voffB); PG8_STAGE(PG8_SA(1, 0), cA + kstep, voffA); PG8_STAGE(PG8_SB(1, 1), cB + hstep + kstep, voffB);
    PG8_WAIT_V(6); PG8_BAR;
    PG8_STAMP();
    for (;;) {
        const bool has_next = S.next(ui + 1, nxt);
        const char* nA = has_next ? (const char*)g.A + (size_t)nxt.pm * tstep : cA; const char* nB = has_next ? (const char*)g.Bt + (size_t)nxt.pn * tstep : cB;
        for (int t = 0; t < nt; t += 2) {
            const bool last = (t == nt - 2);
            const char* a1 = cA + (size_t)(t + 1) * kstep;
            const char* a2 = last ? nA : cA + (size_t)(t + 2) * kstep; const char* b2 = last ? nB : cB + (size_t)(t + 2) * kstep;
            const char* a3 = a2 + kstep; const char* b3 = b2 + kstep;
            if (last && has_next) S.a_ready(nxt);
            PG8_LDB(B0, 0, 0); PG8_SCHED; PG8_LDA(At, 0, 0); PG8_STAGE(PG8_SA(1, 1), a1 + hstep, voffA);
            PG8_WAIT_L(8); PG8_BAR; PG8_WAIT_L(0); PG8_MMA(0, 0, At, B0); PG8_BAR; PG8_SCHED;
            PG8_LDB(B1, 0, 1); PG8_STAGE(PG8_SB(0, 0), b2, voffB);
            PG8_BAR; PG8_WAIT_L(0); PG8_MMA(0, 1, At, B1); PG8_BAR;
            PG8_LDA(At, 0, 1); PG8_STAGE(PG8_SA(0, 0), a2, voffA);
            PG8_BAR; PG8_WAIT_L(0); PG8_MMA(1, 0, At, B0); PG8_BAR; PG8_SCHED;
            PG8_STAGE(PG8_SB(0, 1), b2 + hstep, voffB);
            PG8_WAIT_V(6); PG8_BAR; PG8_MMA(1, 1, At, B1); PG8_BAR;
            PG8_LDB(B0, 1, 0); PG8_SCHED; PG8_LDA(At, 1, 0); PG8_STAGE(PG8_SA(0, 1), a2 + hstep, voffA);
            PG8_WAIT_L(8); PG8_BAR; PG8_WAIT_L(0); PG8_MMA(0, 0, At, B0); PG8_BAR; PG8_SCHED;
            PG8_LDB(B1, 1, 1); PG8_STAGE(PG8_SB(1, 0), b3, voffB);
            PG8_BAR; PG8_WAIT_L(0); PG8_MMA(0, 1, At, B1); PG8_BAR;
            PG8_LDA(At, 1, 1); PG8_STAGE(PG8_SA(1, 0), a3, voffA);
            PG8_BAR; PG8_WAIT_L(0); PG8_MMA(1, 0, At, B0); PG8_BAR; PG8_SCHED;
            PG8_STAGE(PG8_SB(1, 1), b3 + hstep, voffB);
            PG8_WAIT_V(6); PG8_BAR; PG8_MMA(1, 1, At, B1); PG8_BAR;
        }
        PG8_STAMP();
        if constexpr (!Epi::AFTER_DRAIN) { E(acc, cur, wr, wc, fr, fq); S.done(cur); }
        PG8_STAMP();
        if (!has_next) break;
#pragma unroll
        for (int a = 0; a < 2; ++a)
#pragma unroll
            for (int b = 0; b < 2; ++b)
#pragma unroll
                for (int m = 0; m < 4; ++m)
#pragma unroll
                    for (int n = 0; n < 2; ++n) acc[a][b][m][n] = (f32x4){0.f, 0.f, 0.f, 0.f};
        cur = nxt; cA = nA; cB = nB; ++ui;
    }
    PG8_WAIT_V(0);
    if (wr == 0) PG8_BAR;
    PG8_BAR;
    if constexpr (Epi::AFTER_DRAIN) { E.fused(acc, cur, wr, wc, fr, fq, lds, wid, lane); S.done(cur); }
    PG8_STAMP();
    if (STAMP && wid == 0) { stamps[lane] = lane < nts ? (((unsigned long long)(unsigned)ts_hi << 32) | (unsigned)ts_lo) : 0ull;
        if (lane == 62) stamps[62] = rt_entry; if (lane == 63) stamps[63] = (unsigned long long)wall_clock64(); }
#undef PG8_STAMP
#undef PG8_SA
#undef PG8_SB
#undef PG8_STAGE
#undef PG8_LDA
#undef PG8_LDB
#undef PG8_MMA
#undef PG8_WAIT_V
#undef PG8_WAIT_L
#undef PG8_BAR
#undef PG8_SCHED
}
}
constexpr int DM = 1024, NBATCH = 16, SEQL = 2048, CTXL = 256, DEPTH = 4;
constexpr int MC = NBATCH * CTXL, ML = NBATCH * SEQL, MT = MC + ML;
constexpr int NPROJ = 3840, NGATE = 4096, DIN = 7696;
constexpr int C_AQ = 0, C_AK = 512, C_AV = 640, C_GQ = 768, C_GK = 1280, C_GV = 1408, C_SX = 1536, C_SZ = 2048, C_SB = 2560, C_SC = 2816, C_SU = 3072, C_DT = 3584;
constexpr int KVPOS = CTXL + SEQL;
constexpr int NCHUNK = MT / 128;
constexpr int NSUB = MT / 16;
constexpr int MOE_MAXBLK = 320, MOE_MAXSLOT = MOE_MAXBLK * 256;
constexpr float ALPHA = 1.6817928305074290f;
constexpr float LN_EPS = 1e-6f;
constexpr float LOG2E = 1.4426950408889634f;
constexpr float QSCALE = 0.125f * LOG2E;

enum { I_X = 0, I_C, I_CTX, I_CCTX, I_MODW, I_MODB, I_WIN, I_SINK, I_GQN, I_GKN, I_CONVW, I_CONVB, I_DTB, I_ALOG, I_SSDD, I_SSDNW,
       I_S5ARE, I_S5AIM, I_S5LDT, I_S5BRE, I_S5BIM, I_S5CRE, I_S5CIM, I_S5D, I_S5GLU, I_WBR, I_WOUT, I_LN1G, I_LN1B, I_LN2G, I_LN2B,
       I_RW, I_RB, I_MWG, I_MWU, I_MWD, N_IN };

constexpr size_t MiB = 1u << 20;
constexpr size_t WS_CTL = 0, CTL_ZERO_BYTES = 1 * MiB;
constexpr size_t WS_MOD = 1 * MiB;
constexpr size_t WS_TOKI = 3 * MiB;
constexpr size_t WS_TOKW = 4 * MiB;
constexpr size_t WS_SSQ = 5 * MiB;
constexpr size_t WS_ADEC = 7 * MiB;
constexpr size_t WS_W3T = 8 * MiB;
constexpr size_t WS_QT = 16 * MiB;
constexpr size_t WS_A16 = 20 * MiB;
constexpr size_t WS_DT = 21 * MiB;
constexpr size_t WS_WINT = 24 * MiB;
constexpr size_t WS_WGT = 32 * MiB;
constexpr size_t WS_WBT = 40 * MiB;
constexpr size_t WS_WOT = 44 * MiB;
constexpr size_t WS_WGLUT = 46 * MiB;
constexpr size_t WS_XRES = 48 * MiB;
constexpr size_t WS_H = 192 * MiB;
constexpr size_t WS_A = 264 * MiB;
constexpr size_t WS_A_HID = WS_A + 160 * MiB;
constexpr size_t WS_B = 552 * MiB;
constexpr size_t WS_B_MOED = WS_B + 64 * MiB;
constexpr size_t WS_D = 696 * MiB;
constexpr size_t WS_KALL = 840 * MiB;
constexpr size_t WS_VTALL = 858 * MiB;
constexpr size_t WS_XT = 876 * MiB;
constexpr size_t WS_BROW = 912 * MiB;
constexpr size_t WS_BT = 930 * MiB;
constexpr size_t WS_CROW = 948 * MiB;
constexpr size_t WS_QU = 966 * MiB;
constexpr size_t WS_Y5G = 1038 * MiB;
constexpr size_t WS_END = 1074 * MiB;
constexpr int CW_BAR = 4096;
constexpr int CW_CNT = 16384;

constexpr int LDS_BYTES = 147456;
constexpr int LDS_MISC = 131072;

#define GAS __attribute__((address_space(1)))

struct Args { const float* in[N_IN]; float* out; unsigned char* ws; int ph_lo, ph_hi; };
#define CAS __attribute__((address_space(4)))
struct Ctx {
    const CAS Args* A;
    LAS unsigned char* lds;
    int tid, lane, wave, G, bid;
};
template <class T> DI T* wsp(const Ctx& c, size_t off) { return (T*)(c.A->ws + off); }
DI void row_load(const float* p, int lane, f32x4 (&v)[4]) {
#pragma unroll
    for (int i = 0; i < 4; ++i) v[i] = *(const f32x4*)(p + lane * 4 + 256 * i);
}
DI void row_store(float* p, int lane, const f32x4 (&v)[4]) {
#pragma unroll
    for (int i = 0; i < 4; ++i) *(f32x4*)(p + lane * 4 + 256 * i) = v[i];
}
DI void row_store_bf16(bf16* p, int lane, const f32x4 (&v)[4]) {
#pragma unroll
    for (int i = 0; i < 4; ++i) { u32x2 w; w.x = pk2(v[i][0], v[i][1]); w.y = pk2(v[i][2], v[i][3]); *(u32x2*)(p + lane * 4 + 256 * i) = w; }
}
DI void row_ln(f32x4 (&v)[4]) {
    float s = 0.f;
#pragma unroll
    for (int i = 0; i < 4; ++i) s += (v[i][0] + v[i][1]) + (v[i][2] + v[i][3]);
    const float mu = wave_sum(s) * (1.0f / 1024.0f);
    float q = 0.f;
#pragma unroll
    for (int i = 0; i < 4; ++i) { v[i] -= mu; q += (v[i][0] * v[i][0] + v[i][1] * v[i][1]) + (v[i][2] * v[i][2] + v[i][3] * v[i][3]); }
    const float rs = rsqrtf(wave_sum(q) * (1.0f / 1024.0f) + LN_EPS);
#pragma unroll
    for (int i = 0; i < 4; ++i) v[i] *= rs;
}
DI int row_modidx(int row) { return row < MC ? 16 : (row - MC) >> 11; }
DI void row_modulate(const f32x4 (&x)[4], const float* scale, const float* shift, int lane, f32x4 (&h)[4]) {
#pragma unroll
    for (int i = 0; i < 4; ++i) h[i] = x[i];
    row_ln(h);
#pragma unroll
    for (int i = 0; i < 4; ++i) { const f32x4 sc = *(const f32x4*)(scale + lane * 4 + 256 * i), sh = *(const f32x4*)(shift + lane * 4 + 256 * i); h[i] = h[i] * (sc + 1.0f) + sh; }
}

DI void mod_unit(const Ctx& c, int unit) {
    const int l = unit / 48, cb = unit % 48;
    LAS float* cond = (LAS float*)c.lds;
    LAS float* red = (LAS float*)(c.lds + 17 * 1024 * 4);
    for (int i = c.tid; i < 17 * 1024; i += 512) { const int r = i >> 10, k = i & 1023; const float v = r < 16 ? c.A->in[I_C][r * 1024 + k] : c.A->in[I_CCTX][k]; cond[i] = siluf_(v); }
    __syncthreads();
    const int col = c.tid & 127, kq = c.tid >> 7;
    float acc[17];
#pragma unroll
    for (int r = 0; r < 17; ++r) acc[r] = 0.f;
    const float* w = c.A->in[I_MODW] + (size_t)l * 1024 * 6144 + cb * 128 + col;
    for (int k = kq * 256; k < kq * 256 + 256; ++k) { const float wv = w[(size_t)k * 6144];
#pragma unroll
        for (int r = 0; r < 17; ++r) acc[r] += cond[r * 1024 + k] * wv; }
#pragma unroll
    for (int r = 0; r < 17; ++r) red[(kq * 17 + r) * 128 + col] = acc[r];
    __syncthreads();
    float* MOD = wsp<float>(c, WS_MOD);
    for (int i = c.tid; i < 17 * 128; i += 512) { const int r = i >> 7, cc = i & 127;
        const float s = (red[(0 * 17 + r) * 128 + cc] + red[(1 * 17 + r) * 128 + cc]) + (red[(2 * 17 + r) * 128 + cc] + red[(3 * 17 + r) * 128 + cc]);
        MOD[((size_t)l * 17 + r) * 6144 + cb * 128 + cc] = s + c.A->in[I_MODB][l * 6144 + cb * 128 + cc]; }
    __syncthreads();
}

template <class Map> DI void wconv_tile(const Ctx& c, const float* src, int ld, bf16* dst, int K, int nd0, int k0, Map map) {
    LAS float* tile = (LAS float*)c.lds;
    const int kk = c.tid >> 4, n4 = (c.tid & 15) * 4;
    const int sc = map(nd0 + n4);
#pragma unroll
    for (int p = 0; p < 2; ++p) { const int k = kk + 32 * p;
        f32x4 v = {0.f, 0.f, 0.f, 0.f};
        if (sc >= 0) v = *(const f32x4*)(src + (size_t)(k0 + k) * ld + sc);
        tile[k * 65 + n4 + 0] = v[0]; tile[k * 65 + n4 + 1] = v[1]; tile[k * 65 + n4 + 2] = v[2]; tile[k * 65 + n4 + 3] = v[3]; }
    __syncthreads();
    const int n = c.tid >> 3, k8 = (c.tid & 7) * 8;
    u32x4 w; w.x = pk2(tile[(k8 + 0) * 65 + n], tile[(k8 + 1) * 65 + n]); w.y = pk2(tile[(k8 + 2) * 65 + n], tile[(k8 + 3) * 65 + n]);
    w.z = pk2(tile[(k8 + 4) * 65 + n], tile[(k8 + 5) * 65 + n]); w.w = pk2(tile[(k8 + 6) * 65 + n], tile[(k8 + 7) * 65 + n]);
    *(u32x4*)(dst + (size_t)(nd0 + n) * K + k0 + k8) = w;
    __syncthreads();
}
struct MapWin { DI int operator()(int r) const { return r < 3072 ? r : (r < 3584 ? r + 16 : (r < 3600 ? r - 512 : -1)); } };
struct MapOff { int off; DI int operator()(int r) const { return r + off; } };
struct MapGlu { DI int operator()(int r) const { const int jt = r >> 8, w = r & 255; return w < 128 ? jt * 128 + w : 512 + jt * 128 + (w - 128); } };
struct MapGU  { DI int operator()(int r) const { const int jt = r >> 8, w = r & 127; return jt * 128 + w; } };

constexpr int WSMALL_TILES = 960 + 1024 + 512 + 256 + 128;
DI void wsmall_tile(const Ctx& c, int layer, int t) {
    if (t < 960) { wconv_tile(c, c.A->in[I_WIN] + (size_t)layer * 1024 * DIN, DIN, wsp<bf16>(c, WS_WINT), 1024, (t >> 4) * 64, (t & 15) * 64, MapWin{}); return; }
    t -= 960;
    if (t < 1024) { wconv_tile(c, c.A->in[I_WIN] + (size_t)layer * 1024 * DIN, DIN, wsp<bf16>(c, WS_WGT), 1024, (t >> 4) * 64, (t & 15) * 64, MapOff{3600}); return; }
    t -= 1024;
    if (t < 512) { const int n = t >> 7, tt = t & 127; wconv_tile(c, c.A->in[I_WBR] + ((size_t)layer * 4 + n) * 512 * 1024, 1024, wsp<bf16>(c, WS_WBT) + (size_t)n * 1024 * 512, 512, (tt >> 3) * 64, (tt & 7) * 64, MapOff{0}); return; }
    t -= 512;
    if (t < 256) { wconv_tile(c, c.A->in[I_WOUT] + (size_t)layer * 1024 * 1024, 1024, wsp<bf16>(c, WS_WOT), 1024, (t >> 4) * 64, (t & 15) * 64, MapOff{0}); return; }
    t -= 256;
    wconv_tile(c, c.A->in[I_S5GLU] + (size_t)layer * 512 * 1024, 1024, wsp<bf16>(c, WS_WGLUT), 512, (t >> 3) * 64, (t & 7) * 64, MapGlu{});
}
constexpr int WMOE_TILES = 32 * 384;
DI void wmoe_tile(const Ctx& c, int layer, int t) {
    const int e = t / 384, tt = t % 384;
    if (tt < 256) { const int nd0 = (tt >> 4) * 64, k0 = (tt & 15) * 64;
        const float* src = ((nd0 & 128) ? c.A->in[I_MWU] : c.A->in[I_MWG]) + ((size_t)layer * 32 + e) * 1024 * 512;
        wconv_tile(c, src, 512, wsp<bf16>(c, WS_B) + (size_t)e * 1024 * 1024, 1024, nd0, k0, MapGU{}); }
    else { const int u = tt - 256;
        wconv_tile(c, c.A->in[I_MWD] + ((size_t)layer * 32 + e) * 512 * 1024, 1024, wsp<bf16>(c, WS_B_MOED) + (size_t)e * 1024 * 512, 512, (u >> 3) * 64, (u & 7) * 64, MapOff{0}); }
}

DI void s5mat_unit(const Ctx& c, int layer, int g) {
    LAS float* pw = (LAS float*)c.lds;
    LAS float* bb = (LAS float*)(c.lds + 17408);
    LAS float* cc = (LAS float*)(c.lds + 33792);
    LAS float* kt = (LAS float*)(c.lds + 41984);
    const int tid = c.tid;
    if (tid < 128) { const int dir = tid >> 6, n = tid & 63;
        const float are = fminf(c.A->in[I_S5ARE][((layer * 2 + dir) * 32 + g) * 64 + n], -1e-4f), aim = c.A->in[I_S5AIM][((layer * 2 + dir) * 32 + g) * 64 + n];
        const float dt = expf(c.A->in[I_S5LDT][(layer * 2 + dir) * 32 + g]);
        const float lr = are * dt, li = aim * dt;
        for (int tau = 0; tau <= 16; ++tau) { const float mag = expf(lr * tau); float sn, cs; sincosf(li * tau, &sn, &cs); pw[((dir * 64 + n) * 17 + tau) * 2] = mag * cs; pw[((dir * 64 + n) * 17 + tau) * 2 + 1] = mag * sn; }
        const float abr = pw[((dir * 64 + n) * 17 + 1) * 2] - 1.0f, abi = pw[((dir * 64 + n) * 17 + 1) * 2 + 1];
        const float den = are * are + aim * aim;
        const float cr = (abr * are + abi * aim) / den, ci = (abi * are - abr * aim) / den;
        for (int s = 0; s < 16; ++s) { const float br = c.A->in[I_S5BRE][(((size_t)layer * 32 + g) * 64 + n) * 16 + s], bi = c.A->in[I_S5BIM][(((size_t)layer * 32 + g) * 64 + n) * 16 + s];
            bb[((dir * 64 + n) * 16 + s) * 2] = cr * br - ci * bi; bb[((dir * 64 + n) * 16 + s) * 2 + 1] = cr * bi + ci * br; }
    }
    for (int i = tid; i < 1024; i += 512) { const int s = i >> 6, n = i & 63; cc[i * 2] = c.A->in[I_S5CRE][(((size_t)layer * 32 + g) * 16 + s) * 64 + n]; cc[i * 2 + 1] = c.A->in[I_S5CIM][(((size_t)layer * 32 + g) * 16 + s) * 64 + n]; }
    __syncthreads();
    for (int i = tid; i < 8192; i += 512) { const int dir = i >> 12, tau = (i >> 8) & 15, s = (i >> 4) & 15, sp = i & 15;
        float acc = 0.f;
        for (int n = 0; n < 64; ++n) { const float cr = cc[(s * 64 + n) * 2], ci = cc[(s * 64 + n) * 2 + 1], pr = pw[((dir * 64 + n) * 17 + tau) * 2], pi = pw[((dir * 64 + n) * 17 + tau) * 2 + 1];
            const float zr = cr * pr - ci * pi, zi = cr * pi + ci * pr; const float br = bb[((dir * 64 + n) * 16 + sp) * 2], bi = bb[((dir * 64 + n) * 16 + sp) * 2 + 1];
            acc += zr * br - zi * bi; }
        kt[i] = acc; }
    __syncthreads();
    bf16* W3T = wsp<bf16>(c, WS_W3T) + (size_t)g * 256 * 512;
    bf16* QT = wsp<bf16>(c, WS_QT) + (size_t)g * 256 * 256;
    const float* dsk = c.A->in[I_S5D] + layer * 512 + g * 16;
    for (int i = tid; i < 256 * 256; i += 512) { const int col = i >> 8, k = i & 255; const int t = col >> 4, s = col & 15, tp = k >> 4, sp = k & 15;
        float v = 0.f;
        if (t >= tp) v += kt[((0 * 16 + (t - tp)) * 16 + s) * 16 + sp];
        if (tp >= t) v += kt[((1 * 16 + (tp - t)) * 16 + s) * 16 + sp];
        if (col == k) v += dsk[s];
        W3T[(size_t)col * 512 + k] = f2bf(v); }
    for (int i = tid; i < 256 * 256; i += 512) { const int col = i >> 8, kk = i & 255; const int t = col >> 4, s = col & 15, dir = kk >> 7, ri = (kk >> 6) & 1, n = kk & 63;
        const int e = dir == 0 ? t + 1 : 16 - t;
        const float cr = cc[(s * 64 + n) * 2], ci = cc[(s * 64 + n) * 2 + 1], pr = pw[((dir * 64 + n) * 17 + e) * 2], pi = pw[((dir * 64 + n) * 17 + e) * 2 + 1];
        const float zr = cr * pr - ci * pi, zi = cr * pi + ci * pr;
        W3T[(size_t)col * 512 + 256 + kk] = f2bf(ri == 0 ? zr : -zi); }
    for (int i = tid; i < 256 * 256; i += 512) { const int col = i >> 8, k = i & 255; const int dir = col >> 7, ri = (col >> 6) & 1, n = col & 63, tp = k >> 4, sp = k & 15;
        const int e = dir == 0 ? 15 - tp : tp;
        const float pr = pw[((dir * 64 + n) * 17 + e) * 2], pi = pw[((dir * 64 + n) * 17 + e) * 2 + 1], br = bb[((dir * 64 + n) * 16 + sp) * 2], bi = bb[((dir * 64 + n) * 16 + sp) * 2 + 1];
        QT[(size_t)col * 256 + k] = f2bf(ri == 0 ? pr * br - pi * bi : pr * bi + pi * br); }
    if (tid < 128) { const int dir = tid >> 6, n = tid & 63; float* A16 = wsp<float>(c, WS_A16);
        A16[((g * 2 + dir) * 64 + n) * 2] = pw[((dir * 64 + n) * 17 + 16) * 2]; A16[((g * 2 + dir) * 64 + n) * 2 + 1] = pw[((dir * 64 + n) * 17 + 16) * 2 + 1]; }
    __syncthreads();
}

DI void row_phase_first(const Ctx& c) {
    const float* MOD = wsp<float>(c, WS_MOD);
    for (int row = c.bid * 8 + c.wave; row < MT; row += c.G * 8) {
        const float* src = row < MC ? c.A->in[I_CTX] + (size_t)row * 1024 : c.A->in[I_X] + (size_t)(row - MC) * 1024;
        f32x4 x[4], h[4]; row_load(src, c.lane, x);
        row_store(wsp<float>(c, WS_XRES) + (size_t)row * 1024, c.lane, x);
        const float* md = MOD + ((size_t)0 * 17 + row_modidx(row)) * 6144;
        row_modulate(x, md + 1024, md, c.lane, h);
        row_store_bf16(wsp<bf16>(c, WS_H) + (size_t)row * 1024, c.lane, h);
    }
}
DI void prep_unit(const Ctx& c, int layer, int unit) {
    const int tok0 = unit * 64;
    const bool isctx = tok0 < MC;
    const int b = isctx ? tok0 >> 8 : (tok0 - MC) >> 11;
    const int t0 = isctx ? tok0 & 255 : (tok0 - MC) & 2047;
    const int L = isctx ? CTXL : SEQL;
    const int kpos0 = isctx ? t0 : CTXL + t0;
    bf16* PROJ = wsp<bf16>(c, WS_A);
    const int tid = c.tid, lane = c.lane, wave = c.wave;
    {
        const int half = lane >> 5, j = lane & 31;
        const int d0 = j < 16 ? j : j + 16, d1 = d0 + 16;
        const float invf = exp2f(-(float)(j & 15) * (13.287712379549449f / 16.0f));
#pragma unroll 1
        for (int vec = 0; vec < 20; ++vec) {
            int col, kvh = 0, type = 0; bool isq, norm; const float* nw = nullptr;
            if (vec < 8) { col = C_AQ + vec * 64; isq = true; norm = false; }
            else if (vec < 10) { col = C_AK + (vec - 8) * 64; isq = false; norm = false; kvh = vec - 8; type = 0; }
            else if (vec < 18) { col = C_GQ + (vec - 10) * 64; isq = true; norm = true; nw = c.A->in[I_GQN] + layer * 64; }
            else { col = C_GK + (vec - 18) * 64; isq = false; norm = true; nw = c.A->in[I_GKN] + layer * 64; kvh = vec - 18; type = 1; }
#pragma unroll 1
            for (int sub = 0; sub < 4; ++sub) {
                const int tok = sub * 16 + wave * 2 + half;
                bf16* p = PROJ + (size_t)(tok0 + tok) * NPROJ + col;
                float x0 = bf2f(p[d0]), x1 = bf2f(p[d1]);
                if (norm) { float ss = x0 * x0 + x1 * x1;
#pragma unroll
                    for (int m = 16; m >= 1; m >>= 1) ss += __shfl_xor(ss, m);
                    const float rs = rsqrtf(ss * (1.0f / 64.0f) + LN_EPS); x0 = x0 * rs * nw[d0]; x1 = x1 * rs * nw[d1]; }
                if (!isctx) { const int pos = t0 + tok; const float ang = (float)(j < 16 ? (pos >> 6) : (pos & 63)) * invf; float sn, cs; sincosf(ang, &sn, &cs);
                    const float o0 = x0 * cs - x1 * sn, o1 = x1 * cs + x0 * sn; x0 = o0; x1 = o1; }
                if (isq) { p[d0] = f2bf(x0 * QSCALE); p[d1] = f2bf(x1 * QSCALE); }
                else { bf16* kp = wsp<bf16>(c, WS_KALL) + ((size_t)((type * 16 + b) * 2 + kvh) * KVPOS + kpos0 + tok) * 64; kp[d0] = f2bf(x0); kp[d1] = f2bf(x1); }
            }
        }
    }
    {
        LAS bf16* vt = (LAS bf16*)c.lds;
        const int tr = tid >> 3, c8 = (tid & 7) * 8;
#pragma unroll
        for (int q = 0; q < 4; ++q) { const int vcol = ((q >> 1) ? C_GV : C_AV) + (q & 1) * 64;
            *(LAS u32x4*)(vt + (q * 64 + tr) * 72 + c8) = *(const u32x4*)(PROJ + (size_t)(tok0 + tr) * NPROJ + vcol + c8); }
        __syncthreads();
#pragma unroll
        for (int q = 0; q < 4; ++q) { const int d = tr, t8 = c8;
            LAS bf16* s = vt + (q * 64 + t8) * 72 + d;
            u32x4 w; w.x = (unsigned)s[0] | ((unsigned)s[72] << 16); w.y = (unsigned)s[144] | ((unsigned)s[216] << 16); w.z = (unsigned)s[288] | ((unsigned)s[360] << 16); w.w = (unsigned)s[432] | ((unsigned)s[504] << 16);
            *(u32x4*)(wsp<bf16>(c, WS_VTALL) + ((size_t)(((q >> 1) * 16 + b) * 2 + (q & 1)) * 64 + d) * KVPOS + kpos0 + t8) = w; }
        __syncthreads();
    }
    {
        LAS bf16* tin = (LAS bf16*)c.lds;
        LAS bf16* tout = (LAS bf16*)(c.lds + 66 * 264 * 2);
        const int cg = tok0 >> 7, s0 = tok0 & 127;
        const float* cw = c.A->in[I_CONVW] + (size_t)layer * 3 * 1024;
        const float* cb_ = c.A->in[I_CONVB] + (size_t)layer * 1024;
#pragma unroll 1
        for (int cb = 0; cb < 4; ++cb) {
            const int scol = cb == 0 ? C_SX : (cb == 1 ? C_SX + 256 : (cb == 2 ? C_SB : C_SC));
            for (int i = tid; i < 66 * 32; i += 512) { const int rr = i >> 5, ch = (i & 31) * 8; const int pos = t0 - 1 + rr;
                u32x4 v = {0u, 0u, 0u, 0u};
                if (pos >= 0 && pos < L) v = *(const u32x4*)(PROJ + (size_t)(tok0 - 1 + rr) * NPROJ + scol + ch);
                *(LAS u32x4*)(tin + rr * 264 + ch) = v; }
            __syncthreads();
            { const int c2 = tid & 127, tq = tid >> 7; const int ch = cb * 256 + 2 * c2;
                const float w0a = cw[ch], w0b = cw[ch + 1], w1a = cw[1024 + ch], w1b = cw[1024 + ch + 1], w2a = cw[2048 + ch], w2b = cw[2048 + ch + 1], ba = cb_[ch], bbv = cb_[ch + 1];
                unsigned pv = *(LAS unsigned*)(tin + (tq * 16) * 264 + 2 * c2), cv = *(LAS unsigned*)(tin + (tq * 16 + 1) * 264 + 2 * c2);
#pragma unroll 4
                for (int t = 0; t < 16; ++t) { const unsigned nv = *(LAS unsigned*)(tin + (tq * 16 + t + 2) * 264 + 2 * c2);
                    const float ya = w0a * bflo(pv) + w1a * bflo(cv) + w2a * bflo(nv) + ba, yb = w0b * bfhi(pv) + w1b * bfhi(cv) + w2b * bfhi(nv) + bbv;
                    *(LAS unsigned*)(tout + (tq * 16 + t) * 264 + 2 * c2) = pk2(siluf_(ya), siluf_(yb)); pv = cv; cv = nv; } }
            __syncthreads();
            if (cb >= 2) { bf16* dst = wsp<bf16>(c, cb == 2 ? WS_BROW : WS_CROW); const int t = tid >> 3, c32 = (tid & 7) * 32;
#pragma unroll
                for (int i = 0; i < 4; ++i) *(u32x4*)(dst + (size_t)(tok0 + t) * 256 + c32 + 8 * i) = *(LAS u32x4*)(tout + t * 264 + c32 + 8 * i); }
            if (cb <= 2) { bf16* dst = cb == 2 ? wsp<bf16>(c, WS_BT) + (size_t)cg * 256 * 128 : wsp<bf16>(c, WS_XT) + ((size_t)cg * 512 + cb * 256) * 128;
                const int ch = tid >> 1, hf = tid & 1;
#pragma unroll
                for (int i = 0; i < 4; ++i) { LAS bf16* s = tout + (hf * 32 + 8 * i) * 264 + ch;
                    u32x4 w; w.x = (unsigned)s[0] | ((unsigned)s[264] << 16); w.y = (unsigned)s[528] | ((unsigned)s[792] << 16); w.z = (unsigned)s[1056] | ((unsigned)s[1320] << 16); w.w = (unsigned)s[1584] | ((unsigned)s[1848] << 16);
                    *(u32x4*)(dst + (size_t)ch * 128 + s0 + hf * 32 + 8 * i) = w; } }
            __syncthreads();
        }
    }
    for (int i = tid; i < 64 * 16; i += 512) { const int tok = i >> 4, k = i & 15;
        const float x = bf2f(PROJ[(size_t)(tok0 + tok) * NPROJ + C_DT + k]) + c.A->in[I_DTB][layer * 16 + k];
        wsp<float>(c, WS_DT)[(size_t)(tok0 + tok) * 16 + k] = fmaxf(x, 0.f) + log1pf(__expf(-fabsf(x))); }
}
struct AttnJob {
    const bf16* q; int q_row0; int qcol;
    const bf16* k; const bf16* vt;
    int ntile, lt_lo;
    int window, qpos0;
    const float* sink;
    bf16* out; int out_col;
};
DI int attn_tile_pos(int i, int lt_lo) { return i < 4 ? 64 * i : CTXL + 64 * (lt_lo + i - 4); }
DI void attn_unit(const Ctx& c, const AttnJob& J) {
    LAS bf16* Ks = (LAS bf16*)c.lds;
    LAS bf16* Vs = (LAS bf16*)(c.lds + 2 * 64 * 72 * 2);
    const int tid = c.tid, lane = c.lane, wave = c.wave;
    const int g = wave >> 1, qs = (wave & 1) * 32, r = lane & 31, hh = lane >> 5;
    const int qrow = J.q_row0 + qs + r;
    bf16x8 qf[4];
#pragma unroll
    for (int s = 0; s < 4; ++s) qf[s] = *(const bf16x8*)(J.q + (size_t)qrow * NPROJ + J.qcol + g * 64 + 16 * s + 8 * hh);
    float m_run = J.sink ? J.sink[g] * LOG2E : -1e30f;
    float l_run = (J.sink && hh == 0) ? 1.0f : 0.0f;
    f32x16 O0, O1;
#pragma unroll
    for (int i = 0; i < 16; ++i) { O0[i] = 0.f; O1[i] = 0.f; }
    const int srow = tid >> 3, sch = (tid & 7) * 8;
    u32x4 kreg, vreg;
    { const int p0 = attn_tile_pos(0, J.lt_lo); kreg = *(const u32x4*)(J.k + (size_t)(p0 + srow) * 64 + sch); vreg = *(const u32x4*)(J.vt + (size_t)srow * KVPOS + p0 + sch); }
    *(LAS u32x4*)(Ks + srow * 72 + sch) = kreg; *(LAS u32x4*)(Vs + srow * 72 + sch) = vreg;
    __syncthreads();
#pragma unroll 1
    for (int i = 0; i < J.ntile; ++i) {
        const int cur = i & 1;
        const bool more = (i + 1 < J.ntile);
        if (more) { const int p1 = attn_tile_pos(i + 1, J.lt_lo); kreg = *(const u32x4*)(J.k + (size_t)(p1 + srow) * 64 + sch); vreg = *(const u32x4*)(J.vt + (size_t)srow * KVPOS + p1 + sch); }
        LAS bf16* Kc = Ks + cur * 64 * 72; LAS bf16* Vc = Vs + cur * 64 * 72;
        f32x16 S0, S1;
#pragma unroll
        for (int e = 0; e < 16; ++e) { S0[e] = 0.f; S1[e] = 0.f; }
#pragma unroll
        for (int s = 0; s < 4; ++s) {
            const bf16x8 a0 = *(LAS bf16x8*)(Kc + r * 72 + 16 * s + 8 * hh), a1 = *(LAS bf16x8*)(Kc + (32 + r) * 72 + 16 * s + 8 * hh);
            S0 = MFMA32(a0, qf[s], S0); S1 = MFMA32(a1, qf[s], S1);
        }
        if (J.window && i >= 4) {
            const int kbase = 64 * (J.lt_lo + i - 4) - (J.qpos0 + qs + r);
#pragma unroll
            for (int e = 0; e < 16; ++e) { const int d0 = kbase + crow(e, hh), d1 = d0 + 32;
                if (d0 > 128 || d0 < -128) S0[e] = -1e30f;
                if (d1 > 128 || d1 < -128) S1[e] = -1e30f; }
        }
        float mx = S0[0];
#pragma unroll
        for (int e = 1; e < 16; ++e) mx = fmaxf(mx, S0[e]);
#pragma unroll
        for (int e = 0; e < 16; ++e) mx = fmaxf(mx, S1[e]);
        mx = fmaxf(mx, __shfl_xor(mx, 32));
        const float m_new = fmaxf(m_run, mx);
        const float alpha = __builtin_amdgcn_exp2f(m_run - m_new);
        m_run = m_new;
        float ps = 0.f;
#pragma unroll
        for (int e = 0; e < 16; ++e) { S0[e] = __builtin_amdgcn_exp2f(S0[e] - m_new); S1[e] = __builtin_amdgcn_exp2f(S1[e] - m_new); ps += S0[e] + S1[e]; }
        l_run = l_run * alpha + ps;
#pragma unroll
        for (int e = 0; e < 16; ++e) { O0[e] *= alpha; O1[e] *= alpha; }
        bf16x8 pf[2][2];
        pf[0][0] = pack8(S0[0], S0[1], S0[2], S0[3], S0[4], S0[5], S0[6], S0[7]); pf[0][1] = pack8(S0[8], S0[9], S0[10], S0[11], S0[12], S0[13], S0[14], S0[15]);
        pf[1][0] = pack8(S1[0], S1[1], S1[2], S1[3], S1[4], S1[5], S1[6], S1[7]); pf[1][1] = pack8(S1[8], S1[9], S1[10], S1[11], S1[12], S1[13], S1[14], S1[15]);
#pragma unroll
        for (int kh = 0; kh < 2; ++kh)
#pragma unroll
            for (int s2 = 0; s2 < 2; ++s2) {
                const int ko = 32 * kh + 16 * s2 + 4 * hh;
                { const u32x2 lo = *(LAS u32x2*)(Vc + r * 72 + ko), hi = *(LAS u32x2*)(Vc + r * 72 + ko + 8); u32x4 w = {lo.x, lo.y, hi.x, hi.y}; O0 = MFMA32(__builtin_bit_cast(bf16x8, w), pf[kh][s2], O0); }
                { const u32x2 lo = *(LAS u32x2*)(Vc + (32 + r) * 72 + ko), hi = *(LAS u32x2*)(Vc + (32 + r) * 72 + ko + 8); u32x4 w = {lo.x, lo.y, hi.x, hi.y}; O1 = MFMA32(__builtin_bit_cast(bf16x8, w), pf[kh][s2], O1); }
            }
        if (more) { *(LAS u32x4*)(Ks + (cur ^ 1) * 64 * 72 + srow * 72 + sch) = kreg; *(LAS u32x4*)(Vs + (cur ^ 1) * 64 * 72 + srow * 72 + sch) = vreg; }
        __syncthreads();
    }
    l_run += __shfl_xor(l_run, 32);
    const float inv = 1.0f / l_run;
    bf16* op = J.out + (size_t)qrow * 512 + J.out_col + g * 64 + 4 * hh;
#pragma unroll
    for (int k4 = 0; k4 < 4; ++k4) {
        u32x2 w0; w0.x = pk2(O0[4 * k4] * inv, O0[4 * k4 + 1] * inv); w0.y = pk2(O0[4 * k4 + 2] * inv, O0[4 * k4 + 3] * inv); *(u32x2*)(op + 8 * k4) = w0;
        u32x2 w1; w1.x = pk2(O1[4 * k4] * inv, O1[4 * k4 + 1] * inv); w1.y = pk2(O1[4 * k4 + 2] * inv, O1[4 * k4 + 3] * inv); *(u32x2*)(op + 32 + 8 * k4) = w1;
    }
}
DI void attn_global_unit(const Ctx& c, int idx) {
    const int b = idx >> 6, kvh = (idx >> 5) & 1, qb = idx & 31;
    AttnJob J; J.q = wsp<bf16>(c, WS_A); J.q_row0 = MC + b * SEQL + 64 * qb; J.qcol = C_GQ + kvh * 256;
    J.k = wsp<bf16>(c, WS_KALL) + (size_t)((16 + b) * 2 + kvh) * KVPOS * 64; J.vt = wsp<bf16>(c, WS_VTALL) + (size_t)((16 + b) * 2 + kvh) * 64 * KVPOS;
    J.ntile = 36; J.lt_lo = 0; J.window = 0; J.qpos0 = 0; J.sink = nullptr; J.out = wsp<bf16>(c, WS_B) + (size_t)2 * MT * 512; J.out_col = kvh * 256;
    attn_unit(c, J);
}
DI void attn_window_unit(const Ctx& c, int layer, int idx) {
    const int b = idx >> 6, kvh = (idx >> 5) & 1, qb = idx & 31;
    AttnJob J; J.q = wsp<bf16>(c, WS_A); J.q_row0 = MC + b * SEQL + 64 * qb; J.qcol = C_AQ + kvh * 256;
    J.k = wsp<bf16>(c, WS_KALL) + (size_t)(b * 2 + kvh) * KVPOS * 64; J.vt = wsp<bf16>(c, WS_VTALL) + (size_t)(b * 2 + kvh) * 64 * KVPOS;
    const int lo = qb - 2 < 0 ? 0 : qb - 2, hi = qb + 3 > 32 ? 32 : qb + 3;
    J.ntile = 4 + hi - lo; J.lt_lo = lo; J.window = 1; J.qpos0 = 64 * qb; J.sink = c.A->in[I_SINK] + layer * 8 + kvh * 4; J.out = wsp<bf16>(c, WS_B); J.out_col = kvh * 256;
    attn_unit(c, J);
}
DI void attn_ctx_unit(const Ctx& c, int layer, int idx) {
    const int type = idx >> 7, b = (idx >> 3) & 15, kvh = (idx >> 2) & 1, qb = idx & 3;
    AttnJob J; J.q = wsp<bf16>(c, WS_A); J.q_row0 = b * CTXL + 64 * qb; J.qcol = (type ? C_GQ : C_AQ) + kvh * 256;
    J.k = wsp<bf16>(c, WS_KALL) + (size_t)((type * 16 + b) * 2 + kvh) * KVPOS * 64; J.vt = wsp<bf16>(c, WS_VTALL) + (size_t)((type * 16 + b) * 2 + kvh) * 64 * KVPOS;
    J.ntile = 4; J.lt_lo = 0; J.window = 0; J.qpos0 = 0; J.sink = type ? nullptr : c.A->in[I_SINK] + layer * 8 + kvh * 4; J.out = wsp<bf16>(c, WS_B) + (size_t)(type ? 2 : 0) * MT * 512; J.out_col = kvh * 256;
    attn_unit(c, J);
}
DI float wave_incl_scan(float v, int lane) {
#pragma unroll
    for (int off = 1; off < 64; off <<= 1) { const float t = __shfl_up(v, off); if (lane >= off) v += t; }
    return v;
}
DI bf16x8 ldg8(const bf16* p) { return *(const bf16x8*)p; }
DI float ssd_cum(const Ctx& c, int layer, int cg, int h, int dir, LAS float* cum, LAS float* dtv) {
    const int lane = c.lane;
    const float a = -__expf(c.A->in[I_ALOG][(layer * 2 + dir) * 8 + h]);
    const float* DT = wsp<float>(c, WS_DT) + (size_t)cg * 128 * 16 + dir * 8 + h;
    const float d0 = DT[(2 * lane) * 16], d1 = DT[(2 * lane + 1) * 16];
    const float da0 = d0 * a, da1 = d1 * a;
    const float incl = wave_incl_scan(da0 + da1, lane);
    const float tot = __shfl(incl, 63);
    float c0, c1;
    if (dir == 0) { c0 = incl - da1; c1 = incl; }
    else { c1 = tot - incl + da1; c0 = c1 + da0; }
    cum[2 * lane] = c0; cum[2 * lane + 1] = c1; dtv[2 * lane] = d0; dtv[2 * lane + 1] = d1;
    return tot;
}
DI void ssd_states_unit(const Ctx& c, int layer, int unit) {
    const int cg = unit >> 1, g = unit & 1;
    const int lane = c.lane, wave = c.wave, r = lane & 31, hh = lane >> 5;
    const int j = wave & 3, dir = wave >> 2, h = 4 * g + j;
    LAS float* cum = (LAS float*)c.lds + wave * 256;
    LAS float* dtv = cum + 128;
    const float tot = ssd_cum(c, layer, cg, h, dir, cum, dtv);
    { const float w0 = dtv[2 * lane] * __expf(tot - cum[2 * lane]), w1 = dtv[2 * lane + 1] * __expf(tot - cum[2 * lane + 1]); cum[2 * lane] = w0; cum[2 * lane + 1] = w1; }
    if (lane == 0) wsp<float>(c, WS_ADEC)[cg * 16 + dir * 8 + h] = tot;
    __builtin_amdgcn_wave_barrier();
    const bf16* XT = wsp<bf16>(c, WS_XT) + ((size_t)cg * 512 + h * 64) * 128;
    const bf16* BT = wsp<bf16>(c, WS_BT) + ((size_t)cg * 256 + g * 128) * 128;
    f32x16 acc[2][4];
#pragma unroll
    for (int a_ = 0; a_ < 2; ++a_)
#pragma unroll
        for (int b_ = 0; b_ < 4; ++b_)
#pragma unroll
            for (int e = 0; e < 16; ++e) acc[a_][b_][e] = 0.f;
#pragma unroll 2
    for (int ks = 0; ks < 8; ++ks) {
        const int k = 16 * ks + 8 * hh;
        const f32x4 wa = *(LAS f32x4*)(cum + k), wb = *(LAS f32x4*)(cum + k + 4);
        bf16x8 af[2];
#pragma unroll
        for (int ph = 0; ph < 2; ++ph) { const u32x4 raw = *(const u32x4*)(XT + (size_t)(32 * ph + r) * 128 + k);
            af[ph] = pack8(bflo(raw.x) * wa[0], bfhi(raw.x) * wa[1], bflo(raw.y) * wa[2], bfhi(raw.y) * wa[3], bflo(raw.z) * wb[0], bfhi(raw.z) * wb[1], bflo(raw.w) * wb[2], bfhi(raw.w) * wb[3]); }
#pragma unroll
        for (int nt = 0; nt < 4; ++nt) { const bf16x8 bfr = ldg8(BT + (size_t)(32 * nt + r) * 128 + k);
            acc[0][nt] = MFMA32(af[0], bfr, acc[0][nt]); acc[1][nt] = MFMA32(af[1], bfr, acc[1][nt]); }
    }
    float* SL = wsp<float>(c, WS_D) + (size_t)(cg * 16 + dir * 8 + h) * 8192;
#pragma unroll
    for (int ph = 0; ph < 2; ++ph)
#pragma unroll
        for (int nt = 0; nt < 4; ++nt)
#pragma unroll
            for (int e = 0; e < 16; ++e) SL[(32 * ph + crow(e, hh)) * 128 + 32 * nt + r] = acc[ph][nt][e];
    __builtin_amdgcn_wave_barrier();
}
DI int ssd_chunk_of(int b, int dir, int step) {
    if (dir == 0) return step < 2 ? 2 * b + step : 32 + 16 * b + (step - 2);
    return step < 2 ? 2 * b + (1 - step) : 32 + 16 * b + (15 - (step - 2));
}
DI void ssd_recur(const Ctx& c, int first, int stride) {
    float* SL = wsp<float>(c, WS_D); const float* ADEC = wsp<float>(c, WS_ADEC);
    for (int it = first; it < 16 * 16 * 2048; it += stride) {
        const int e4 = it & 2047, dh = (it >> 11) & 15, b = it >> 15; const int dir = dh >> 3;
        f32x4 loc[18]; float dec[18];
#pragma unroll
        for (int s = 0; s < 18; ++s) { const int cg = ssd_chunk_of(b, dir, s); loc[s] = *(const f32x4*)(SL + (size_t)(cg * 16 + dh) * 8192 + e4 * 4); dec[s] = __expf(ADEC[cg * 16 + dh]); }
        f32x4 st = {0.f, 0.f, 0.f, 0.f};
#pragma unroll
        for (int s = 0; s < 18; ++s) { const int cg = ssd_chunk_of(b, dir, s); *(f32x4*)(SL + (size_t)(cg * 16 + dh) * 8192 + e4 * 4) = st; st = st * dec[s] + loc[s]; }
    }
}
DI void ssd_out_unit(const Ctx& c, int layer, int unit) {
    const int cg = unit >> 1, g = unit & 1;
    const int lane = c.lane, wave = c.wave, r = lane & 31, hh = lane >> 5;
    const int j = wave & 3, lh = wave >> 2, h = 4 * g + j;
    LAS float* cumf = (LAS float*)c.lds + wave * 512; LAS float* dtf = cumf + 128; LAS float* cumb = cumf + 256; LAS float* dtb = cumf + 384;
    ssd_cum(c, layer, cg, h, 0, cumf, dtf);
    ssd_cum(c, layer, cg, h, 1, cumb, dtb);
    __builtin_amdgcn_wave_barrier();
    const bf16* XT = wsp<bf16>(c, WS_XT) + ((size_t)cg * 512 + h * 64) * 128;
    const bf16* BR = wsp<bf16>(c, WS_BROW) + (size_t)cg * 128 * 256 + g * 128;
    const bf16* CR = wsp<bf16>(c, WS_CROW) + (size_t)cg * 128 * 256 + g * 128;
    const float* SLf = wsp<float>(c, WS_D) + (size_t)(cg * 16 + h) * 8192;
    const float* SLb = wsp<float>(c, WS_D) + (size_t)(cg * 16 + 8 + h) * 8192;
    const bf16* PROJ = wsp<bf16>(c, WS_A);
    const float Dh = c.A->in[I_SSDD][layer * 8 + h];
    const float* nw = c.A->in[I_SSDNW] + layer * 512 + h * 64;
    bf16* YS = wsp<bf16>(c, WS_B) + (size_t)1 * MT * 512;
#pragma unroll 1
    for (int lbi = 0; lbi < 2; ++lbi) {
        const int lb = 2 * lh + lbi, l = 32 * lb + r;
        bf16x8 cf[8];
#pragma unroll
        for (int ks = 0; ks < 8; ++ks) cf[ks] = ldg8(CR + (size_t)l * 256 + 16 * ks + 8 * hh);
        f32x16 y0, y1;
#pragma unroll
        for (int e = 0; e < 16; ++e) { y0[e] = 0.f; y1[e] = 0.f; }
#pragma unroll
        for (int dir = 0; dir < 2; ++dir) {
            const float* SLd = dir == 0 ? SLf : SLb;
            f32x16 t0, t1;
#pragma unroll
            for (int e = 0; e < 16; ++e) { t0[e] = 0.f; t1[e] = 0.f; }
#pragma unroll 2
            for (int ks = 0; ks < 8; ++ks) { const int k = 16 * ks + 8 * hh;
                { const f32x4 a0 = *(const f32x4*)(SLd + (size_t)r * 128 + k), a1 = *(const f32x4*)(SLd + (size_t)r * 128 + k + 4); t0 = MFMA32(pack8(a0[0], a0[1], a0[2], a0[3], a1[0], a1[1], a1[2], a1[3]), cf[ks], t0); }
                { const f32x4 a0 = *(const f32x4*)(SLd + (size_t)(32 + r) * 128 + k), a1 = *(const f32x4*)(SLd + (size_t)(32 + r) * 128 + k + 4); t1 = MFMA32(pack8(a0[0], a0[1], a0[2], a0[3], a1[0], a1[1], a1[2], a1[3]), cf[ks], t1); }
            }
            const float ed = __expf(dir == 0 ? cumf[l] : cumb[l]);
#pragma unroll
            for (int e = 0; e < 16; ++e) { y0[e] += t0[e] * ed; y1[e] += t1[e] * ed; }
        }
        const float cfl = cumf[l], cbl = cumb[l];
#pragma unroll 1
        for (int sb = 0; sb < 4; ++sb) {
            f32x16 X;
#pragma unroll
            for (int e = 0; e < 16; ++e) X[e] = 0.f;
#pragma unroll
            for (int ks = 0; ks < 8; ++ks) X = MFMA32(ldg8(BR + (size_t)(32 * sb + r) * 256 + 16 * ks + 8 * hh), cf[ks], X);
#pragma unroll
            for (int dir = 0; dir < 2; ++dir) {
                if (dir == 0 ? (sb > lb) : (sb < lb)) continue;
                LAS float* cum = dir == 0 ? cumf : cumb; LAS float* dtv = dir == 0 ? dtf : dtb; const float cl = dir == 0 ? cfl : cbl;
                float mv[16];
#pragma unroll
                for (int q = 0; q < 4; ++q) { const int sq = 32 * sb + 8 * q + 4 * hh; const f32x4 cs = *(LAS f32x4*)(cum + sq), ds = *(LAS f32x4*)(dtv + sq);
#pragma unroll
                    for (int i = 0; i < 4; ++i) { const int s = sq + i; const bool valid = dir == 0 ? (s <= l) : (s >= l);
                        mv[4 * q + i] = valid ? X[4 * q + i] * ds[i] * __expf(cl - cs[i]) : 0.f; } }
                const bf16x8 p0 = pack8(mv[0], mv[1], mv[2], mv[3], mv[4], mv[5], mv[6], mv[7]), p1 = pack8(mv[8], mv[9], mv[10], mv[11], mv[12], mv[13], mv[14], mv[15]);
#pragma unroll
                for (int s2 = 0; s2 < 2; ++s2) { const int ko = 32 * sb + 16 * s2 + 4 * hh;
                    { const u32x2 lo = *(const u32x2*)(XT + (size_t)r * 128 + ko), hi = *(const u32x2*)(XT + (size_t)r * 128 + ko + 8); u32x4 w = {lo.x, lo.y, hi.x, hi.y}; y0 = MFMA32(__builtin_bit_cast(bf16x8, w), s2 == 0 ? p0 : p1, y0); }
                    { const u32x2 lo = *(const u32x2*)(XT + (size_t)(32 + r) * 128 + ko), hi = *(const u32x2*)(XT + (size_t)(32 + r) * 128 + ko + 8); u32x4 w = {lo.x, lo.y, hi.x, hi.y}; y1 = MFMA32(__builtin_bit_cast(bf16x8, w), s2 == 0 ? p0 : p1, y1); }
                }
            }
        }
        const size_t tok = (size_t)cg * 128 + l;
        float ssq = 0.f;
#pragma unroll
        for (int ph = 0; ph < 2; ++ph)
#pragma unroll
            for (int k4 = 0; k4 < 4; ++k4) { const int p = 32 * ph + 8 * k4 + 4 * hh;
                const u32x2 zw = *(const u32x2*)(PROJ + tok * NPROJ + C_SZ + h * 64 + p);
                const f32x4 nwv = *(const f32x4*)(nw + p);
                float o[4];
#pragma unroll
                for (int i = 0; i < 4; ++i) { const float xv = bf2f(XT[(size_t)(p + i) * 128 + l]); const float yv = (ph == 0 ? y0[4 * k4 + i] : y1[4 * k4 + i]) + Dh * xv;
                    const float z = i == 0 ? bflo(zw.x) : (i == 1 ? bfhi(zw.x) : (i == 2 ? bflo(zw.y) : bfhi(zw.y)));
                    const float gz = yv * siluf_(z); ssq += gz * gz; o[i] = gz * nwv[i]; }
                u32x2 w; w.x = pk2(o[0], o[1]); w.y = pk2(o[2], o[3]); *(u32x2*)(YS + tok * 512 + h * 64 + p) = w; }
        ssq += __shfl_xor(ssq, 32);
        if (hh == 0) wsp<float>(c, WS_SSQ)[tok * 8 + h] = ssq;
    }
    __builtin_amdgcn_wave_barrier();
}
DI float gelu_tanh(float x) { const float u = 0.7978845608028654f * (x + 0.044715f * x * x * x); const float t = 1.0f - 2.0f / (__expf(2.0f * u) + 1.0f); return 0.5f * x * (1.0f + t); }
template <int PASS> DI void s5_gemm_unit(const Ctx& c, int unit) {
    const int g = unit / 9, rb = unit % 9;
    const int lane = c.lane, wave = c.wave, r = lane & 31, hh = lane >> 5;
    const int R = rb * 256 + wave * 32 + r;
    const bf16* PROJ = wsp<bf16>(c, WS_A);
    const bf16* Ua = PROJ + (size_t)R * 16 * NPROJ + C_SU + g * 16 + 8 * hh;
    float* QU = wsp<float>(c, WS_QU);
    const bf16* Wt = PASS == 1 ? wsp<bf16>(c, WS_QT) + (size_t)g * 256 * 256 : wsp<bf16>(c, WS_W3T) + (size_t)g * 256 * 512;
    constexpr int LDW = PASS == 1 ? 256 : 512;
    f32x16 acc[8];
#pragma unroll
    for (int ct = 0; ct < 8; ++ct)
#pragma unroll
        for (int e = 0; e < 16; ++e) acc[ct][e] = 0.f;
#pragma unroll 2
    for (int ks = 0; ks < 16; ++ks) {
        const bf16x8 af = ldg8(Ua + (size_t)ks * NPROJ);
#pragma unroll
        for (int ct = 0; ct < 8; ++ct) acc[ct] = MFMA32(af, ldg8(Wt + (size_t)(32 * ct + r) * LDW + 16 * ks + 8 * hh), acc[ct]);
    }
    if (PASS == 3) {
        const float* Sa = QU + ((size_t)R * 32 + g) * 256 + 8 * hh;
#pragma unroll 2
        for (int ks = 0; ks < 16; ++ks) {
            const f32x4 a0 = *(const f32x4*)(Sa + 16 * ks), a1 = *(const f32x4*)(Sa + 16 * ks + 4);
            const bf16x8 af = pack8(a0[0], a0[1], a0[2], a0[3], a1[0], a1[1], a1[2], a1[3]);
#pragma unroll
            for (int ct = 0; ct < 8; ++ct) acc[ct] = MFMA32(af, ldg8(Wt + (size_t)(32 * ct + r) * LDW + 256 + 16 * ks + 8 * hh), acc[ct]);
        }
        bf16* Y5G = wsp<bf16>(c, WS_Y5G);
#pragma unroll
        for (int ct = 0; ct < 8; ++ct)
#pragma unroll
            for (int e = 0; e < 16; ++e) { const int Ro = rb * 256 + wave * 32 + crow(e, hh); const int t = 2 * ct + (r >> 4), s = r & 15;
                Y5G[((size_t)Ro * 16 + t) * 512 + g * 16 + s] = f2bf(gelu_tanh(acc[ct][e])); }
    } else {
#pragma unroll
        for (int ct = 0; ct < 8; ++ct)
#pragma unroll
            for (int e = 0; e < 16; ++e) { const int Ro = rb * 256 + wave * 32 + crow(e, hh); QU[((size_t)Ro * 32 + g) * 256 + 32 * ct + r] = acc[ct][e]; }
    }
}
DI int s5_row_of(int b, int dir, int step) {
    if (dir == 0) return step < 16 ? 16 * b + step : 256 + 128 * b + (step - 16);
    return step < 16 ? 16 * b + (15 - step) : 256 + 128 * b + (127 - (step - 16));
}
DI void s5_scan(const Ctx& c, int gt) {
    const int n = gt & 63, dir = (gt >> 6) & 1, g = (gt >> 7) & 31, b = gt >> 12;
    float* QU = wsp<float>(c, WS_QU);
    const float* A16 = wsp<float>(c, WS_A16) + ((g * 2 + dir) * 64 + n) * 2;
    const float ar = A16[0], ai = A16[1];
    float sr = 0.f, si = 0.f;
#pragma unroll 1
    for (int s0 = 0; s0 < 144; s0 += 8) {
        float qr[8], qi[8];
#pragma unroll
        for (int k = 0; k < 8; ++k) { const size_t o = ((size_t)s5_row_of(b, dir, s0 + k) * 32 + g) * 256 + dir * 128 + n; qr[k] = QU[o]; qi[k] = QU[o + 64]; }
#pragma unroll
        for (int k = 0; k < 8; ++k) { const size_t o = ((size_t)s5_row_of(b, dir, s0 + k) * 32 + g) * 256 + dir * 128 + n; QU[o] = sr; QU[o + 64] = si;
            const float nr = ar * sr - ai * si + qr[k], ni = ar * si + ai * sr + qi[k]; sr = nr; si = ni; }
    }
}
DI void top2_of4(float a, float b, float cc, float d, float& m1, float& m2, int& i1, int& i2) {
    m1 = a; i1 = 0; if (b > m1) { m1 = b; i1 = 1; } if (cc > m1) { m1 = cc; i1 = 2; } if (d > m1) { m1 = d; i1 = 3; }
    m2 = -3.0e38f; i2 = 0;
    if (i1 != 0) { m2 = a; i2 = 0; }
    if (i1 != 1 && b > m2) { m2 = b; i2 = 1; }
    if (i1 != 2 && cc > m2) { m2 = cc; i2 = 2; }
    if (i1 != 3 && d > m2) { m2 = d; i2 = 3; }
}
DI void row_phase_mid(const Ctx& c, int layer) {
    LAS float* rwT = (LAS float*)c.lds;
    for (int i = c.tid; i < 1024 * 8; i += 512) { const int d = i >> 3, e4 = (i & 7) * 4; const f32x4 v = *(const f32x4*)(c.A->in[I_RW] + d * 32 + e4);
        rwT[(e4 + 0) * 1024 + d] = v[0]; rwT[(e4 + 1) * 1024 + d] = v[1]; rwT[(e4 + 2) * 1024 + d] = v[2]; rwT[(e4 + 3) * 1024 + d] = v[3]; }
    __syncthreads();
    const float* MOD = wsp<float>(c, WS_MOD); const int lane = c.lane;
    const float* g1 = c.A->in[I_LN1G] + layer * 1024; const float* b1 = c.A->in[I_LN1B] + layer * 1024;
    unsigned* cnt = wsp<unsigned>(c, WS_CTL) + CW_CNT + layer * 32;
    for (int row = c.bid * 8 + c.wave; row < MT; row += c.G * 8) {
        const float* md = MOD + ((size_t)layer * 17 + row_modidx(row)) * 6144;
        float* xr = wsp<float>(c, WS_XRES) + (size_t)row * 1024;
        f32x4 x[4], mx[4], h[4];
        row_load(xr, lane, x); row_load(wsp<float>(c, WS_B) + (size_t)row * 1024, lane, mx);
#pragma unroll
        for (int i = 0; i < 4; ++i) { const f32x4 gt = *(const f32x4*)(md + 2048 + lane * 4 + 256 * i); x[i] = x[i] * ALPHA + gt * mx[i]; }
        row_ln(x);
#pragma unroll
        for (int i = 0; i < 4; ++i) { const f32x4 gg = *(const f32x4*)(g1 + lane * 4 + 256 * i), bb = *(const f32x4*)(b1 + lane * 4 + 256 * i); x[i] = x[i] * gg + bb; }
        row_store(xr, lane, x);
        row_modulate(x, md + 4096, md + 3072, lane, h);
        row_store_bf16(wsp<bf16>(c, WS_H) + (size_t)row * 1024, lane, h);
        LAS float* lgs = (LAS float*)(c.lds + LDS_MISC + 2048) + c.wave * 32;
#pragma unroll 2
        for (int e = 0; e < 32; ++e) { float a = 0.f;
#pragma unroll
            for (int i = 0; i < 4; ++i) { const f32x4 w = *(LAS f32x4*)(rwT + e * 1024 + lane * 4 + 256 * i); a += (h[i][0] * w[0] + h[i][1] * w[1]) + (h[i][2] * w[2] + h[i][3] * w[3]); }
            a = wave_sum(a); if (lane == 0) lgs[e] = 1.0f / (1.0f + expf(-a)); }
        __builtin_amdgcn_wave_barrier();
        float best = -3.0e38f; int be0 = 0, be1 = 0; float bw0 = 0.f, bw1 = 0.f;
#pragma unroll 1
        for (int gI = 0; gI < 8; ++gI) {
            const f32x4 scv = *(LAS f32x4*)(lgs + gI * 4); const f32x4 rbv = *(const f32x4*)(c.A->in[I_RB] + gI * 4);
            float m1, m2; int i1, i2; top2_of4(scv[0] + rbv[0], scv[1] + rbv[1], scv[2] + rbv[2], scv[3] + rbv[3], m1, m2, i1, i2);
            const float gs = m1 + m2;
            if (gs > best) { best = gs; be0 = gI * 4 + i1; be1 = gI * 4 + i2;
                bw0 = i1 == 0 ? scv[0] : (i1 == 1 ? scv[1] : (i1 == 2 ? scv[2] : scv[3]));
                bw1 = i2 == 0 ? scv[0] : (i2 == 1 ? scv[1] : (i2 == 2 ? scv[2] : scv[3])); }
        }
        __builtin_amdgcn_wave_barrier();
        if (lane == 0) { const float ws = bw0 + bw1; const unsigned p0 = atomicAdd(cnt + be0, 1u), p1 = atomicAdd(cnt + be1, 1u);
            int* ti = wsp<int>(c, WS_TOKI) + (size_t)row * 4; ti[0] = be0; ti[1] = be1; ti[2] = (int)p0; ti[3] = (int)p1;
            float* tw = wsp<float>(c, WS_TOKW) + (size_t)row * 2; tw[0] = bw0 / ws; tw[1] = bw1 / ws; }
    }
    __syncthreads();
}
DI int moe_tables(const Ctx& c, int layer, LAS int* start, LAS int* blk_e) {
    if (c.tid == 0) { const unsigned* cnt = wsp<unsigned>(c, WS_CTL) + CW_CNT + layer * 32; int nb = 0;
        for (int e = 0; e < 32; ++e) { const int cn = (int)__hip_atomic_load(cnt + e, __ATOMIC_RELAXED, __HIP_MEMORY_SCOPE_AGENT); const int k = (cn + 255) >> 8; start[e] = nb * 256; for (int q = 0; q < k; ++q) blk_e[nb + q] = e; nb += k; }
        start[32] = nb; }
    __syncthreads();
    return __builtin_amdgcn_readfirstlane(start[32]);
}
DI void moe_gather(const Ctx& c, int layer) {
    LAS int* start = (LAS int*)(c.lds + LDS_MISC + 64); LAS int* blk_e = start + 64;
    moe_tables(c, layer, start, blk_e);
    const bf16* H = wsp<bf16>(c, WS_H); bf16* XS = wsp<bf16>(c, WS_A);
    for (int row = c.bid * 8 + c.wave; row < MT; row += c.G * 8) {
        const int* ti = wsp<int>(c, WS_TOKI) + (size_t)row * 4;
        const int s0 = start[ti[0]] + ti[2], s1 = start[ti[1]] + ti[3];
        const u32x4 a = *(const u32x4*)(H + (size_t)row * 1024 + c.lane * 8), b = *(const u32x4*)(H + (size_t)row * 1024 + 512 + c.lane * 8);
        *(u32x4*)(XS + (size_t)s0 * 1024 + c.lane * 8) = a; *(u32x4*)(XS + (size_t)s0 * 1024 + 512 + c.lane * 8) = b;
        *(u32x4*)(XS + (size_t)s1 * 1024 + c.lane * 8) = a; *(u32x4*)(XS + (size_t)s1 * 1024 + 512 + c.lane * 8) = b;
        if (c.lane == 0) { int* sl = wsp<int>(c, WS_TOKW + 512 * 1024) + (size_t)row * 2; sl[0] = s0; sl[1] = s1; }
    }
    __syncthreads();
}
DI void row_phase_last(const Ctx& c, int layer) {
    const float* MOD = wsp<float>(c, WS_MOD); const int lane = c.lane;
    const float* g2 = c.A->in[I_LN2G] + layer * 1024; const float* b2 = c.A->in[I_LN2B] + layer * 1024;
    const bf16* YE = wsp<bf16>(c, WS_A);
    for (int row = c.bid * 8 + c.wave; row < MT; row += c.G * 8) {
        const float* md = MOD + ((size_t)layer * 17 + row_modidx(row)) * 6144;
        float* xr = wsp<float>(c, WS_XRES) + (size_t)row * 1024;
        const int* sl = wsp<int>(c, WS_TOKW + 512 * 1024) + (size_t)row * 2; const float* tw = wsp<float>(c, WS_TOKW) + (size_t)row * 2;
        const int s0 = sl[0], s1 = sl[1]; const float w0 = tw[0], w1 = tw[1];
        f32x4 x[4], h[4]; row_load(xr, lane, x);
#pragma unroll
        for (int i = 0; i < 4; ++i) { const u32x2 a = *(const u32x2*)(YE + (size_t)s0 * 1024 + lane * 4 + 256 * i), b = *(const u32x2*)(YE + (size_t)s1 * 1024 + lane * 4 + 256 * i);
            f32x4 f; f[0] = w0 * bflo(a.x) + w1 * bflo(b.x); f[1] = w0 * bfhi(a.x) + w1 * bfhi(b.x); f[2] = w0 * bflo(a.y) + w1 * bflo(b.y); f[3] = w0 * bfhi(a.y) + w1 * bfhi(b.y);
            const f32x4 gt = *(const f32x4*)(md + 5120 + lane * 4 + 256 * i); x[i] = x[i] * ALPHA + gt * f; }
        row_ln(x);
#pragma unroll
        for (int i = 0; i < 4; ++i) { const f32x4 gg = *(const f32x4*)(g2 + lane * 4 + 256 * i), bb = *(const f32x4*)(b2 + lane * 4 + 256 * i); x[i] = x[i] * gg + bb; }
        if (layer < DEPTH - 1) {
            row_store(xr, lane, x);
            const float* mdn = MOD + ((size_t)(layer + 1) * 17 + row_modidx(row)) * 6144;
            row_modulate(x, mdn + 1024, mdn, lane, h);
            row_store_bf16(wsp<bf16>(c, WS_H) + (size_t)row * 1024, lane, h);
        } else if (row >= MC) row_store(c.A->out + (size_t)(row - MC) * 1024, lane, x);
    }
}
constexpr int NPH = 13;
constexpr int NGP = 2 + DEPTH * NPH;

#ifndef ONLY_PHASE
#define ONLY_PHASE -9
#endif
#define PH_EN(p) (ONLY_PHASE == -9 || ONLY_PHASE == (p))
#define RUN(gp) (lo <= (gp) && (gp) < hi)
#define FRESH() Ctx c = c0; { int t_ = c0.wave * 64 + (int)__builtin_amdgcn_mbcnt_hi(~0u, __builtin_amdgcn_mbcnt_lo(~0u, 0u)); asm volatile("" : "+v"(t_)); const CAS Args* a_ = c0.A; asm volatile("" : "+s"(a_)); c.A = a_; c.tid = t_; c.lane = t_ & 63; c.wave = __builtin_amdgcn_readfirstlane(t_ >> 6); }
#if MK_SPLIT
struct BarT { int dummy; };
#define GRID_BAR() do { } while (0)
#else
typedef XcdBarrier BarT;
#define GRID_BAR() xcd_barrier(bar)
#endif
#define SEAM(gp) do { if ((gp) + 1 < hi) GRID_BAR(); } while (0)
template <int layer> DI void layer_phases(const Ctx& c0, const int lo, const int hi, const BarT& bar) {
        const int gp0 = 2 + layer * NPH;
        if (PH_EN(0) && RUN(gp0 + 0)) { FRESH();
            pg8::Gemm g{wsp<bf16>(c, WS_H), wsp<bf16>(c, WS_WINT), MT, NPROJ, 1024}; pg8::StaticOrder S; S.init(MT, NPROJ, c.G, c.bid);
            pg8::EpiStoreBf16<0> E{wsp<bf16>(c, WS_A), NPROJ, 1 << 30};
            pg8::gemm_phase<pg8::EpiStoreBf16<0>, pg8::StaticOrder>(c.lds, g, S, E, nullptr, c.tid);
            SEAM(gp0 + 0);
        }
        if (PH_EN(1) && RUN(gp0 + 1)) { FRESH();
            for (int u = c.bid; u < MT / 64; u += c.G) prep_unit(c, layer, u);
            __syncthreads();
            for (int u = c.bid; u < 288; u += c.G) s5_gemm_unit<1>(c, u);
            SEAM(gp0 + 1);
        }
        if (PH_EN(2) && RUN(gp0 + 2)) { FRESH();
            for (int u = c.bid; u < 1024; u += c.G) attn_global_unit(c, u);
            for (int u = c.bid; u < 1024; u += c.G) attn_window_unit(c, layer, u);
            for (int u = c.bid; u < 256; u += c.G) attn_ctx_unit(c, layer, u);
            __syncthreads();
            for (int u = c.bid; u < 576; u += c.G) ssd_states_unit(c, layer, u);
            { const int gt = ((c.bid + c.G / 2) % c.G) * 512 + c.tid; if (gt < 65536) s5_scan(c, gt); }
            SEAM(gp0 + 2);
        }
        if (PH_EN(3) && RUN(gp0 + 3)) { FRESH();
            ssd_recur(c, c.bid * 512 + c.tid, c.G * 512);
            for (int u = c.bid; u < 288; u += c.G) s5_gemm_unit<3>(c, u);
            SEAM(gp0 + 3);
        }
        if (PH_EN(4) && RUN(gp0 + 4)) { FRESH();
            for (int u = c.bid; u < 576; u += c.G) ssd_out_unit(c, layer, u);
            __syncthreads();
            pg8::Gemm g{wsp<bf16>(c, WS_Y5G), wsp<bf16>(c, WS_WGLUT), MT, 1024, 512}; pg8::StaticOrder S; S.init(MT, 1024, c.G, c.bid);
            pg8::EpiPair<1> E{wsp<bf16>(c, WS_B) + (size_t)3 * MT * 512};
            pg8::gemm_phase<pg8::EpiPair<1>, pg8::StaticOrder>(c.lds, g, S, E, nullptr, c.tid);
            SEAM(gp0 + 4);
        }
        if (PH_EN(5) && RUN(gp0 + 5)) { FRESH();
            pg8::Gemm g{wsp<bf16>(c, WS_H), wsp<bf16>(c, WS_WGT), MT, NGATE, 1024}; pg8::StaticOrder S; S.init(MT, NGATE, c.G, c.bid);
            pg8::EpiStoreBf16<1> E{wsp<bf16>(c, WS_A), NGATE, 1 << 30};
            pg8::gemm_phase<pg8::EpiStoreBf16<1>, pg8::StaticOrder>(c.lds, g, S, E, nullptr, c.tid);
            SEAM(gp0 + 5);
        }
        if (PH_EN(6) && RUN(gp0 + 6)) { FRESH();
            pg8::Gemm g{wsp<bf16>(c, WS_B), wsp<bf16>(c, WS_WBT), 4 * MT, 4096, 512}; pg8::MergeOrder S{c.G, c.bid, (MT / 256) * 4, MT / 256};
            pg8::EpiMerge E{wsp<bf16>(c, WS_A), wsp<float>(c, WS_D), wsp<bf16>(c, WS_H), wsp<float>(c, WS_SSQ), MT / 256};
            pg8::gemm_phase<pg8::EpiMerge, pg8::MergeOrder>(c.lds, g, S, E, nullptr, c.tid);
            SEAM(gp0 + 6);
        }
        if (PH_EN(7) && RUN(gp0 + 7)) { FRESH();
            pg8::Gemm g{wsp<bf16>(c, WS_H), wsp<bf16>(c, WS_WOT), MT, 1024, 1024}; pg8::StaticOrder S; S.init(MT, 1024, c.G, c.bid);
            pg8::EpiF32 E{wsp<float>(c, WS_B), 1024};
            pg8::gemm_phase<pg8::EpiF32, pg8::StaticOrder>(c.lds, g, S, E, nullptr, c.tid);
            SEAM(gp0 + 7);
        }
        if (PH_EN(8) && RUN(gp0 + 8)) { FRESH(); row_phase_mid(c, layer); SEAM(gp0 + 8); }
        if (PH_EN(9) && RUN(gp0 + 9)) { FRESH();
            moe_gather(c, layer);
            for (int t = c.bid; t < WMOE_TILES; t += c.G) wmoe_tile(c, layer, t);
            SEAM(gp0 + 9);
        }
        if (PH_EN(10) && RUN(gp0 + 10)) { FRESH();
            LAS int* start = (LAS int*)(c.lds + LDS_MISC + 64); LAS int* blk_e = start + 64;
            const int nb = moe_tables(c, layer, start, blk_e);
            pg8::Gemm g{wsp<bf16>(c, WS_A), wsp<bf16>(c, WS_B), MOE_MAXSLOT, 32 * 1024, 1024}; pg8::MoeOrder S{c.G, c.bid, nb * 4, blk_e};
            pg8::EpiPair<0> E{wsp<bf16>(c, WS_A_HID)};
            pg8::gemm_phase<pg8::EpiPair<0>, pg8::MoeOrder>(c.lds, g, S, E, nullptr, c.tid);
            SEAM(gp0 + 10);
        }
        if (PH_EN(11) && RUN(gp0 + 11)) { FRESH();
            LAS int* start = (LAS int*)(c.lds + LDS_MISC + 64); LAS int* blk_e = start + 64;
            const int nb = moe_tables(c, layer, start, blk_e);
            pg8::Gemm g{wsp<bf16>(c, WS_A_HID), wsp<bf16>(c, WS_B_MOED), MOE_MAXSLOT, 32 * 1024, 512}; pg8::MoeOrder S{c.G, c.bid, nb * 4, blk_e};
            pg8::EpiStoreBf16<0> E{wsp<bf16>(c, WS_A), 1024, 1024};
            pg8::gemm_phase<pg8::EpiStoreBf16<0>, pg8::MoeOrder>(c.lds, g, S, E, nullptr, c.tid);
            SEAM(gp0 + 11);
        }
        if (PH_EN(12) && RUN(gp0 + 12)) { FRESH();
            row_phase_last(c, layer);
            if (layer + 1 < DEPTH) {
                __syncthreads();
                for (int u = c.bid; u < 32; u += c.G) s5mat_unit(c, layer + 1, u);
                for (int t = c.bid; t < WSMALL_TILES; t += c.G) wsmall_tile(c, layer + 1, t);
            }
            SEAM(gp0 + 12);
        }
    }

__global__ void __launch_bounds__(512, 2) mk_fwd(Args args) {
    extern __shared__ __attribute__((aligned(16))) unsigned char lds_raw[];
    Ctx c0;
    c0.A = (const CAS Args*)__builtin_amdgcn_kernarg_segment_ptr();
    c0.lds = (LAS unsigned char*)lds_raw;
    c0.wave = __builtin_amdgcn_readfirstlane((int)threadIdx.x >> 6); c0.tid = 0; c0.lane = 0; c0.G = gridDim.x; c0.bid = blockIdx.x;
    const int tid0 = threadIdx.x;
    const int lo = args.ph_lo, hi = args.ph_hi;
    volatile LAS unsigned* misc = (volatile LAS unsigned*)(c0.lds + LDS_MISC);
    if (tid0 < 4) misc[tid0] = 0u;
    __syncthreads();
#if MK_SPLIT
    BarT bar; bar.dummy = 0;
#else
    BarT bar = xcd_barrier_post(wsp<unsigned>(c0, WS_CTL) + CW_BAR, misc);
#endif
    if (PH_EN(-2) && RUN(0)) { FRESH();
        for (int u = c.bid; u < 192; u += c.G) mod_unit(c, u);
        for (int u = c.bid; u < 32; u += c.G) s5mat_unit(c, 0, u);
        for (int t = c.bid; t < WSMALL_TILES; t += c.G) wsmall_tile(c, 0, t);
        SEAM(0);
    }
    if (PH_EN(-1) && RUN(1)) { FRESH(); row_phase_first(c); SEAM(1); }

    layer_phases<0>(c0, lo, hi, bar);
    layer_phases<1>(c0, lo, hi, bar);
    layer_phases<2>(c0, lo, hi, bar);
    layer_phases<3>(c0, lo, hi, bar);
#undef RUN
#undef SEAM
#undef GRID_BAR
}

extern "C" void kernel_launch(void* const* d_in, const int* in_sizes, int n_in, void* d_out, int out_size, void* d_ws, size_t ws_size, hipStream_t stream) {
    static int grid = 0;
    if (grid == 0) {
        if (n_in != N_IN || out_size != ML * DM || ws_size < WS_END) { fprintf(stderr, "kernel_launch: unexpected problem (n_in %d, out %d, ws %zu < %zu)\n", n_in, out_size, ws_size, (size_t)WS_END); grid = -1; return; }
        int dev = 0, cus = 0, per_cu = 0;
        if (hipGetDevice(&dev) != hipSuccess || hipDeviceGetAttribute(&cus, hipDeviceAttributeMultiprocessorCount, dev) != hipSuccess) { grid = -1; return; }
        if (hipFuncSetAttribute((const void*)mk_fwd, hipFuncAttributeMaxDynamicSharedMemorySize, LDS_BYTES) != hipSuccess) { fprintf(stderr, "kernel_launch: hipFuncSetAttribute failed\n"); grid = -1; return; }
        if (hipOccupancyMaxActiveBlocksPerMultiprocessor(&per_cu, (const void*)mk_fwd, 512, LDS_BYTES) != hipSuccess || per_cu < 1) { fprintf(stderr, "kernel_launch: occupancy query says %d\n", per_cu); }
        (void)hipGetLastError();
        grid = cus;
    }
    if (grid < 0) return;
    (void)hipMemsetAsync((char*)d_ws + WS_CTL, 0, CTL_ZERO_BYTES, stream);
    Args a{};
    for (int i = 0; i < N_IN; ++i) a.in[i] = (const float*)d_in[i];
    a.out = (float*)d_out; a.ws = (unsigned char*)d_ws;
#if MK_SPLIT
    for (int gp = 0; gp < NGP; ++gp) { a.ph_lo = gp; a.ph_hi = gp + 1; hipLaunchKernelGGL(mk_fwd, dim3(grid), dim3(512), LDS_BYTES, stream, a); }
#else
    a.ph_lo = 0; a.ph_hi = NGP; hipLaunchKernelGGL(mk_fwd, dim3(grid), dim3(512), LDS_BYTES, stream, a);
#endif
}
```

```cpp
#include <hip/hip_runtime.h>
#include <cstdio>
#include <cstdint>

#ifndef MK_SPLIT
#define MK_SPLIT 0
#endif

#define DI __device__ __forceinline__
typedef unsigned short bf16;
typedef short bf16x8 __attribute__((ext_vector_type(8)));
typedef float f32x4 __attribute__((ext_vector_type(4)));
typedef float f32x2 __attribute__((ext_vector_type(2)));
typedef float f32x16 __attribute__((ext_vector_type(16)));
typedef unsigned u32x4 __attribute__((ext_vector_type(4)));
typedef unsigned u32x2 __attribute__((ext_vector_type(2)));
typedef __bf16 bf16x2_t __attribute__((ext_vector_type(2)));

DI unsigned pk2(float a, float b) { f32x2 v = {a, b}; bf16x2_t r = __builtin_convertvector(v, bf16x2_t); return __builtin_bit_cast(unsigned, r); }
DI bf16 f2bf(float a) { return (bf16)(pk2(a, 0.f) & 0xffffu); }
DI float bf2f(bf16 b) { return __uint_as_float(((unsigned)b) << 16); }
DI float bflo(unsigned u) { return __uint_as_float(u << 16); }
DI float bfhi(unsigned u) { return __uint_as_float(u & 0xffff0000u); }
DI float frcp(float x) { return __builtin_amdgcn_rcpf(x); }
DI float sigmoidf_(float x) { return frcp(1.0f + __expf(-x)); }
DI float siluf_(float x) { return x * frcp(1.0f + __expf(-x)); }
DI int crow(int reg, int h) { return (reg & 3) + 8 * (reg >> 2) + 4 * h; }
#define MFMA32(a, b, c) __builtin_amdgcn_mfma_f32_32x32x16_bf16((a), (b), (c), 0, 0, 0)
DI bf16x8 pack8(float a0, float a1, float a2, float a3, float a4, float a5, float a6, float a7) {
    u32x4 p; p.x = pk2(a0, a1); p.y = pk2(a2, a3); p.z = pk2(a4, a5); p.w = pk2(a6, a7); return __builtin_bit_cast(bf16x8, p);
}
DI float wave_sum(float v) {
    v += __int_as_float(__builtin_amdgcn_update_dpp(0, __float_as_int(v), 0xB1, 0xf, 0xf, true));
    v += __int_as_float(__builtin_amdgcn_update_dpp(0, __float_as_int(v), 0x4E, 0xf, 0xf, true));
    v += __int_as_float(__builtin_amdgcn_update_dpp(0, __float_as_int(v), 0x141, 0xf, 0xf, true));
    v += __int_as_float(__builtin_amdgcn_update_dpp(0, __float_as_int(v), 0x140, 0xf, 0xf, true));
    const float r0 = __int_as_float(__builtin_amdgcn_readlane(__float_as_int(v), 0)), r1 = __int_as_float(__builtin_amdgcn_readlane(__float_as_int(v), 16));
    const float r2 = __int_as_float(__builtin_amdgcn_readlane(__float_as_int(v), 32)), r3 = __int_as_float(__builtin_amdgcn_readlane(__float_as_int(v), 48));
    return (r0 + r1) + (r2 + r3);
}
#define XB_TMO      128
#define XB_XCNT(j)  (256  + 64 * (j))
#define XB_XSUB(j)  (1280 + 64 * (j))
#define XB_XGEN(j)  (2304 + 64 * (j))
#define XB_TOP      3328
#define XB_TOPGEN   3392
#define XCD_BAR_WORDS 3456
#define XB_SPIN_CAP (1u << 18)
#define LAS __attribute__((address_space(3)))

__device__ __forceinline__ unsigned xb_ld(unsigned* p)              { return __hip_atomic_load(p, __ATOMIC_RELAXED, __HIP_MEMORY_SCOPE_AGENT); }
__device__ __forceinline__ unsigned xb_add(unsigned* p, unsigned v) { return __hip_atomic_fetch_add(p, v, __ATOMIC_RELAXED, __HIP_MEMORY_SCOPE_AGENT); }
__device__ __forceinline__ unsigned xb_xcc_id() { return (unsigned)__builtin_amdgcn_s_getreg((3 << 11) | 20) & 0xFu; }
#define XB_SPIN(cond, bar) do { unsigned _sp = 0; while (cond) { __builtin_amdgcn_s_sleep(1); \
    if ((++_sp & 255u) == 0u) { if (xb_ld(&(bar)[XB_TMO])) break; if (_sp > XB_SPIN_CAP) { atomicAdd(&(bar)[XB_TMO], 1u); break; } } } } while (0)

struct XcdBarrier {
    unsigned* bar; unsigned x;
    volatile LAS unsigned* st;
};

__device__ __forceinline__ XcdBarrier xcd_barrier_post(unsigned* bar, volatile LAS unsigned* st) {
    XcdBarrier b; b.bar = bar; b.x = xb_xcc_id(); b.st = st;
    if (threadIdx.x == 0) (void)xb_add(&bar[XB_XCNT(b.x)], 1u);
    return b;
}
__device__ __forceinline__ void xcd_barrier_complete(unsigned* bar, unsigned x, unsigned& nloc, unsigned& nx) {
    const unsigned G = gridDim.x * gridDim.y * gridDim.z;
    unsigned sum, cnt, mine, sp = 0u;
    for (;;) {
        sum = 0u; cnt = 0u; mine = 0u;
#pragma unroll
        for (unsigned j = 0; j < 16; ++j) { const unsigned c = xb_ld(&bar[XB_XCNT(j)]); sum += c; cnt += (c > 0u) ? 1u : 0u; mine = (j == x) ? c : mine; }
        if (sum == G) break;
        __builtin_amdgcn_s_sleep(1);
        if ((++sp & 255u) == 0u) { if (xb_ld(&bar[XB_TMO])) break; if (sp > XB_SPIN_CAP) { atomicAdd(&bar[XB_TMO], 1u); break; } }
    }
    nloc = mine > 0u ? mine : 1u; nx = cnt > 0u ? cnt : 1u;
}

__device__ __forceinline__ void xcd_barrier(const XcdBarrier& b) {
    asm volatile("s_waitcnt vmcnt(0)" ::: "memory");
    __syncthreads();
    if (threadIdx.x == 0) {
        unsigned* bar = b.bar;
        __builtin_amdgcn_s_waitcnt(0);
        unsigned nloc = b.st[0], nx = b.st[1];
        if (nloc == 0u) { xcd_barrier_complete(bar, b.x, nloc, nx); b.st[0] = nloc; b.st[1] = nx; }
        const unsigned old = xb_add(&bar[XB_XSUB(b.x)], 1u);
        const unsigned gen = old / nloc;
        if (old + 1u == (gen + 1u) * nloc) {
            __builtin_amdgcn_fence(__ATOMIC_RELEASE, "agent");
            asm volatile("s_waitcnt vmcnt(0)" ::: "memory");
            const unsigned og = xb_add(&bar[XB_TOP], 1u);
            const unsigned tg = og / nx;
            if (og + 1u == (tg + 1u) * nx) xb_add(&bar[XB_TOPGEN], 1u);
            else XB_SPIN(xb_ld(&bar[XB_TOPGEN]) == tg, bar);
            __builtin_amdgcn_fence(__ATOMIC_ACQUIRE, "agent");
            xb_add(&bar[XB_XGEN(b.x)], 1u);
            asm volatile("s_waitcnt vmcnt(0)" ::: "memory");
        } else {
            XB_SPIN(xb_ld(&bar[XB_XGEN(b.x)]) == gen, bar);
            __builtin_amdgcn_fence(__ATOMIC_ACQUIRE, "agent");
            asm volatile("s_waitcnt vmcnt(0)" ::: "memory");
        }
    }
    __syncthreads();
}
namespace pg8 {
#define PG8_LAS __attribute__((address_space(3)))
typedef unsigned short bf16_t;
typedef short bf16x8 __attribute__((ext_vector_type(8)));
typedef float f32x4 __attribute__((ext_vector_type(4)));
typedef unsigned u32x4 __attribute__((ext_vector_type(4)));
constexpr int BM = 256, BK = 64, HALF = 128, HTB = HALF * BK * 2  , STAGE_BYTES = 8 * HTB, NXCD = 8, WGM = 8;

__host__ __device__ __forceinline__ int lds_byte(int r, int c) { const int st = (r >> 4) * 2 + (c >> 5), rr = r & 15, cc = c & 31, ob = rr * 64 + cc * 2; return st * 1024 + (ob ^ (((ob >> 9) & 1) << 5)); }
__host__ __device__ __forceinline__ void stage_rc(int b, int& R, int& C) { const int st = b / 1024, sb = b % 1024, swz = sb ^ (((sb >> 9) & 1) << 5); R = (st >> 1) * 16 + swz / 64; C = (st & 1) * 32 + (swz % 64) / 2; }
__host__ __device__ __forceinline__ int perm32(int rho) { const int n = rho >> 4, i = rho & 15; return 8 * (i >> 2) + 4 * n + (i & 3); }

struct Unit { int pm, pn; };
struct Gemm { const bf16_t* A; const bf16_t* Bt; int M, N, K; };

struct StaticOrder {
    int nM, nN, nwg, G, c;
    __host__ __device__ void init(int M, int N, int G_, int c_) { nM = M / BM; nN = N / BM; nwg = nM * nN; G = G_; c = c_; }
    __host__ __device__ bool next(int i, Unit& u) const {
        const long L = (long)i * G + c; if (L >= nwg) return false;
        int wgid = (int)L; { const int q = nwg / NXCD, r = nwg % NXCD, xcd = wgid % NXCD, off = wgid / NXCD; wgid = (xcd < r ? xcd * (q + 1) : r * (q + 1) + (xcd - r) * q) + off; }
        const int nig = WGM * nN, gid = wgid / nig, fm = gid * WGM, gsz = (nM - fm) < WGM ? (nM - fm) : WGM;
        u.pm = fm + ((wgid % nig) % gsz); u.pn = (wgid % nig) / gsz; return true;
    }
    __device__ __forceinline__ void a_ready(const Unit&) const {}
    __device__ __forceinline__ void done(const Unit&) const {}
};
template <int ACT> struct EpiStoreBf16 {
    static constexpr bool PERM = true, AFTER_DRAIN = false;
    bf16_t* O; int ldc; int colwrap;
    __device__ __forceinline__ void operator()(const f32x4 (&acc)[2][2][4][2], const Unit& u, int wr, int wc, int fr, int fq) const {
        const int row0 = u.pm * BM + wr * 64 + fr; const int colt = (u.pn * BM) % colwrap;
        const int col0 = colt + wc * 32 + 8 * fq;
#pragma unroll
        for (int ai = 0; ai < 2; ++ai)
#pragma unroll
            for (int m = 0; m < 4; ++m) { bf16_t* rowp = O + (size_t)(row0 + ai * HALF + m * 16) * ldc + col0;
#pragma unroll
                for (int bj = 0; bj < 2; ++bj) { f32x4 v0 = acc[ai][bj][m][0], v1 = acc[ai][bj][m][1];
                    if (ACT == 1) {
#pragma unroll
                        for (int j = 0; j < 4; ++j) { v0[j] = frcp(1.0f + __expf(-v0[j])); v1[j] = frcp(1.0f + __expf(-v1[j])); } }
                    u32x4 w; w.x = pk2(v0[0], v0[1]); w.y = pk2(v0[2], v0[3]); w.z = pk2(v1[0], v1[1]); w.w = pk2(v1[2], v1[3]);
                    *(u32x4*)(rowp + bj * HALF) = w; } }
    }
};
struct EpiProj {
    static constexpr bool PERM = true, AFTER_DRAIN = false;
    bf16_t* O; int ldc; bf16_t* UF; int su_tile0;
    __device__ __forceinline__ void operator()(const f32x4 (&acc)[2][2][4][2], const Unit& u, int wr, int wc, int fr, int fq) const {
        const int row0 = u.pm * BM + wr * 64 + fr; const int col0 = u.pn * BM + wc * 32 + 8 * fq;
        const bool su = (u.pn == su_tile0) || (u.pn == su_tile0 + 1);
#pragma unroll
        for (int ai = 0; ai < 2; ++ai)
#pragma unroll
            for (int m = 0; m < 4; ++m) { const int row = row0 + ai * HALF + m * 16;
#pragma unroll
                for (int bj = 0; bj < 2; ++bj) { const f32x4 v0 = acc[ai][bj][m][0], v1 = acc[ai][bj][m][1];
                    u32x4 w; w.x = pk2(v0[0], v0[1]); w.y = pk2(v0[2], v0[3]); w.z = pk2(v1[0], v1[1]); w.w = pk2(v1[2], v1[3]);
                    if (su) { const int cs = col0 + bj * HALF - su_tile0 * BM; const int g = cs >> 4, hh = (cs >> 3) & 1; const int R = row >> 4;
                        *(u32x4*)(UF + ((size_t)((g * 72 + (R >> 5)) * 16 + (row & 15)) * 64 + hh * 32 + (R & 31)) * 8) = w; }
                    else *(u32x4*)(O + (size_t)row * ldc + col0 + bj * HALF) = w; } }
    }
};
template <int ACT> struct EpiPair {
    static constexpr bool PERM = true, AFTER_DRAIN = false;
    bf16_t* O;
    __device__ __forceinline__ void operator()(const f32x4 (&acc)[2][2][4][2], const Unit& u, int wr, int wc, int fr, int fq) const {
        const int row0 = u.pm * BM + wr * 64 + fr; const int col0 = (u.pn & 3) * 128 + wc * 32 + 8 * fq;
#pragma unroll
        for (int ai = 0; ai < 2; ++ai)
#pragma unroll
            for (int m = 0; m < 4; ++m) { bf16_t* rowp = O + (size_t)(row0 + ai * HALF + m * 16) * 512 + col0;
                float o[8];
#pragma unroll
                for (int n = 0; n < 2; ++n)
#pragma unroll
                    for (int j = 0; j < 4; ++j) { const float a = acc[ai][0][m][n][j], b = acc[ai][1][m][n][j];
                        o[n * 4 + j] = (ACT == 0) ? (a * frcp(1.0f + __expf(-a))) * b : a * frcp(1.0f + __expf(-b)); }
                u32x4 w; w.x = pk2(o[0], o[1]); w.y = pk2(o[2], o[3]); w.z = pk2(o[4], o[5]); w.w = pk2(o[6], o[7]);
                *(u32x4*)rowp = w; }
    }
};
struct EpiF32 {
    static constexpr bool PERM = false, AFTER_DRAIN = false;
    float* C; int ldc;
    __device__ __forceinline__ void operator()(const f32x4 (&acc)[2][2][4][2], const Unit& u, int wr, int wc, int fr, int fq) const {
        const int row0 = u.pm * BM + wr * 64 + fr, col0 = u.pn * BM + wc * 32 + 4 * fq;
#pragma unroll
        for (int ai = 0; ai < 2; ++ai)
#pragma unroll
            for (int m = 0; m < 4; ++m) { float* rowp = C + (size_t)(row0 + ai * HALF + m * 16) * ldc + col0;
#pragma unroll
                for (int bj = 0; bj < 2; ++bj)
#pragma unroll
                    for (int n = 0; n < 2; ++n) *(f32x4*)(rowp + bj * HALF + n * 16) = acc[ai][bj][m][n]; }
    }
};
struct EpiMerge {
    static constexpr bool PERM = true, AFTER_DRAIN = false;
    bf16_t* MB;
    const float* SSQ;
    int MT;
    __device__ __forceinline__ void operator()(const f32x4 (&acc)[2][2][4][2], const Unit& u, int wr, int wc, int fr, int fq) const {
        const int nb = u.pn >> 2, pn = u.pn & 3, pm = u.pm - nb * MT;
        const int row0 = pm * BM + wr * 64 + fr, col0 = nb * 1024 + pn * BM + wc * 32 + 8 * fq;
        float rsv[2][4];
#pragma unroll
        for (int ai = 0; ai < 2; ++ai)
#pragma unroll
            for (int m = 0; m < 4; ++m) rsv[ai][m] = 1.0f;
        if (nb == 1) {
            f32x4 sq[2][4];
#pragma unroll
            for (int ai = 0; ai < 2; ++ai)
#pragma unroll
                for (int m = 0; m < 4; ++m) sq[ai][m] = *(const f32x4*)(SSQ + (size_t)(row0 + ai * HALF + m * 16) * 16 + 4 * fq);
            __builtin_amdgcn_sched_barrier(0);
#pragma unroll
            for (int ai = 0; ai < 2; ++ai)
#pragma unroll
                for (int m = 0; m < 4; ++m) { float ss = (sq[ai][m][0] + sq[ai][m][1]) + (sq[ai][m][2] + sq[ai][m][3]); ss += __shfl_xor(ss, 16); ss += __shfl_xor(ss, 32);
                    rsv[ai][m] = rsqrtf(ss * (1.0f / 512.0f) + 1e-6f); }
        }
#pragma unroll
        for (int ai = 0; ai < 2; ++ai)
#pragma unroll
            for (int m = 0; m < 4; ++m) { const int row = row0 + ai * HALF + m * 16;
                const float rs = rsv[ai][m];
                bf16_t* gp = MB + (size_t)row * 4096 + col0;
#pragma unroll
                for (int bj = 0; bj < 2; ++bj) { const f32x4 v0 = acc[ai][bj][m][0], v1 = acc[ai][bj][m][1];
                    u32x4 w; w.x = pk2(v0[0] * rs, v0[1] * rs); w.y = pk2(v0[2] * rs, v0[3] * rs); w.z = pk2(v1[0] * rs, v1[1] * rs); w.w = pk2(v1[2] * rs, v1[3] * rs);
                    __builtin_nontemporal_store(w, (u32x4*)(gp + bj * HALF)); } }
    }
};
struct EpiGateMerge {
    static constexpr bool PERM = true, AFTER_DRAIN = false;
    const bf16_t* MB;
    bf16_t* OUT;
    __device__ __forceinline__ void operator()(const f32x4 (&acc)[2][2][4][2], const Unit& u, int wr, int wc, int fr, int fq) const {
        const int row0 = u.pm * BM + wr * 64 + fr, d0 = u.pn * 64 + wc * 16 + 4 * fq;
        u32x2 mq[2][4][4];
#pragma unroll
        for (int ai = 0; ai < 2; ++ai)
#pragma unroll
            for (int m = 0; m < 4; ++m) { const bf16_t* mp = MB + (size_t)(row0 + ai * HALF + m * 16) * 4096 + d0;
#pragma unroll
                for (int q = 0; q < 4; ++q) mq[ai][m][q] = *(const u32x2*)(mp + q * 1024); }
        __builtin_amdgcn_sched_barrier(0);
#pragma unroll
        for (int ai = 0; ai < 2; ++ai)
#pragma unroll
            for (int m = 0; m < 4; ++m) { const int row = row0 + ai * HALF + m * 16;
                f32x4 o = {0.f, 0.f, 0.f, 0.f};
#pragma unroll
                for (int bj = 0; bj < 2; ++bj)
#pragma unroll
                    for (int n = 0; n < 2; ++n) { const u32x2 mw = mq[ai][m][2 * bj + n]; const f32x4 g = acc[ai][bj][m][n];
                        o[0] += __uint_as_float(mw.x << 16) * frcp(1.0f + __expf(-g[0])); o[1] += __uint_as_float(mw.x & 0xffff0000u) * frcp(1.0f + __expf(-g[1]));
                        o[2] += __uint_as_float(mw.y << 16) * frcp(1.0f + __expf(-g[2])); o[3] += __uint_as_float(mw.y & 0xffff0000u) * frcp(1.0f + __expf(-g[3])); }
                u32x2 w; w.x = pk2(o[0], o[1]); w.y = pk2(o[2], o[3]); *(u32x2*)(OUT + (size_t)row * 1024 + d0) = w; }
    }
};
struct MergeOrder {
    int G, c, ntiles, MT;
    __device__ bool next(int i, Unit& u) const {
        int P, j;
        if ((G & 31) == 0) { const int x = c & 7, k = c >> 3; P = i * (G >> 2) + x * (G >> 5) + (k >> 2); j = k & 3; }
        else { const int L = i * G + c; P = L >> 2; j = L & 3; }
        if (P >= ntiles) return false;
        const int n = P / MT, pm = P - n * MT; u.pm = n * MT + pm; u.pn = n * 4 + j; return true; }
    __device__ __forceinline__ void a_ready(const Unit&) const {}
    __device__ __forceinline__ void done(const Unit&) const {}
};
struct MoeOrder {
    int G, c, nunits; const PG8_LAS int* blk_e;
    __device__ bool next(int i, Unit& u) const {
        int pm, j;
        if ((G & 31) == 0) { const int x = c & 7, k = c >> 3; pm = i * (G >> 2) + x * (G >> 5) + (k >> 2); j = k & 3; }
        else { const int L = i * G + c; pm = L >> 2; j = L & 3; }
        if (pm * 4 + j >= nunits) return false;
        u.pm = pm; u.pn = __builtin_amdgcn_readfirstlane(blk_e[pm]) * 4 + j; return true; }
    __device__ __forceinline__ void a_ready(const Unit&) const {}
    __device__ __forceinline__ void done(const Unit&) const {}
};
struct MoeGatherOrder {
    int G, c, nunits; const PG8_LAS int* blk_e; const PG8_LAS int* idx;
    __device__ __forceinline__ int pm_of(int i) const {
        int pm, j;
        if ((G & 31) == 0) { const int x = c & 7, k = c >> 3; pm = i * (G >> 2) + x * (G >> 5) + (k >> 2); j = k & 3; }
        else { const int L = i * G + c; pm = L >> 2; j = L & 3; }
        return pm * 4 + j >= nunits ? -1 : pm; }
    __device__ __forceinline__ bool next(int i, Unit& u) const {
        int pm, j;
        if ((G & 31) == 0) { const int x = c & 7, k = c >> 3; pm = i * (G >> 2) + x * (G >> 5) + (k >> 2); j = k & 3; }
        else { const int L = i * G + c; pm = L >> 2; j = L & 3; }
        if (pm * 4 + j >= nunits) return false;
        u.pm = pm; u.pn = __builtin_amdgcn_readfirstlane(blk_e[pm]) * 4 + j; return true; }
    __device__ __forceinline__ void a_ready(const Unit&) const {}
    __device__ __forceinline__ void done(const Unit&) const {}
};
template <class S> struct GatherTrait { static constexpr bool value = false; };
template <> struct GatherTrait<MoeGatherOrder> { static constexpr bool value = true; };
template <class S> __device__ __forceinline__ int gather_row(const S&, int) { return 0; }
__device__ __forceinline__ int gather_row(const MoeGatherOrder& S, int k) { return S.idx[k]; }


template <class Epi, class Sched, bool STAMP = false>
__device__ __forceinline__ void gemm_phase(PG8_LAS unsigned char* lds, const Gemm g, const Sched& S, const Epi& E, unsigned long long* stamps, const int tid_in) {
    int tid_ = tid_in; asm volatile("" : "+v"(tid_));
    const int tid = tid_, wid = __builtin_amdgcn_readfirstlane(tid >> 6), lane = tid & 63, wr = wid >> 2, wc = wid & 3, fr = lane & 15, fq = lane >> 4;
    const int K = g.K, nt = K / BK;
    int ts_lo = 0, ts_hi = 0, nts = 0; const unsigned long long rt_entry = STAMP ? (unsigned long long)wall_clock64() : 0ull;
#define PG8_STAMP() do { if (STAMP && wid == 0 && nts < 64) { const unsigned long long _c = (unsigned long long)clock64(); \
        ts_lo = (lane == nts) ? (int)(unsigned)_c : ts_lo; ts_hi = (lane == nts) ? (int)(unsigned)(_c >> 32) : ts_hi; ++nts; } } while (0)
    PG8_STAMP();
    unsigned voffA[2], voffB[2];
#pragma unroll
    for (int i = 0; i < 2; ++i) { int R, C; stage_rc(tid * 16 + i * 8192, R, C); const int Rb = Epi::PERM ? ((R & ~31) + perm32(R & 31)) : R;
        voffA[i] = (unsigned)(R * K + C) * 2u; voffB[i] = (unsigned)(Rb * K + C) * 2u; }
    constexpr bool GA = GatherTrait<Sched>::value;
    unsigned roC00 = 0u, roC01 = 0u, roC10 = 0u, roC11 = 0u, roN00 = 0u, roN01 = 0u, roN10 = 0u, roN11 = 0u;
    const char* const gA = (const char*)g.A;
#define PG8_GIDX1(ui_, h_, i_, dst) do { int R, C; stage_rc(tid * 16 + (i_) * 8192, R, C); dst = (unsigned)gather_row(S, (ui_) * 256 + R + 128 * (h_)) * (unsigned)(K * 2) + (unsigned)(C * 2); } while (0)
#define PG8_GIDX(ui_, P) do { PG8_GIDX1(ui_, 0, 0, P##00); PG8_GIDX1(ui_, 0, 1, P##01); PG8_GIDX1(ui_, 1, 0, P##10); PG8_GIDX1(ui_, 1, 1, P##11); } while (0)
#define PG8_STAGE_A(bufoff, plainp, gp, o0, o1) do { if constexpr (GA) { \
        __builtin_amdgcn_global_load_lds((const unsigned*)((const char*)(gp) + (o0)), (PG8_LAS unsigned*)(lds + (bufoff) + ldsw), 16, 0, 0); \
        __builtin_amdgcn_global_load_lds((const unsigned*)((const char*)(gp) + (o1)), (PG8_LAS unsigned*)(lds + (bufoff) + ldsw + 8192), 16, 0, 0); } else PG8_STAGE(bufoff, plainp, voffA); } while (0)
    const size_t kstep = (size_t)(BK * 2);
    const size_t hstep = (size_t)HALF * K * 2;
    const size_t tstep = 2 * hstep;
    const unsigned ldsw = (unsigned)wid * 1024u;
    const int aoff = lds_byte(wr * 64 + fr, fq * 8), boff = lds_byte(wc * 32 + fr, fq * 8);
#define PG8_SA(b, h) (((b) * 2 + (h)) * HTB)
#define PG8_SB(b, h) ((4 + (b) * 2 + (h)) * HTB)
#define PG8_STAGE(bufoff, gbase, voff) do { _Pragma("unroll") for (int _i = 0; _i < 2; ++_i) \
        __builtin_amdgcn_global_load_lds((const unsigned*)((const char*)(gbase) + (voff)[_i]), (PG8_LAS unsigned*)(lds + (bufoff) + ldsw + _i * 8192), 16, 0, 0); } while (0)
#define PG8_LDA(dst, b, h) do { _Pragma("unroll") for (int m = 0; m < 4; ++m) _Pragma("unroll") for (int k = 0; k < 2; ++k) dst[m][k] = *(const PG8_LAS bf16x8*)(lds + PG8_SA(b, h) + aoff + m * 2048 + k * 1024); } while (0)
#define PG8_LDB(dst, b, h) do { _Pragma("unroll") for (int n = 0; n < 2; ++n) _Pragma("unroll") for (int k = 0; k < 2; ++k) dst[n][k] = *(const PG8_LAS bf16x8*)(lds + PG8_SB(b, h) + boff + n * 2048 + k * 1024); } while (0)
#define PG8_MMA(ai, bj, At, Bt) do { __builtin_amdgcn_s_setprio(1); _Pragma("unroll") for (int m = 0; m < 4; ++m) _Pragma("unroll") for (int n = 0; n < 2; ++n) _Pragma("unroll") for (int k = 0; k < 2; ++k) \
        acc[ai][bj][m][n] = __builtin_amdgcn_mfma_f32_16x16x32_bf16(Bt[n][k], At[m][k], acc[ai][bj][m][n], 0, 0, 0); __builtin_amdgcn_s_setprio(0); } while (0)
#define PG8_WAIT_V(n) asm volatile("s_waitcnt vmcnt(" #n ")" ::: "memory")
#define PG8_WAIT_L(n) asm volatile("s_waitcnt lgkmcnt(" #n ")" ::: "memory")
#define PG8_BAR __builtin_amdgcn_s_barrier()
#define PG8_SCHED __builtin_amdgcn_sched_barrier(0)
    Unit cur, nxt; int ui = 0;
    if (!S.next(0, cur)) return;
    f32x4 acc[2][2][4][2];
#pragma unroll
    for (int a = 0; a < 2; ++a)
#pragma unroll
        for (int b = 0; b < 2; ++b)
#pragma unroll
            for (int m = 0; m < 4; ++m)
#pragma unroll
                for (int n = 0; n < 2; ++n) acc[a][b][m][n] = (f32x4){0.f, 0.f, 0.f, 0.f};
    bf16x8 At[4][2], B0[2][2], B1[2][2];
    const char* cA = (const char*)g.A + (size_t)cur.pm * tstep; const char* cB = (const char*)g.Bt + (size_t)cur.pn * tstep;
    S.a_ready(cur);
    if constexpr (GA) PG8_GIDX(0, roC);
    PG8_STAGE(PG8_SB(0, 0), cB, voffB); PG8_STAGE_A(PG8_SA(0, 0), cA, gA, roC00, roC01); PG8_STAGE(PG8_SB(0, 1), cB + hstep, voffB); PG8_STAGE_A(PG8_SA(0, 1), cA + hstep, gA, roC10, roC11);
    if (wr == 1) PG8_BAR;
    PG8_WAIT_V(4); PG8_BAR;
    PG8_STAGE(PG8_SB(1, 0), cB + kstep, voffB); PG8_STAGE_A(PG8_SA(1, 0), cA + kstep, gA + kstep, roC00, roC01); PG8_STAGE(PG8_SB(1, 1), cB + hstep + kstep, voffB);
    PG8_WAIT_V(6); PG8_BAR;
    PG8_STAMP();
    for (;;) {
        const bool has_next = S.next(ui + 1, nxt);
        const char* nA = has_next ? (const char*)g.A + (size_t)nxt.pm * tstep : cA; const char* nB = has_next ? (const char*)g.Bt + (size_t)nxt.pn * tstep : cB;
        if constexpr (GA) { if (has_next) PG8_GIDX(ui + 1, roN); else { roN00 = roC00; roN01 = roC01; roN10 = roC10; roN11 = roC11; } }
        for (int t = 0; t < nt; t += 2) {
            const bool last = (t == nt - 2);
            const char* g1 = gA + (size_t)(t + 1) * kstep; const char* g2 = last ? gA : gA + (size_t)(t + 2) * kstep; const char* g3 = g2 + kstep;
            const unsigned roS00 = last ? roN00 : roC00, roS01 = last ? roN01 : roC01, roS10 = last ? roN10 : roC10, roS11 = last ? roN11 : roC11;
            const char* a1 = cA + (size_t)(t + 1) * kstep;
            const char* a2 = last ? nA : cA + (size_t)(t + 2) * kstep; const char* b2 = last ? nB : cB + (size_t)(t + 2) * kstep;
            const char* a3 = a2 + kstep; const char* b3 = b2 + kstep;
            if (last && has_next) S.a_ready(nxt);
            PG8_LDB(B0, 0, 0); PG8_SCHED; PG8_LDA(At, 0, 0); PG8_STAGE_A(PG8_SA(1, 1), a1 + hstep, g1, roC10, roC11);
            PG8_WAIT_L(8); PG8_BAR; PG8_WAIT_L(0); PG8_MMA(0, 0, At, B0); PG8_BAR; PG8_SCHED;
            PG8_LDB(B1, 0, 1); PG8_STAGE(PG8_SB(0, 0), b2, voffB);
            PG8_BAR; PG8_WAIT_L(0); PG8_MMA(0, 1, At, B1); PG8_BAR;
            PG8_LDA(At, 0, 1); PG8_STAGE_A(PG8_SA(0, 0), a2, g2, roS00, roS01);
            PG8_BAR; PG8_WAIT_L(0); PG8_MMA(1, 0, At, B0); PG8_BAR; PG8_SCHED;
            PG8_STAGE(PG8_SB(0, 1), b2 + hstep, voffB);
            PG8_WAIT_V(6); PG8_BAR; PG8_MMA(1, 1, At, B1); PG8_BAR;
            PG8_LDB(B0, 1, 0); PG8_SCHED; PG8_LDA(At, 1, 0); PG8_STAGE_A(PG8_SA(0, 1), a2 + hstep, g2, roS10, roS11);
            PG8_WAIT_L(8); PG8_BAR; PG8_WAIT_L(0); PG8_MMA(0, 0, At, B0); PG8_BAR; PG8_SCHED;
            PG8_LDB(B1, 1, 1); PG8_STAGE(PG8_SB(1, 0), b3, voffB);
            PG8_BAR; PG8_WAIT_L(0); PG8_MMA(0, 1, At, B1); PG8_BAR;
            PG8_LDA(At, 1, 1); PG8_STAGE_A(PG8_SA(1, 0), a3, g3, roS00, roS01);
            PG8_BAR; PG8_WAIT_L(0); PG8_MMA(1, 0, At, B0); PG8_BAR; PG8_SCHED;
            PG8_STAGE(PG8_SB(1, 1), b3 + hstep, voffB);
            PG8_WAIT_V(6); PG8_BAR; PG8_MMA(1, 1, At, B1); PG8_BAR;
        }
        PG8_STAMP();
        if constexpr (!Epi::AFTER_DRAIN) { E(acc, cur, wr, wc, fr, fq); S.done(cur); }
        PG8_STAMP();
        if (!has_next) break;
#pragma unroll
        for (int a = 0; a < 2; ++a)
#pragma unroll
            for (int b = 0; b < 2; ++b)
#pragma unroll
                for (int m = 0; m < 4; ++m)
#pragma unroll
                    for (int n = 0; n < 2; ++n) acc[a][b][m][n] = (f32x4){0.f, 0.f, 0.f, 0.f};
        cur = nxt; cA = nA; cB = nB; ++ui;
        if constexpr (GA) { roC00 = roN00; roC01 = roN01; roC10 = roN10; roC11 = roN11; }
    }
    PG8_WAIT_V(0);
    if (wr == 0) PG8_BAR;
    PG8_BAR;
    if constexpr (Epi::AFTER_DRAIN) { E.fused(acc, cur, wr, wc, fr, fq, lds, wid, lane); S.done(cur); }
    PG8_STAMP();
    if (STAMP && wid == 0) { stamps[lane] = lane < nts ? (((unsigned long long)(unsigned)ts_hi << 32) | (unsigned)ts_lo) : 0ull;
        if (lane == 62) stamps[62] = rt_entry; if (lane == 63) stamps[63] = (unsigned long long)wall_clock64(); }
#undef PG8_STAMP
#undef PG8_SA
#undef PG8_SB
#undef PG8_STAGE
#undef PG8_STAGE_A
#undef PG8_GIDX
#undef PG8_GIDX1
#undef PG8_LDA
#undef PG8_LDB
#undef PG8_MMA
#undef PG8_WAIT_V
#undef PG8_WAIT_L
#undef PG8_BAR
#undef PG8_SCHED
}
}
constexpr int DM = 1024, NBATCH = 16, SEQL = 2048, CTXL = 256, DEPTH = 4;
constexpr int MC = NBATCH * CTXL, ML = NBATCH * SEQL, MT = MC + ML;
constexpr int NPROJ = 3840, NGATE = 4096, DIN = 7696;
constexpr int C_AQ = 0, C_AK = 512, C_AV = 640, C_GQ = 768, C_GK = 1280, C_GV = 1408, C_SX = 1536, C_SZ = 2048, C_SB = 2560, C_SC = 2816, C_SU = 3072, C_DT = 3584;
constexpr int KVPOS = CTXL + SEQL;
constexpr int NCHUNK = MT / 128;
constexpr int NSUB = MT / 16;
constexpr int MOE_MAXBLK = 320, MOE_MAXSLOT = MOE_MAXBLK * 256;
constexpr float ALPHA = 1.6817928305074290f;
constexpr float LN_EPS = 1e-6f;
constexpr float LOG2E = 1.4426950408889634f;
constexpr float QSCALE = 0.125f * LOG2E;

enum { I_X = 0, I_C, I_CTX, I_CCTX, I_MODW, I_MODB, I_WIN, I_SINK, I_GQN, I_GKN, I_CONVW, I_CONVB, I_DTB, I_ALOG, I_SSDD, I_SSDNW,
       I_S5ARE, I_S5AIM, I_S5LDT, I_S5BRE, I_S5BIM, I_S5CRE, I_S5CIM, I_S5D, I_S5GLU, I_WBR, I_WOUT, I_LN1G, I_LN1B, I_LN2G, I_LN2B,
       I_RW, I_RB, I_MWG, I_MWU, I_MWD, N_IN };

constexpr size_t MiB = 1u << 20;
constexpr size_t WS_CTL = 0, CTL_ZERO_BYTES = 128 * 1024;
constexpr size_t WS_MOD = 1 * MiB;
constexpr size_t WS_TOKI = 3 * MiB;
constexpr size_t WS_WGBASE = 3 * MiB + 768 * 1024;
constexpr size_t WS_TOKW = 4 * MiB;
constexpr size_t WS_SSQ = 1146 * MiB;
constexpr size_t WS_ADEC = 7 * MiB;
constexpr size_t WS_ROPE = 7 * MiB + 65536;
constexpr size_t WS_W3T = 8 * MiB;
constexpr size_t WS_QT = 16 * MiB;
constexpr size_t WS_A16 = 20 * MiB;
constexpr size_t WS_DT = 21 * MiB;
constexpr size_t WS_WINT = 24 * MiB;
constexpr size_t WS_WGT = 32 * MiB;
constexpr size_t WS_WBT = 40 * MiB;
constexpr size_t WS_WOT = 44 * MiB;
constexpr size_t WS_WGLUT = 46 * MiB;
constexpr size_t WS_XRES = 48 * MiB;
constexpr size_t WS_H = 192 * MiB;
constexpr size_t WS_A = 264 * MiB;
constexpr size_t WS_A_HID = WS_A + 160 * MiB;
constexpr size_t WS_B = 552 * MiB;
constexpr size_t WS_B_MOED = WS_B + 64 * MiB;
constexpr size_t WS_UF = WS_B + 108 * MiB;
constexpr size_t WS_D = 696 * MiB;
constexpr size_t WS_KALL = 840 * MiB;
constexpr size_t WS_VTALL = 858 * MiB;
constexpr size_t WS_XT = 876 * MiB;
constexpr size_t WS_BROW = 912 * MiB;
constexpr size_t WS_BT = 930 * MiB;
constexpr size_t WS_CROW = 948 * MiB;
constexpr size_t WS_QU = 966 * MiB;
constexpr size_t WS_Y5G = 1038 * MiB;
constexpr size_t WS_HB = 1074 * MiB;
constexpr size_t WS_END = 1149 * MiB;
constexpr size_t WS_MOEW1 = WS_D + 72 * MiB;
constexpr size_t WS_MOEW2 = WS_QU + 36 * MiB;
constexpr size_t WS_S2T = 5 * MiB;
constexpr int CW_TICKET = 16384 + 256;
constexpr int CW_BAR = 4096;
constexpr int CW_CNT = 16384;

constexpr int LDS_BYTES = 163840;
constexpr int LDS_MISC = 131072;

#define GAS __attribute__((address_space(1)))

struct Args { const float* in[N_IN]; float* out; unsigned char* ws; int ph_lo, ph_hi; };
#define CAS __attribute__((address_space(4)))
struct Ctx {
    const CAS Args* A;
    LAS unsigned char* lds;
    int tid, lane, wave, G, bid;
};
template <class T> DI T* wsp(const Ctx& c, size_t off) { return (T*)(c.A->ws + off); }
DI void row_load(const float* p, int lane, f32x4 (&v)[4]) {
#pragma unroll
    for (int i = 0; i < 4; ++i) v[i] = *(const f32x4*)(p + lane * 4 + 256 * i);
}
DI void row_load_pk(const bf16* p, int lane, u32x2 (&v)[4]) {
#pragma unroll
    for (int i = 0; i < 4; ++i) v[i] = *(const u32x2*)(p + lane * 4 + 256 * i);
}
DI void row_store(float* p, int lane, const f32x4 (&v)[4]) {
#pragma unroll
    for (int i = 0; i < 4; ++i) *(f32x4*)(p + lane * 4 + 256 * i) = v[i];
}
DI void row_store_nt(float* p, int lane, const f32x4 (&v)[4]) {
#pragma unroll
    for (int i = 0; i < 4; ++i) __builtin_nontemporal_store(v[i], (f32x4*)(p + lane * 4 + 256 * i));
}
DI void row_store_bf16(bf16* p, int lane, const f32x4 (&v)[4]) {
#pragma unroll
    for (int i = 0; i < 4; ++i) { u32x2 w; w.x = pk2(v[i][0], v[i][1]); w.y = pk2(v[i][2], v[i][3]); *(u32x2*)(p + lane * 4 + 256 * i) = w; }
}
DI void row_ln(f32x4 (&v)[4]) {
    float s = 0.f;
#pragma unroll
    for (int i = 0; i < 4; ++i) s += (v[i][0] + v[i][1]) + (v[i][2] + v[i][3]);
    const float mu = wave_sum(s) * (1.0f / 1024.0f);
    float q = 0.f;
#pragma unroll
    for (int i = 0; i < 4; ++i) { v[i] -= mu; q += (v[i][0] * v[i][0] + v[i][1] * v[i][1]) + (v[i][2] * v[i][2] + v[i][3] * v[i][3]); }
    const float rs = rsqrtf(wave_sum(q) * (1.0f / 1024.0f) + LN_EPS);
#pragma unroll
    for (int i = 0; i < 4; ++i) v[i] *= rs;
}
DI int row_modidx(int row) { return row < MC ? 16 : (row - MC) >> 11; }
DI void row_modulate(const f32x4 (&x)[4], const float* scale, const float* shift, int lane, f32x4 (&h)[4]) {
#pragma unroll
    for (int i = 0; i < 4; ++i) h[i] = x[i];
    row_ln(h);
#pragma unroll
    for (int i = 0; i < 4; ++i) { const f32x4 sc = *(const f32x4*)(scale + lane * 4 + 256 * i), sh = *(const f32x4*)(shift + lane * 4 + 256 * i); h[i] = h[i] * (sc + 1.0f) + sh; }
}

DI void row_modulate_r(const f32x4 (&x)[4], const f32x4 (&sc)[4], const f32x4 (&sh)[4], f32x4 (&h)[4]) {
#pragma unroll
    for (int i = 0; i < 4; ++i) h[i] = x[i];
    row_ln(h);
#pragma unroll
    for (int i = 0; i < 4; ++i) h[i] = h[i] * (sc[i] + 1.0f) + sh[i];
}

DI void mod_unit(const Ctx& c, int unit) {
    const int l = unit / 48, cb = unit % 48;
    LAS float* cond = (LAS float*)c.lds;
    {   f32x4 cq[9];
#pragma unroll
        for (int q = 0; q < 9; ++q) { const int i4 = c.tid + 512 * q; const int r = i4 >> 8, k4 = (i4 & 255) * 4;
            cq[q] = (f32x4){0.f, 0.f, 0.f, 0.f}; if (i4 < 17 * 256) cq[q] = *(const f32x4*)(r < 16 ? c.A->in[I_C] + r * 1024 + k4 : c.A->in[I_CCTX] + k4); }
#pragma unroll
        for (int q = 0; q < 9; ++q) { const int i4 = c.tid + 512 * q;
            if (i4 < 17 * 256) { f32x4 o; o[0] = siluf_(cq[q][0]); o[1] = siluf_(cq[q][1]); o[2] = siluf_(cq[q][2]); o[3] = siluf_(cq[q][3]); *(LAS f32x4*)(cond + i4 * 4) = o; } } }
    __syncthreads();
    const int c4 = (c.tid & 31) * 4, kq = c.tid >> 5;
    f32x4 acc[17];
#pragma unroll
    for (int r = 0; r < 17; ++r) acc[r] = (f32x4){0.f, 0.f, 0.f, 0.f};
    const float* w = c.A->in[I_MODW] + (size_t)l * 1024 * 6144 + cb * 128 + c4;
    for (int k = kq * 64; k < kq * 64 + 64; k += 4) {
        const f32x4 w0 = __builtin_nontemporal_load((const f32x4*)(w + (size_t)k * 6144)), w1 = __builtin_nontemporal_load((const f32x4*)(w + (size_t)(k + 1) * 6144)),
                    w2 = __builtin_nontemporal_load((const f32x4*)(w + (size_t)(k + 2) * 6144)), w3 = __builtin_nontemporal_load((const f32x4*)(w + (size_t)(k + 3) * 6144));
#pragma unroll
        for (int r = 0; r < 17; ++r) { const f32x4 cv = *(LAS f32x4*)(cond + r * 1024 + k); acc[r] += (w0 * cv[0] + w1 * cv[1]) + (w2 * cv[2] + w3 * cv[3]); } }
#pragma unroll
    for (int r = 0; r < 17; ++r)
#pragma unroll
        for (int j = 0; j < 4; ++j) acc[r][j] += __shfl_xor(acc[r][j], 32);
    __syncthreads();
    LAS float* red = (LAS float*)c.lds;
    if (c.lane < 32) {
#pragma unroll
        for (int r = 0; r < 17; ++r) *(LAS f32x4*)(red + (c.wave * 17 + r) * 128 + c4) = acc[r]; }
    __syncthreads();
    float* MOD = wsp<float>(c, WS_MOD);
    for (int i = c.tid; i < 17 * 128; i += 512) { const int r = i >> 7, cc = i & 127;
        float s_ = 0.f;
#pragma unroll
        for (int wv = 0; wv < 8; ++wv) s_ += red[(wv * 17 + r) * 128 + cc];
        MOD[((size_t)l * 17 + r) * 6144 + cb * 128 + cc] = s_ + c.A->in[I_MODB][l * 6144 + cb * 128 + cc]; }
    __syncthreads();
}

struct WTile { const float* src; int ld; bf16* dst; int K, nd0, k0, sc; };
DI int map_win(int r) { return r < 3072 ? r : (r < 3584 ? r + 16 : (r < 3600 ? r - 512 : -1)); }
DI int map_gate(int R) { const int pn = R >> 8, rt = R & 255; return 3600 + (2 * (rt >> 7) + ((rt >> 2) & 1)) * 1024 + 64 * pn + 16 * ((rt >> 5) & 3) + 4 * ((rt >> 3) & 3) + (rt & 3); }
DI int map_glu(int r) { const int jt = r >> 8, w = r & 255; return w < 128 ? jt * 128 + w : 512 + jt * 128 + (w - 128); }
DI int map_gu(int r) { return (r >> 8) * 128 + (r & 127); }
constexpr int WSMALL_TILES = 960 + 1024 + 512 + 256 + 128;
DI WTile wsmall_desc(const Ctx& c, int layer, int t, int n4) {
    WTile w;
    if (t < 960) { w.src = c.A->in[I_WIN] + (size_t)layer * 1024 * DIN; w.ld = DIN; w.dst = wsp<bf16>(c, WS_WINT); w.K = 1024; w.nd0 = (t >> 4) * 64; w.k0 = (t & 15) * 64; w.sc = map_win(w.nd0 + n4); return w; }
    t -= 960;
    if (t < 1024) { w.src = c.A->in[I_WIN] + (size_t)layer * 1024 * DIN; w.ld = DIN; w.dst = wsp<bf16>(c, WS_WGT); w.K = 1024; w.nd0 = (t >> 4) * 64; w.k0 = (t & 15) * 64; w.sc = map_gate(w.nd0 + n4); return w; }
    t -= 1024;
    if (t < 512) { const int n = t >> 7, tt = t & 127; w.src = c.A->in[I_WBR] + ((size_t)layer * 4 + n) * 512 * 1024; w.ld = 1024; w.dst = wsp<bf16>(c, WS_WBT) + (size_t)n * 1024 * 512; w.K = 512; w.nd0 = (tt >> 3) * 64; w.k0 = (tt & 7) * 64; w.sc = w.nd0 + n4; return w; }
    t -= 512;
    if (t < 256) { w.src = c.A->in[I_WOUT] + (size_t)layer * 1024 * 1024; w.ld = 1024; w.dst = wsp<bf16>(c, WS_WOT); w.K = 1024; w.nd0 = (t >> 4) * 64; w.k0 = (t & 15) * 64; w.sc = w.nd0 + n4; return w; }
    t -= 256;
    w.src = c.A->in[I_S5GLU] + (size_t)layer * 512 * 1024; w.ld = 1024; w.dst = wsp<bf16>(c, WS_WGLUT); w.K = 512; w.nd0 = (t >> 3) * 64; w.k0 = (t & 7) * 64; w.sc = map_glu(w.nd0 + n4); return w;
}
constexpr int WMOE_TILES = 32 * 384;
DI WTile wmoe_desc(const Ctx& c, int layer, int t, int n4) {
    WTile w; const int e = t / 384, tt = t - e * 384;
    if (tt < 256) { w.nd0 = (tt >> 4) * 64; w.k0 = (tt & 15) * 64; w.src = ((w.nd0 & 128) ? c.A->in[I_MWU] : c.A->in[I_MWG]) + ((size_t)layer * 32 + e) * 1024 * 512; w.ld = 512;
        w.dst = wsp<bf16>(c, WS_MOEW1) + (size_t)e * 1024 * 1024; w.K = 1024; w.sc = map_gu(w.nd0 + n4); }
    else { const int u = tt - 256; w.nd0 = (u >> 3) * 64; w.k0 = (u & 7) * 64; w.src = c.A->in[I_MWD] + ((size_t)layer * 32 + e) * 512 * 1024; w.ld = 1024;
        w.dst = wsp<bf16>(c, WS_MOEW2) + (size_t)e * 1024 * 512; w.K = 512; w.sc = w.nd0 + n4; }
    return w;
}
template <int MOE> DI void wconv_load(const Ctx& c, int layer, int t0, int stride, int ntiles, int kk, int n4, f32x4 (&v)[4][2]) {
#pragma unroll
    for (int q = 0; q < 4; ++q) { const int t = t0 + q * stride;
        v[q][0] = (f32x4){0.f, 0.f, 0.f, 0.f}; v[q][1] = v[q][0];
        if (t < ntiles) { const WTile w = MOE ? wmoe_desc(c, layer, t, n4) : wsmall_desc(c, layer, t, n4);
            if (w.sc >= 0) { v[q][0] = __builtin_nontemporal_load((const f32x4*)(w.src + (size_t)(w.k0 + kk) * w.ld + w.sc)); v[q][1] = __builtin_nontemporal_load((const f32x4*)(w.src + (size_t)(w.k0 + kk + 32) * w.ld + w.sc)); } } }
}
template <int MOE> DI void wconv_run(const Ctx& c, int layer, int first, int stride, int ntiles) {
    LAS float* tiles = (LAS float*)c.lds;
    const int kk = c.tid >> 4, n4 = (c.tid & 15) * 4, n = c.tid >> 3, k8 = (c.tid & 7) * 8;
    f32x4 v[4][2];
    if (first < ntiles) wconv_load<MOE>(c, layer, first, stride, ntiles, kk, n4, v);
    for (int t0 = first; t0 < ntiles; t0 += 4 * stride) {
#pragma unroll
        for (int q = 0; q < 4; ++q)
#pragma unroll
            for (int p2 = 0; p2 < 2; ++p2) { LAS float* tp = tiles + q * 4160 + (kk + 32 * p2) * 65 + n4; tp[0] = v[q][p2][0]; tp[1] = v[q][p2][1]; tp[2] = v[q][p2][2]; tp[3] = v[q][p2][3]; }
        __syncthreads();
        if (t0 + 4 * stride < ntiles) wconv_load<MOE>(c, layer, t0 + 4 * stride, stride, ntiles, kk, n4, v);
#pragma unroll
        for (int q = 0; q < 4; ++q) { const int t = t0 + q * stride;
            if (t < ntiles) { const WTile w = MOE ? wmoe_desc(c, layer, t, n4) : wsmall_desc(c, layer, t, n4);
                LAS float* tp = tiles + q * 4160 + k8 * 65 + n;
                u32x4 o; o.x = pk2(tp[0], tp[65]); o.y = pk2(tp[130], tp[195]); o.z = pk2(tp[260], tp[325]); o.w = pk2(tp[390], tp[455]);
                *(u32x4*)(w.dst + (size_t)(w.nd0 + n) * w.K + w.k0 + k8) = o; } }
        __syncthreads();
    }
}

template <int MOE> DI void wconv_dyn(const Ctx& c, int layer, unsigned* cnt, int tbase, int ntiles, int max_trips) {
    LAS float* tiles = (LAS float*)c.lds;
    volatile LAS int* tk = (volatile LAS int*)(c.lds + LDS_MISC + 1600);
    const int kk = c.tid >> 4, n4 = (c.tid & 15) * 4, n = c.tid >> 3, k8 = (c.tid & 7) * 8;
    f32x4 v[4][2];
    if (c.tid == 0) { tk[0] = (int)__hip_atomic_fetch_add(cnt, 1u, __ATOMIC_RELAXED, __HIP_MEMORY_SCOPE_AGENT); tk[1] = max_trips > 1 ? (int)__hip_atomic_fetch_add(cnt, 1u, __ATOMIC_RELAXED, __HIP_MEMORY_SCOPE_AGENT) : (1 << 24); }
    __syncthreads();
    int cur = tbase + tk[0] * 4;
    if (cur < ntiles) wconv_load<MOE>(c, layer, cur, 1, ntiles, kk, n4, v);
    for (int i = 0; cur < ntiles; ++i) {
#pragma unroll
        for (int q = 0; q < 4; ++q)
#pragma unroll
            for (int p2 = 0; p2 < 2; ++p2) { LAS float* tp = tiles + q * 4160 + (kk + 32 * p2) * 65 + n4; tp[0] = v[q][p2][0]; tp[1] = v[q][p2][1]; tp[2] = v[q][p2][2]; tp[3] = v[q][p2][3]; }
        __syncthreads();
        const int nxt = tbase + tk[(i + 1) & 1] * 4;
        if (nxt < ntiles) wconv_load<MOE>(c, layer, nxt, 1, ntiles, kk, n4, v);
        unsigned t2 = 1u << 24; if (c.tid == 0 && i + 2 < max_trips) t2 = __hip_atomic_fetch_add(cnt, 1u, __ATOMIC_RELAXED, __HIP_MEMORY_SCOPE_AGENT);
#pragma unroll
        for (int q = 0; q < 4; ++q) { const int t = cur + q;
            if (t < ntiles) { const WTile w = MOE ? wmoe_desc(c, layer, t, n4) : wsmall_desc(c, layer, t, n4);
                LAS float* tp = tiles + q * 4160 + k8 * 65 + n;
                u32x4 o; o.x = pk2(tp[0], tp[65]); o.y = pk2(tp[130], tp[195]); o.z = pk2(tp[260], tp[325]); o.w = pk2(tp[390], tp[455]);
                *(u32x4*)(w.dst + (size_t)(w.nd0 + n) * w.K + w.k0 + k8) = o; } }
        if (c.tid == 0) tk[i & 1] = (int)t2;
        __syncthreads();
        cur = nxt;
    }
}

DI size_t w3idx(int col, int k) { return ((size_t)((col >> 5) * 32 + (k >> 4)) * 64 + ((k >> 3) & 1) * 32 + (col & 31)) * 8 + (k & 7); }
DI size_t qtidx(int col, int k) { return ((size_t)((col >> 5) * 16 + (k >> 4)) * 64 + ((k >> 3) & 1) * 32 + (col & 31)) * 8 + (k & 7); }
DI void s5mat_unit(const Ctx& c, int layer, int unit) {
    const int g = unit >> 3, part = unit & 7;
    LAS float* pw = (LAS float*)c.lds;
    LAS float* bb = (LAS float*)(c.lds + 17408);
    LAS float* cc = (LAS float*)(c.lds + 33792);
    LAS float* kt = (LAS float*)(c.lds + 41984);
    const int tid = c.tid;
    for (int i = tid; i < 2 * 64 * 17; i += 512) { const int dir = i / 1088, rem = i - dir * 1088, n = rem / 17, tau = rem - n * 17;
        const float are = fminf(c.A->in[I_S5ARE][((layer * 2 + dir) * 32 + g) * 64 + n], -1e-4f), aim = c.A->in[I_S5AIM][((layer * 2 + dir) * 32 + g) * 64 + n];
        const float dt = expf(c.A->in[I_S5LDT][(layer * 2 + dir) * 32 + g]);
        const float mag = expf(are * dt * tau); float sn, cs; sincosf(aim * dt * tau, &sn, &cs);
        pw[i * 2] = mag * cs; pw[i * 2 + 1] = mag * sn; }
    for (int i = tid; i < 1024; i += 512) { const int s = i >> 6, n = i & 63; cc[i * 2] = c.A->in[I_S5CRE][(((size_t)layer * 32 + g) * 16 + s) * 64 + n]; cc[i * 2 + 1] = c.A->in[I_S5CIM][(((size_t)layer * 32 + g) * 16 + s) * 64 + n]; }
    __syncthreads();
    for (int i = tid; i < 2 * 64 * 16; i += 512) { const int dir = i >> 10, n = (i >> 4) & 63, s = i & 15;
        const float are = fminf(c.A->in[I_S5ARE][((layer * 2 + dir) * 32 + g) * 64 + n], -1e-4f), aim = c.A->in[I_S5AIM][((layer * 2 + dir) * 32 + g) * 64 + n];
        const float abr = pw[((dir * 64 + n) * 17 + 1) * 2] - 1.0f, abi = pw[((dir * 64 + n) * 17 + 1) * 2 + 1];
        const float den = are * are + aim * aim;
        const float cr = (abr * are + abi * aim) / den, ci = (abi * are - abr * aim) / den;
        const float br = c.A->in[I_S5BRE][(((size_t)layer * 32 + g) * 64 + n) * 16 + s], bi = c.A->in[I_S5BIM][(((size_t)layer * 32 + g) * 64 + n) * 16 + s];
        bb[i * 2] = cr * br - ci * bi; bb[i * 2 + 1] = cr * bi + ci * br; }
    __syncthreads();
    {   const int dir = tid >> 8, tau = (tid >> 4) & 15, s0 = ((tid >> 2) & 3) * 4, sp0 = (tid & 3) * 4;
        float acc[4][4];
#pragma unroll
        for (int a_ = 0; a_ < 4; ++a_)
#pragma unroll
            for (int b_ = 0; b_ < 4; ++b_) acc[a_][b_] = 0.f;
#pragma unroll 2
        for (int n = 0; n < 64; ++n) {
            const f32x2 pv = *(LAS f32x2*)(pw + ((dir * 64 + n) * 17 + tau) * 2);
            const f32x4 b01 = *(LAS f32x4*)(bb + ((dir * 64 + n) * 16 + sp0) * 2), b23 = *(LAS f32x4*)(bb + ((dir * 64 + n) * 16 + sp0 + 2) * 2);
#pragma unroll
            for (int a_ = 0; a_ < 4; ++a_) { const f32x2 cv = *(LAS f32x2*)(cc + ((s0 + a_) * 64 + n) * 2);
                const float zr = cv.x * pv.x - cv.y * pv.y, zi = cv.x * pv.y + cv.y * pv.x;
                acc[a_][0] += zr * b01[0] - zi * b01[1]; acc[a_][1] += zr * b01[2] - zi * b01[3]; acc[a_][2] += zr * b23[0] - zi * b23[1]; acc[a_][3] += zr * b23[2] - zi * b23[3]; } }
#pragma unroll
        for (int a_ = 0; a_ < 4; ++a_) *(LAS f32x4*)(kt + ((dir * 16 + tau) * 16 + s0 + a_) * 16 + sp0) = (f32x4){acc[a_][0], acc[a_][1], acc[a_][2], acc[a_][3]};
    }
    __syncthreads();
    bf16* W3T = wsp<bf16>(c, WS_W3T) + (size_t)g * 256 * 512;
    bf16* QT = wsp<bf16>(c, WS_QT) + (size_t)g * 256 * 256;
    const float* dsk = c.A->in[I_S5D] + layer * 512 + g * 16;
    for (int q = tid; q < 1024; q += 512) { const int col = part * 32 + (q >> 5), k0 = (q & 31) * 8; const int t = col >> 4, s_ = col & 15, tp = k0 >> 4, sp0 = k0 & 15;
        float v[8];
#pragma unroll
        for (int j = 0; j < 8; ++j) { float x = 0.f;
            if (t >= tp) x += kt[((0 * 16 + (t - tp)) * 16 + s_) * 16 + sp0 + j];
            if (tp >= t) x += kt[((1 * 16 + (tp - t)) * 16 + s_) * 16 + sp0 + j];
            if (col == k0 + j) x += dsk[s_];
            v[j] = x; }
        u32x4 w; w.x = pk2(v[0], v[1]); w.y = pk2(v[2], v[3]); w.z = pk2(v[4], v[5]); w.w = pk2(v[6], v[7]);
        *(u32x4*)(W3T + w3idx(col, k0)) = w; }
    for (int q = tid; q < 1024; q += 512) { const int col = part * 32 + (q >> 5), kk0 = (q & 31) * 8; const int t = col >> 4, s_ = col & 15, dir = kk0 >> 7, ri = (kk0 >> 6) & 1, n0 = kk0 & 63;
        const int e = dir == 0 ? t + 1 : 16 - t;
        float v[8];
#pragma unroll
        for (int j = 0; j < 8; ++j) { const int n = n0 + j;
            const float cr = cc[(s_ * 64 + n) * 2], ci = cc[(s_ * 64 + n) * 2 + 1], pr = pw[((dir * 64 + n) * 17 + e) * 2], pi = pw[((dir * 64 + n) * 17 + e) * 2 + 1];
            const float zr = cr * pr - ci * pi, zi = cr * pi + ci * pr; v[j] = ri == 0 ? zr : -zi; }
        u32x4 w; w.x = pk2(v[0], v[1]); w.y = pk2(v[2], v[3]); w.z = pk2(v[4], v[5]); w.w = pk2(v[6], v[7]);
        *(u32x4*)(W3T + w3idx(col, 256 + kk0)) = w; }
    for (int q = tid; q < 1024; q += 512) { const int col = part * 32 + (q >> 5), k0 = (q & 31) * 8; const int dir = col >> 7, ri = (col >> 6) & 1, n = col & 63, tp = k0 >> 4, sp0 = k0 & 15;
        const int e = dir == 0 ? 15 - tp : tp;
        const float pr = pw[((dir * 64 + n) * 17 + e) * 2], pi = pw[((dir * 64 + n) * 17 + e) * 2 + 1];
        float v[8];
#pragma unroll
        for (int j = 0; j < 8; ++j) { const float br = bb[((dir * 64 + n) * 16 + sp0 + j) * 2], bi = bb[((dir * 64 + n) * 16 + sp0 + j) * 2 + 1]; v[j] = ri == 0 ? pr * br - pi * bi : pr * bi + pi * br; }
        u32x4 w; w.x = pk2(v[0], v[1]); w.y = pk2(v[2], v[3]); w.z = pk2(v[4], v[5]); w.w = pk2(v[6], v[7]);
        *(u32x4*)(QT + qtidx(col, k0)) = w; }
    if (part == 0 && tid < 128) { const int dir = tid >> 6, n = tid & 63; float* A16 = wsp<float>(c, WS_A16);
        A16[((g * 2 + dir) * 64 + n) * 2] = pw[((dir * 64 + n) * 17 + 16) * 2]; A16[((g * 2 + dir) * 64 + n) * 2 + 1] = pw[((dir * 64 + n) * 17 + 16) * 2 + 1]; }
    __syncthreads();
}

DI void row_phase_first(const Ctx& c) {
    const float* MOD = wsp<float>(c, WS_MOD);
    const int stride = c.G * 8; int row = c.bid * 8 + c.wave;
    f32x4 xn[4];
    if (row < MT) row_load(row < MC ? c.A->in[I_CTX] + (size_t)row * 1024 : c.A->in[I_X] + (size_t)(row - MC) * 1024, c.lane, xn);
    for (; row < MT; row += stride) {
        f32x4 x[4], h[4];
#pragma unroll
        for (int i = 0; i < 4; ++i) x[i] = xn[i];
        const int nr = row + stride;
        if (nr < MT) row_load(nr < MC ? c.A->in[I_CTX] + (size_t)nr * 1024 : c.A->in[I_X] + (size_t)(nr - MC) * 1024, c.lane, xn);
        row_store(wsp<float>(c, WS_XRES) + (size_t)row * 1024, c.lane, x);
        const float* md = MOD + ((size_t)0 * 17 + row_modidx(row)) * 6144;
        row_modulate(x, md + 1024, md, c.lane, h);
        row_store_bf16(wsp<bf16>(c, WS_H) + (size_t)row * 1024, c.lane, h);
    }
}

DI void s5mat_dyn(const Ctx& c, int layer, unsigned* cnt) {
    volatile LAS int* tk = (volatile LAS int*)(c.lds + LDS_MISC + 1616);
    if (c.tid == 0) tk[0] = (int)__hip_atomic_fetch_add(cnt, 1u, __ATOMIC_RELAXED, __HIP_MEMORY_SCOPE_AGENT);
    __syncthreads();
    int cur = tk[0];
    __syncthreads();
    while (cur < 256) {
        unsigned t2 = 0; if (c.tid == 0) t2 = __hip_atomic_fetch_add(cnt, 1u, __ATOMIC_RELAXED, __HIP_MEMORY_SCOPE_AGENT);
        s5mat_unit(c, layer, cur);
        if (c.tid == 0) tk[0] = (int)t2;
        __syncthreads();
        cur = tk[0];
        __syncthreads();
    }
}
DI const bf16* headvec_src(const Ctx& c, int pass) {
    const int item = pass * 512 + c.tid; const int row = item / 20, vec = item - row * 20;
    const int col = vec < 8 ? C_AQ + vec * 64 : (vec < 10 ? C_AK + (vec - 8) * 64 : (vec < 18 ? C_GQ + (vec - 10) * 64 : C_GK + (vec - 18) * 64));
    return wsp<bf16>(c, WS_A) + (size_t)row * NPROJ + col;
}
DI void headvec_load(const Ctx& c, int pass, u32x4 (&raw)[8]) {
    const bf16* p = headvec_src(c, pass);
#pragma unroll
    for (int i = 0; i < 8; ++i) raw[i] = *(const u32x4*)(p + 8 * i);
}
DI void headvec_pass(const Ctx& c, int layer, int pass, const u32x4 (&raw)[8]) {
    const int item = pass * 512 + c.tid; const int row = item / 20, vec = item - row * 20;
    const bool isctx = row < MC;
    const int b = isctx ? row >> 8 : (row - MC) >> 11;
    const int t = isctx ? row & 255 : (row - MC) & 2047;
    int col, kvh = 0, type = 0; bool isq, norm; const float* nw = nullptr;
    if (vec < 8) { col = C_AQ + vec * 64; isq = true; norm = false; }
    else if (vec < 10) { col = C_AK + (vec - 8) * 64; isq = false; norm = false; kvh = vec - 8; type = 0; }
    else if (vec < 18) { col = C_GQ + (vec - 10) * 64; isq = true; norm = true; nw = c.A->in[I_GQN] + layer * 64; }
    else { col = C_GK + (vec - 18) * 64; isq = false; norm = true; nw = c.A->in[I_GKN] + layer * 64; kvh = vec - 18; type = 1; }
    bf16* p = wsp<bf16>(c, WS_A) + (size_t)row * NPROJ + col;
    float x[64];
#pragma unroll
    for (int i = 0; i < 8; ++i) { const u32x4 w = raw[i];
        x[8 * i] = bflo(w.x); x[8 * i + 1] = bfhi(w.x); x[8 * i + 2] = bflo(w.y); x[8 * i + 3] = bfhi(w.y); x[8 * i + 4] = bflo(w.z); x[8 * i + 5] = bfhi(w.z); x[8 * i + 6] = bflo(w.w); x[8 * i + 7] = bfhi(w.w); }
    LAS float* ropeL = (LAS float*)(c.lds + LDS_MISC + 2048);
    if (norm) { float ss = 0.f;
#pragma unroll
        for (int d = 0; d < 64; ++d) ss += x[d] * x[d];
        const float rs = rsqrtf(ss * (1.0f / 64.0f) + LN_EPS);
#pragma unroll
        for (int d4 = 0; d4 < 16; ++d4) { const f32x4 w = *(LAS f32x4*)(ropeL + 2048 + (vec >= 18 ? 64 : 0) + 4 * d4); x[4 * d4] *= rs * w[0]; x[4 * d4 + 1] *= rs * w[1]; x[4 * d4 + 2] *= rs * w[2]; x[4 * d4 + 3] *= rs * w[3]; } }
    if (!isctx) { LAS float* tr = ropeL + (t >> 6) * 32; LAS float* tc = ropeL + (t & 63) * 32;
#pragma unroll
        for (int i2 = 0; i2 < 8; ++i2) { const f32x4 a = *(LAS f32x4*)(tr + 4 * i2), bq = *(LAS f32x4*)(tc + 4 * i2);
#pragma unroll
            for (int u = 0; u < 2; ++u) { const int i = 2 * i2 + u; const float cr = a[2 * u], sr = a[2 * u + 1], cc = bq[2 * u], sc = bq[2 * u + 1];
                const float r0 = x[i] * cr - x[i + 16] * sr, r1 = x[i + 16] * cr + x[i] * sr; x[i] = r0; x[i + 16] = r1;
                const float c0 = x[32 + i] * cc - x[48 + i] * sc, c1 = x[48 + i] * cc + x[32 + i] * sc; x[32 + i] = c0; x[48 + i] = c1; } } }
    bf16* dst = p; float sc_ = QSCALE;
    if (!isq) { dst = wsp<bf16>(c, WS_KALL) + ((size_t)((type * 16 + b) * 2 + kvh) * KVPOS + (isctx ? t : CTXL + t)) * 64; sc_ = 1.0f; }
#pragma unroll
    for (int i = 0; i < 8; ++i) { u32x4 w; w.x = pk2(x[8 * i] * sc_, x[8 * i + 1] * sc_); w.y = pk2(x[8 * i + 2] * sc_, x[8 * i + 3] * sc_); w.z = pk2(x[8 * i + 4] * sc_, x[8 * i + 5] * sc_); w.w = pk2(x[8 * i + 6] * sc_, x[8 * i + 7] * sc_);
        *(u32x4*)(dst + 8 * i) = w; }
}
DI void headvec_passes(const Ctx& c, int layer) {
    constexpr int NPASS = (MT * 20) / 512;
    int u = c.bid; if (u >= NPASS) return;
    u32x4 cur[8], nxt[8];
    headvec_load(c, u, cur);
    for (; u < NPASS; u += c.G) {
        const bool more = u + c.G < NPASS;
        if (more) headvec_load(c, u + c.G, nxt);
        headvec_pass(c, layer, u, cur);
        if (more) {
#pragma unroll
            for (int i = 0; i < 8; ++i) cur[i] = nxt[i]; }
    }
}
DI void headvec_tables(const Ctx& c, int layer) {
    LAS float* ropeL = (LAS float*)(c.lds + LDS_MISC + 2048);
    {   const f32x4 rv = *(const f32x4*)(wsp<float>(c, WS_ROPE) + c.tid * 4);
        float qn = 0.f, kn = 0.f; if (c.tid < 64) { qn = c.A->in[I_GQN][layer * 64 + c.tid]; kn = c.A->in[I_GKN][layer * 64 + c.tid]; }
        *(LAS f32x4*)(ropeL + c.tid * 4) = rv;
        if (c.tid < 64) { ropeL[2048 + c.tid] = qn; ropeL[2048 + 64 + c.tid] = kn; } }
    __syncthreads();
}
DI void rope_table(const Ctx& c) {
    for (int i = c.tid; i < 1024; i += 512) { const int v = i >> 4, f = i & 15; const float ang = (float)v * exp2f(-(float)f * (13.287712379549449f / 16.0f)); float sn, cs; sincosf(ang, &sn, &cs);
        wsp<float>(c, WS_ROPE)[i * 2] = cs; wsp<float>(c, WS_ROPE)[i * 2 + 1] = sn; }
}
DI void prep_unit(const Ctx& c, int layer, int unit) {
    const int tok0 = unit * 64;
    const bool isctx = tok0 < MC;
    const int b = isctx ? tok0 >> 8 : (tok0 - MC) >> 11;
    const int t0 = isctx ? tok0 & 255 : (tok0 - MC) & 2047;
    const int L = isctx ? CTXL : SEQL;
    const int kpos0 = isctx ? t0 : CTXL + t0;
    bf16* PROJ = wsp<bf16>(c, WS_A);
    const int tid = c.tid, lane = c.lane, wave = c.wave;
    {
        LAS bf16* vt = (LAS bf16*)c.lds;
        const int tr = tid >> 3, c8 = (tid & 7) * 8;
#pragma unroll
        for (int q = 0; q < 4; ++q) { const int vcol = ((q >> 1) ? C_GV : C_AV) + (q & 1) * 64;
            *(LAS u32x4*)(vt + (q * 64 + tr) * 72 + c8) = *(const u32x4*)(PROJ + (size_t)(tok0 + tr) * NPROJ + vcol + c8); }
        __syncthreads();
#pragma unroll
        for (int q = 0; q < 4; ++q) { const int d = tr, t8 = c8;
            LAS bf16* s = vt + (q * 64 + t8) * 72 + d;
            u32x4 w; w.x = (unsigned)s[0] | ((unsigned)s[72] << 16); w.y = (unsigned)s[144] | ((unsigned)s[216] << 16); w.z = (unsigned)s[288] | ((unsigned)s[360] << 16); w.w = (unsigned)s[432] | ((unsigned)s[504] << 16);
            *(u32x4*)(wsp<bf16>(c, WS_VTALL) + ((size_t)(((q >> 1) * 16 + b) * 2 + (q & 1)) * 64 + d) * KVPOS + kpos0 + t8) = w; }
        __syncthreads();
    }
    {
        LAS bf16* tin = (LAS bf16*)c.lds;
        LAS bf16* tout = (LAS bf16*)(c.lds + 66 * 264 * 2);
        const int cg = tok0 >> 7, s0 = tok0 & 127;
        const float* cw = c.A->in[I_CONVW] + (size_t)layer * 3 * 1024;
        const float* cb_ = c.A->in[I_CONVB] + (size_t)layer * 1024;
#define PREP_LOADBLK(cbi) { const int scol_ = (cbi) == 0 ? C_SX : ((cbi) == 1 ? C_SX + 256 : ((cbi) == 2 ? C_SB : C_SC)); _Pragma("unroll") for (int q = 0; q < 5; ++q) { const int i = tid + 512 * q; const int rr = i >> 5, ch = (i & 31) * 8; const int pos = t0 - 1 + rr; \
            pvv[q] = (u32x4){0u, 0u, 0u, 0u}; if (i < 66 * 32 && pos >= 0 && pos < L) pvv[q] = *(const u32x4*)(PROJ + (size_t)(tok0 - 1 + rr) * NPROJ + scol_ + ch); } }
        u32x4 pvv[5];
        PREP_LOADBLK(0)
#pragma unroll 1
        for (int cb = 0; cb < 4; ++cb) {
#pragma unroll
            for (int q = 0; q < 5; ++q) { const int i = tid + 512 * q; if (i < 66 * 32) *(LAS u32x4*)(tin + (i >> 5) * 264 + (i & 31) * 8) = pvv[q]; }
            const int c2 = tid & 127, tq = tid >> 7; const int ch = cb * 256 + 2 * c2;
            const float w0a = cw[ch], w0b = cw[ch + 1], w1a = cw[1024 + ch], w1b = cw[1024 + ch + 1], w2a = cw[2048 + ch], w2b = cw[2048 + ch + 1], ba = cb_[ch], bbv = cb_[ch + 1];
            __syncthreads();
            if (cb < 3) PREP_LOADBLK(cb + 1)
            {
                unsigned pv = *(LAS unsigned*)(tin + (tq * 16) * 264 + 2 * c2), cv = *(LAS unsigned*)(tin + (tq * 16 + 1) * 264 + 2 * c2);
#pragma unroll 4
                for (int t = 0; t < 16; ++t) { const unsigned nv = *(LAS unsigned*)(tin + (tq * 16 + t + 2) * 264 + 2 * c2);
                    const float ya = w0a * bflo(pv) + w1a * bflo(cv) + w2a * bflo(nv) + ba, yb = w0b * bfhi(pv) + w1b * bfhi(cv) + w2b * bfhi(nv) + bbv;
                    *(LAS unsigned*)(tout + (tq * 16 + t) * 264 + 2 * c2) = pk2(siluf_(ya), siluf_(yb)); pv = cv; cv = nv; } }
            __syncthreads();
            if (cb >= 2) {
                bf16* dst = wsp<bf16>(c, cb == 2 ? WS_BROW : WS_CROW) + (size_t)(cg * 4 + (s0 >> 5)) * 16 * 512;
#pragma unroll
                for (int i = 0; i < 4; ++i) { const int pc = tid + 512 * i; const int t = pc & 63, kq = pc >> 6;
                    *(u32x4*)(dst + ((size_t)((t >> 5) * 16 + (kq >> 1)) * 64 + (kq & 1) * 32 + (t & 31)) * 8) = *(LAS u32x4*)(tout + t * 264 + kq * 8); } }
            if (cb <= 2) {
                bf16* dst = cb == 2 ? wsp<bf16>(c, WS_BT) + (size_t)cg * 8 * 8 * 512 : wsp<bf16>(c, WS_XT) + (size_t)(cg * 16 + cb * 8) * 8 * 512;
#pragma unroll
                for (int i = 0; i < 4; ++i) { const int pc = tid + 512 * i; const int ch = pc & 255, hh = (pc >> 8) & 1, ksl = pc >> 9;
                    LAS bf16* sp = tout + (16 * ksl + 4 * hh) * 264 + ch;
                    u32x4 w; w.x = (unsigned)sp[0] | ((unsigned)sp[264] << 16); w.y = (unsigned)sp[528] | ((unsigned)sp[792] << 16);
                    w.z = (unsigned)sp[8 * 264] | ((unsigned)sp[9 * 264] << 16); w.w = (unsigned)sp[10 * 264] | ((unsigned)sp[11 * 264] << 16);
                    *(u32x4*)(dst + ((size_t)((ch >> 5) * 8 + (s0 >> 4) + ksl) * 64 + hh * 32 + (ch & 31)) * 8) = w; } }
            __syncthreads();
        }
    }
    for (int i = tid; i < 64 * 16; i += 512) { const int tok = i >> 4, k = i & 15;
        const float x = bf2f(PROJ[(size_t)(tok0 + tok) * NPROJ + C_DT + k]) + c.A->in[I_DTB][layer * 16 + k];
        wsp<float>(c, WS_DT)[(size_t)(tok0 + tok) * 16 + k] = fmaxf(x, 0.f) + log1pf(__expf(-fabsf(x))); }
}
struct AttnJob {
    const bf16* q; int q_row0; int qcol;
    const bf16* k; const bf16* vt;
    int ntile, lt_lo;
    int window, qpos0;
    const float* sink;
    bf16* out; int out_col;
};
DI int attn_tile_pos(int i, int lt_lo) { return i < 4 ? 64 * i : CTXL + 64 * (lt_lo + i - 4); }
struct AttnPre { bf16x8 qf[4]; u32x4 k0, v0; float sink; };
DI void attn_preload(const Ctx& c, const AttnJob& J, AttnPre& P) {
    const int tid = c.tid, lane = c.lane, wave = c.wave;
    const int g = wave >> 1, qs = (wave & 1) * 32, r = lane & 31, hh = lane >> 5;
    const int qrow = J.q_row0 + qs + r;
#pragma unroll
    for (int s = 0; s < 4; ++s) P.qf[s] = *(const bf16x8*)(J.q + (size_t)qrow * NPROJ + J.qcol + g * 64 + 16 * s + 8 * hh);
    const int srow = tid >> 3, sch = (tid & 7) * 8; const int p0 = attn_tile_pos(0, J.lt_lo);
    P.k0 = *(const u32x4*)(J.k + (size_t)(p0 + srow) * 64 + sch); P.v0 = *(const u32x4*)(J.vt + (size_t)srow * KVPOS + p0 + sch);
    P.sink = J.sink ? J.sink[g] : 0.f;
}
DI void attn_unit(const Ctx& c, const AttnJob& J, AttnPre& P, const AttnJob& JN, const bool has_next) {
    LAS bf16* Ks = (LAS bf16*)c.lds;
    LAS bf16* Vs = (LAS bf16*)(c.lds + 2 * 64 * 72 * 2);
    const int tid = c.tid, lane = c.lane, wave = c.wave;
    const int g = wave >> 1, qs = (wave & 1) * 32, r = lane & 31, hh = lane >> 5;
    const int qrow = J.q_row0 + qs + r;
    bf16x8 qf[4];
#pragma unroll
    for (int s = 0; s < 4; ++s) qf[s] = P.qf[s];
    float m_run = J.sink ? P.sink * LOG2E : -1e30f;
    float l_run = (J.sink && hh == 0) ? 1.0f : 0.0f;
    f32x16 O0, O1;
#pragma unroll
    for (int i = 0; i < 16; ++i) { O0[i] = 0.f; O1[i] = 0.f; }
    const int srow = tid >> 3, sch = (tid & 7) * 8;
    u32x4 kreg = P.k0, vreg = P.v0;
    *(LAS u32x4*)(Ks + srow * 72 + sch) = kreg; *(LAS u32x4*)(Vs + srow * 72 + sch) = vreg;
    __syncthreads();
    if (has_next) attn_preload(c, JN, P);
#pragma unroll 1
    for (int i = 0; i < J.ntile; ++i) {
        const int cur = i & 1;
        const bool more = (i + 1 < J.ntile);
        if (more) { const int p1 = attn_tile_pos(i + 1, J.lt_lo); kreg = *(const u32x4*)(J.k + (size_t)(p1 + srow) * 64 + sch); vreg = *(const u32x4*)(J.vt + (size_t)srow * KVPOS + p1 + sch); }
        LAS bf16* Kc = Ks + cur * 64 * 72; LAS bf16* Vc = Vs + cur * 64 * 72;
        f32x16 S0, S1;
#pragma unroll
        for (int e = 0; e < 16; ++e) { S0[e] = 0.f; S1[e] = 0.f; }
#pragma unroll
        for (int s = 0; s < 4; ++s) {
            const bf16x8 a0 = *(LAS bf16x8*)(Kc + r * 72 + 16 * s + 8 * hh), a1 = *(LAS bf16x8*)(Kc + (32 + r) * 72 + 16 * s + 8 * hh);
            S0 = MFMA32(a0, qf[s], S0); S1 = MFMA32(a1, qf[s], S1);
        }
        if (J.window && i >= 4) {
            const int kbase = 64 * (J.lt_lo + i - 4) - (J.qpos0 + qs + r);
#pragma unroll
            for (int e = 0; e < 16; ++e) { const int d0 = kbase + crow(e, hh), d1 = d0 + 32;
                if (d0 > 128 || d0 < -128) S0[e] = -1e30f;
                if (d1 > 128 || d1 < -128) S1[e] = -1e30f; }
        }
        float mx = S0[0];
#pragma unroll
        for (int e = 1; e < 16; ++e) mx = fmaxf(mx, S0[e]);
#pragma unroll
        for (int e = 0; e < 16; ++e) mx = fmaxf(mx, S1[e]);
        mx = fmaxf(mx, __shfl_xor(mx, 32));
        if (__builtin_amdgcn_ballot_w64(mx > m_run + 8.0f) != 0ull) {
            const float m_new = fmaxf(m_run, mx);
            const float alpha = __builtin_amdgcn_exp2f(m_run - m_new);
            m_run = m_new; l_run *= alpha;
#pragma unroll
            for (int e = 0; e < 16; ++e) { O0[e] *= alpha; O1[e] *= alpha; }
        }
        {
            const f32x2 mm = {m_run, m_run}; f32x2 ps2 = {0.f, 0.f};
#pragma unroll
            for (int e = 0; e < 8; ++e) {
                f32x2 a = (f32x2){S0[2 * e], S0[2 * e + 1]} - mm, b2 = (f32x2){S1[2 * e], S1[2 * e + 1]} - mm;
                a.x = __builtin_amdgcn_exp2f(a.x); a.y = __builtin_amdgcn_exp2f(a.y); b2.x = __builtin_amdgcn_exp2f(b2.x); b2.y = __builtin_amdgcn_exp2f(b2.y);
                ps2 += a; ps2 += b2;
                S0[2 * e] = a.x; S0[2 * e + 1] = a.y; S1[2 * e] = b2.x; S1[2 * e + 1] = b2.y;
            }
            l_run += ps2.x + ps2.y;
        }
        bf16x8 pf[2][2];
        pf[0][0] = pack8(S0[0], S0[1], S0[2], S0[3], S0[4], S0[5], S0[6], S0[7]); pf[0][1] = pack8(S0[8], S0[9], S0[10], S0[11], S0[12], S0[13], S0[14], S0[15]);
        pf[1][0] = pack8(S1[0], S1[1], S1[2], S1[3], S1[4], S1[5], S1[6], S1[7]); pf[1][1] = pack8(S1[8], S1[9], S1[10], S1[11], S1[12], S1[13], S1[14], S1[15]);
#pragma unroll
        for (int kh = 0; kh < 2; ++kh)
#pragma unroll
            for (int s2 = 0; s2 < 2; ++s2) {
                const int ko = 32 * kh + 16 * s2 + 4 * hh;
                { const u32x2 lo = *(LAS u32x2*)(Vc + r * 72 + ko), hi = *(LAS u32x2*)(Vc + r * 72 + ko + 8); u32x4 w = {lo.x, lo.y, hi.x, hi.y}; O0 = MFMA32(__builtin_bit_cast(bf16x8, w), pf[kh][s2], O0); }
                { const u32x2 lo = *(LAS u32x2*)(Vc + (32 + r) * 72 + ko), hi = *(LAS u32x2*)(Vc + (32 + r) * 72 + ko + 8); u32x4 w = {lo.x, lo.y, hi.x, hi.y}; O1 = MFMA32(__builtin_bit_cast(bf16x8, w), pf[kh][s2], O1); }
            }
        if (more) { *(LAS u32x4*)(Ks + (cur ^ 1) * 64 * 72 + srow * 72 + sch) = kreg; *(LAS u32x4*)(Vs + (cur ^ 1) * 64 * 72 + srow * 72 + sch) = vreg; }
        __syncthreads();
    }
    l_run += __shfl_xor(l_run, 32);
    const float inv = 1.0f / l_run;
    bf16* op = J.out + (size_t)qrow * 512 + J.out_col + g * 64 + 4 * hh;
#pragma unroll
    for (int k4 = 0; k4 < 4; ++k4) {
        u32x2 w0; w0.x = pk2(O0[4 * k4] * inv, O0[4 * k4 + 1] * inv); w0.y = pk2(O0[4 * k4 + 2] * inv, O0[4 * k4 + 3] * inv); *(u32x2*)(op + 8 * k4) = w0;
        u32x2 w1; w1.x = pk2(O1[4 * k4] * inv, O1[4 * k4 + 1] * inv); w1.y = pk2(O1[4 * k4 + 2] * inv, O1[4 * k4 + 3] * inv); *(u32x2*)(op + 32 + 8 * k4) = w1;
    }
}
DI AttnJob attn_job(const Ctx& c, int layer, int jl) {
    int j = jl;
    if (c.G == 256 && jl < 2048) { const int i = (jl >> 8) & 3, w = jl & 255; j = (jl & ~1023) + ((i * 8 + (w & 7)) << 5) + (w >> 3); }
    AttnJob J; J.q = wsp<bf16>(c, WS_A); J.window = 0; J.qpos0 = 0; J.lt_lo = 0; J.sink = nullptr;
    if (j < 1024) { const int b = j >> 6, kvh = (j >> 5) & 1, qb = j & 31;
        J.q_row0 = MC + b * SEQL + 64 * qb; J.qcol = C_GQ + kvh * 256;
        J.k = wsp<bf16>(c, WS_KALL) + (size_t)((16 + b) * 2 + kvh) * KVPOS * 64; J.vt = wsp<bf16>(c, WS_VTALL) + (size_t)((16 + b) * 2 + kvh) * 64 * KVPOS;
        J.ntile = 36; J.out = wsp<bf16>(c, WS_B) + (size_t)2 * MT * 512; J.out_col = kvh * 256; }
    else if (j < 2048) { const int idx = j - 1024; const int b = idx >> 6, kvh = (idx >> 5) & 1, qb = idx & 31;
        J.q_row0 = MC + b * SEQL + 64 * qb; J.qcol = C_AQ + kvh * 256;
        J.k = wsp<bf16>(c, WS_KALL) + (size_t)(b * 2 + kvh) * KVPOS * 64; J.vt = wsp<bf16>(c, WS_VTALL) + (size_t)(b * 2 + kvh) * 64 * KVPOS;
        const int lo = qb - 2 < 0 ? 0 : qb - 2, hi = qb + 3 > 32 ? 32 : qb + 3;
        J.ntile = 4 + hi - lo; J.lt_lo = lo; J.window = 1; J.qpos0 = 64 * qb; J.sink = c.A->in[I_SINK] + layer * 8 + kvh * 4; J.out = wsp<bf16>(c, WS_B); J.out_col = kvh * 256; }
    else { const int idx = j - 2048; const int type = idx >> 7, b = (idx >> 3) & 15, kvh = (idx >> 2) & 1, qb = idx & 3;
        J.q_row0 = b * CTXL + 64 * qb; J.qcol = (type ? C_GQ : C_AQ) + kvh * 256;
        J.k = wsp<bf16>(c, WS_KALL) + (size_t)((type * 16 + b) * 2 + kvh) * KVPOS * 64; J.vt = wsp<bf16>(c, WS_VTALL) + (size_t)((type * 16 + b) * 2 + kvh) * 64 * KVPOS;
        J.ntile = 4; J.sink = type ? nullptr : c.A->in[I_SINK] + layer * 8 + kvh * 4; J.out = wsp<bf16>(c, WS_B) + (size_t)(type ? 2 : 0) * MT * 512; J.out_col = kvh * 256; }
    return J;
}
DI void attn_units(const Ctx& c, int layer) {
    int j = c.bid; if (j >= 2304) return;
    AttnJob J = attn_job(c, layer, j); AttnPre P; attn_preload(c, J, P);
    for (; j < 2304; j += c.G) {
        const bool has_next = j + c.G < 2304;
        AttnJob JN = attn_job(c, layer, has_next ? j + c.G : j);
        attn_unit(c, J, P, JN, has_next);
        J = JN;
    }
}
DI float wave_incl_scan(float v, int lane) {
#pragma unroll
    for (int off = 1; off < 64; off <<= 1) { const float t = __shfl_up(v, off); if (lane >= off) v += t; }
    return v;
}
DI bf16x8 ldg8(const bf16* p) { return *(const bf16x8*)p; }
DI float ssd_cum(const Ctx& c, int layer, int cg, int h, int dir, LAS float* cum, LAS float* dtv) {
    const int lane = c.lane;
    const float a = -__expf(c.A->in[I_ALOG][(layer * 2 + dir) * 8 + h]);
    const float* DT = wsp<float>(c, WS_DT) + (size_t)cg * 128 * 16 + dir * 8 + h;
    const float d0 = DT[(2 * lane) * 16], d1 = DT[(2 * lane + 1) * 16];
    const float da0 = d0 * a, da1 = d1 * a;
    const float incl = wave_incl_scan(da0 + da1, lane);
    const float tot = __shfl(incl, 63);
    float c0, c1;
    if (dir == 0) { c0 = incl - da1; c1 = incl; }
    else { c1 = tot - incl + da1; c0 = c1 + da0; }
    cum[2 * lane] = c0; cum[2 * lane + 1] = c1; dtv[2 * lane] = d0; dtv[2 * lane + 1] = d1;
    return tot;
}
DI void ssd_states_unit(const Ctx& c, int layer, int unit) {
    const int cg = unit >> 1, g = unit & 1;
    const int tid = c.tid, lane = c.lane, wave = c.wave, hh = lane >> 5;
    const int j = wave & 3, dir = wave >> 2, h = 4 * g + j;
    LAS bf16* XTs = (LAS bf16*)c.lds;
    LAS bf16* BTs = (LAS bf16*)(c.lds + 65536);
    LAS float* cum = (LAS float*)(c.lds + 98304) + wave * 256; LAS float* dtv = cum + 128;
    {
        const bf16* xs = wsp<bf16>(c, WS_XT) + (size_t)(cg * 16 + 8 * g) * 8 * 512;
        const bf16* bs = wsp<bf16>(c, WS_BT) + (size_t)(cg * 8 + 4 * g) * 8 * 512;
        u32x4 v[12];
#pragma unroll
        for (int i = 0; i < 8; ++i) v[i] = *(const u32x4*)(xs + (size_t)(tid + 512 * i) * 8);
#pragma unroll
        for (int i = 0; i < 4; ++i) v[8 + i] = *(const u32x4*)(bs + (size_t)(tid + 512 * i) * 8);
        const float tot = ssd_cum(c, layer, cg, h, dir, cum, dtv);
        { const float w0 = dtv[2 * lane] * __expf(tot - cum[2 * lane]), w1 = dtv[2 * lane + 1] * __expf(tot - cum[2 * lane + 1]); cum[2 * lane] = w0; cum[2 * lane + 1] = w1; }
        if (lane == 0) wsp<float>(c, WS_ADEC)[cg * 16 + dir * 8 + h] = tot;
#pragma unroll
        for (int i = 0; i < 8; ++i) *(LAS u32x4*)(XTs + (tid + 512 * i) * 8) = v[i];
#pragma unroll
        for (int i = 0; i < 4; ++i) *(LAS u32x4*)(BTs + (tid + 512 * i) * 8) = v[8 + i];
    }
    __syncthreads();
    f32x16 acc[2][4];
#pragma unroll
    for (int a_ = 0; a_ < 2; ++a_)
#pragma unroll
        for (int b_ = 0; b_ < 4; ++b_)
#pragma unroll
            for (int e = 0; e < 16; ++e) acc[a_][b_][e] = 0.f;
#pragma unroll 2
    for (int ks = 0; ks < 8; ++ks) {
        const f32x4 wa = *(LAS f32x4*)(cum + 16 * ks + 4 * hh), wb = *(LAS f32x4*)(cum + 16 * ks + 8 + 4 * hh);
        bf16x8 af[2];
#pragma unroll
        for (int ph = 0; ph < 2; ++ph) { const u32x4 raw = *(LAS u32x4*)(XTs + (((2 * j + ph) * 8 + ks) * 64 + lane) * 8);
            af[ph] = pack8(bflo(raw.x) * wa[0], bfhi(raw.x) * wa[1], bflo(raw.y) * wa[2], bfhi(raw.y) * wa[3], bflo(raw.z) * wb[0], bfhi(raw.z) * wb[1], bflo(raw.w) * wb[2], bfhi(raw.w) * wb[3]); }
#pragma unroll
        for (int nt = 0; nt < 4; ++nt) { const bf16x8 bfr = *(LAS bf16x8*)(BTs + ((nt * 8 + ks) * 64 + lane) * 8);
            acc[0][nt] = MFMA32(af[0], bfr, acc[0][nt]); acc[1][nt] = MFMA32(af[1], bfr, acc[1][nt]); }
    }
    const int r = lane & 31;
    bf16* SL = wsp<bf16>(c, WS_D) + (size_t)(cg * 16 + dir * 8 + h) * 8192;
#pragma unroll
    for (int ph = 0; ph < 2; ++ph)
#pragma unroll
        for (int nt = 0; nt < 4; ++nt)
#pragma unroll
            for (int e = 0; e < 16; ++e) SL[(32 * ph + crow(e, hh)) * 128 + 32 * nt + r] = f2bf(acc[ph][nt][e]);
    __syncthreads();
}
DI int ssd_chunk_of(int b, int dir, int step) {
    if (dir == 0) return step < 2 ? 2 * b + step : 32 + 16 * b + (step - 2);
    return step < 2 ? 2 * b + (1 - step) : 32 + 16 * b + (15 - (step - 2));
}
DI void ssd_recur_load(const Ctx& c, int it, u32x2 (&loc)[18], float (&dec)[18]) {
    const bf16* SL = wsp<bf16>(c, WS_D); const float* ADEC = wsp<float>(c, WS_ADEC);
    const int e4 = it & 2047, dh = (it >> 11) & 15, b = it >> 15; const int dir = dh >> 3;
#pragma unroll
    for (int s = 0; s < 18; ++s) { const int cg = ssd_chunk_of(b, dir, s); loc[s] = *(const u32x2*)(SL + (size_t)(cg * 16 + dh) * 8192 + e4 * 4); dec[s] = ADEC[cg * 16 + dh]; }
}
DI void ssd_recur(const Ctx& c, int first, int stride) {
    bf16* HB = wsp<bf16>(c, WS_HB);
    constexpr int NIT = 16 * 16 * 2048;
    u32x2 loc[18], locn[18]; float dec[18], decn[18];
    if (first < NIT) ssd_recur_load(c, first, loc, dec);
    for (int it = first; it < NIT; it += stride) {
        const int e4 = it & 2047, dh = (it >> 11) & 15, b = it >> 15; const int dir = dh >> 3;
        const int p = e4 >> 5, n = (e4 & 31) * 4;
        const size_t fo = ((size_t)((p >> 5) * 8 + (n >> 4)) * 64 + ((n >> 3) & 1) * 32 + (p & 31)) * 8 + (n & 7);
        const bool more = it + stride < NIT;
        if (more) ssd_recur_load(c, it + stride, locn, decn);
        f32x4 st = {0.f, 0.f, 0.f, 0.f};
#pragma unroll
        for (int s = 0; s < 18; ++s) { const int cg = ssd_chunk_of(b, dir, s);
            u32x2 w; w.x = pk2(st[0], st[1]); w.y = pk2(st[2], st[3]); *(u32x2*)(HB + (size_t)(cg * 16 + dh) * 8192 + fo) = w;
            st = st * __expf(dec[s]) + (f32x4){bflo(loc[s].x), bfhi(loc[s].x), bflo(loc[s].y), bfhi(loc[s].y)}; }
        if (more) {
#pragma unroll
            for (int s = 0; s < 18; ++s) { loc[s] = locn[s]; dec[s] = decn[s]; } }
    }
}
struct SsdStage { u32x4 v[14]; u32x2 zw[4]; };
DI int ssd_out_unit_of(int slot_linear, int G) {
    if (G != 256) return slot_linear;
    const int k = slot_linear >> 8, w = slot_linear & 255, x = w & 7, j = w >> 3;
    const int sl = k * 32 + j, q = (sl >> 2) * 8 + x;
    return (q >> 1) * 8 + (q & 1) * 4 + (sl & 3);
}
DI void ssd_out_load(const Ctx& c, int slot, SsdStage& S) {
    const int unit = ssd_out_unit_of(slot, c.G);
    const int cg = unit >> 3, h = unit & 7, g = h >> 2;
    const int tid = c.tid, lane = c.lane, wave = c.wave, r = lane & 31, hh = lane >> 5;
    const int lb = wave & 3, ph = wave >> 2, l = 32 * lb + r;
    const bf16* cs = wsp<bf16>(c, WS_CROW) + (size_t)(cg * 64 + g * 8) * 512;
    const bf16* bs = wsp<bf16>(c, WS_BROW) + (size_t)(cg * 64 + g * 8) * 512;
    const bf16* xs = wsp<bf16>(c, WS_XT) + (size_t)(cg * 16 + 2 * h) * 8 * 512;
    const bf16* hs = wsp<bf16>(c, WS_HB) + (size_t)(cg * 16 + h) * 8192;
#pragma unroll
    for (int i = 0; i < 4; ++i) S.v[i] = *(const u32x4*)(cs + (size_t)i * 16 * 512 + (size_t)tid * 8);
#pragma unroll
    for (int i = 0; i < 4; ++i) S.v[4 + i] = *(const u32x4*)(bs + (size_t)i * 16 * 512 + (size_t)tid * 8);
#pragma unroll
    for (int i = 0; i < 2; ++i) S.v[8 + i] = *(const u32x4*)(xs + (size_t)(tid + 512 * i) * 8);
#pragma unroll
    for (int i = 0; i < 4; ++i) S.v[10 + i] = *(const u32x4*)(hs + (size_t)(i >> 1) * 8 * 8192 + (size_t)(tid + 512 * (i & 1)) * 8);
    const size_t tok = (size_t)cg * 128 + l;
#pragma unroll
    for (int k4 = 0; k4 < 4; ++k4) S.zw[k4] = *(const u32x2*)(wsp<bf16>(c, WS_A) + tok * NPROJ + C_SZ + h * 64 + 32 * ph + 8 * k4 + 4 * hh);
}
DI void ssd_out_units(const Ctx& c, int layer, int first, int stride, int nunits) {
    const int tid = c.tid, lane = c.lane, wave = c.wave, r = lane & 31, hh = lane >> 5;
    const int lb = wave & 3, ph = wave >> 2, l = 32 * lb + r;
    LAS bf16* CFs = (LAS bf16*)c.lds;
    LAS bf16* BFs = (LAS bf16*)(c.lds + 32768);
    LAS bf16* XTs = (LAS bf16*)(c.lds + 65536);
    LAS bf16* HBs = (LAS bf16*)(c.lds + 81920);
    LAS float* cumf = (LAS float*)(c.lds + 114688); LAS float* dtf = cumf + 128; LAS float* cumb = cumf + 256; LAS float* dtb = cumf + 384;
    SsdStage S;
    if (first < nunits) ssd_out_load(c, first, S);
    for (int slot = first; slot < nunits; slot += stride) {
        const int unit = ssd_out_unit_of(slot, c.G); const int cg = unit >> 3, h = unit & 7;
        u32x2 zw[4];
#pragma unroll
        for (int k4 = 0; k4 < 4; ++k4) zw[k4] = S.zw[k4];
        if (wave == 0) ssd_cum(c, layer, cg, h, 0, cumf, dtf);
        if (wave == 1) ssd_cum(c, layer, cg, h, 1, cumb, dtb);
#pragma unroll
        for (int i = 0; i < 4; ++i) *(LAS u32x4*)(CFs + (i * 512 + tid) * 8) = S.v[i];
#pragma unroll
        for (int i = 0; i < 4; ++i) *(LAS u32x4*)(BFs + (i * 512 + tid) * 8) = S.v[4 + i];
#pragma unroll
        for (int i = 0; i < 2; ++i) *(LAS u32x4*)(XTs + (i * 512 + tid) * 8) = S.v[8 + i];
#pragma unroll
        for (int i = 0; i < 4; ++i) *(LAS u32x4*)(HBs + (i * 512 + tid) * 8) = S.v[10 + i];
        const float Dh = c.A->in[I_SSDD][layer * 8 + h];
        f32x4 nwq[4];
#pragma unroll
        for (int k4 = 0; k4 < 4; ++k4) nwq[k4] = *(const f32x4*)(c.A->in[I_SSDNW] + layer * 512 + h * 64 + 32 * ph + 8 * k4 + 4 * hh);
        __syncthreads();
        if (slot + stride < nunits) ssd_out_load(c, slot + stride, S);
        const size_t tok = (size_t)cg * 128 + l;
        bf16x8 cf[8];
#pragma unroll
        for (int ks = 0; ks < 8; ++ks) cf[ks] = *(LAS bf16x8*)(CFs + ((lb * 8 + ks) * 64 + lane) * 8);
        f32x16 y;
#pragma unroll
        for (int e = 0; e < 16; ++e) y[e] = 0.f;
#pragma unroll
        for (int dir = 0; dir < 2; ++dir) {
            f32x16 t;
#pragma unroll
            for (int e = 0; e < 16; ++e) t[e] = 0.f;
            {   bf16x8 af[8];
#pragma unroll
                for (int ks = 0; ks < 8; ++ks) af[ks] = *(LAS bf16x8*)(HBs + ((dir * 16 + ph * 8 + ks) * 64 + lane) * 8);
                __builtin_amdgcn_sched_barrier(0);
#pragma unroll
                for (int ks = 0; ks < 8; ++ks) t = MFMA32(af[ks], cf[ks], t); }
            const float ed = __expf(dir == 0 ? cumf[l] : cumb[l]);
#pragma unroll
            for (int e = 0; e < 16; ++e) y[e] += t[e] * ed;
        }
        const float cfl = cumf[l], cbl = cumb[l];
#pragma unroll 1
        for (int sb = 0; sb < 4; ++sb) {
            f32x16 X;
#pragma unroll
            for (int e = 0; e < 16; ++e) X[e] = 0.f;
            {   bf16x8 af[8];
#pragma unroll
                for (int ks = 0; ks < 8; ++ks) af[ks] = *(LAS bf16x8*)(BFs + ((sb * 8 + ks) * 64 + lane) * 8);
                __builtin_amdgcn_sched_barrier(0);
#pragma unroll
                for (int ks = 0; ks < 8; ++ks) X = MFMA32(af[ks], cf[ks], X); }
#pragma unroll
            for (int dir = 0; dir < 2; ++dir) {
                if (dir == 0 ? (sb > lb) : (sb < lb)) continue;
                LAS float* cum = dir == 0 ? cumf : cumb; LAS float* dtv = dir == 0 ? dtf : dtb; const float cl = dir == 0 ? cfl : cbl;
                float mv[16];
#pragma unroll
                for (int q = 0; q < 4; ++q) { const int sq = 32 * sb + 8 * q + 4 * hh; const f32x4 cs = *(LAS f32x4*)(cum + sq), ds = *(LAS f32x4*)(dtv + sq);
#pragma unroll
                    for (int i = 0; i < 4; ++i) { const int s_ = sq + i; const bool valid = dir == 0 ? (s_ <= l) : (s_ >= l);
                        float v = valid ? X[4 * q + i] * ds[i] * __expf(cl - cs[i]) : 0.f;
                        if (dir == 0 && s_ == l) v += Dh;
                        mv[4 * q + i] = v; } }
                const bf16x8 p0 = pack8(mv[0], mv[1], mv[2], mv[3], mv[4], mv[5], mv[6], mv[7]), p1 = pack8(mv[8], mv[9], mv[10], mv[11], mv[12], mv[13], mv[14], mv[15]);
                y = MFMA32(*(LAS bf16x8*)(XTs + ((ph * 8 + 2 * sb) * 64 + lane) * 8), p0, y);
                y = MFMA32(*(LAS bf16x8*)(XTs + ((ph * 8 + 2 * sb + 1) * 64 + lane) * 8), p1, y);
            }
        }
        bf16* YS = wsp<bf16>(c, WS_B) + (size_t)1 * MT * 512 + tok * 512 + h * 64 + 32 * ph;
        float ssq = 0.f;
#pragma unroll
        for (int k4 = 0; k4 < 4; ++k4) { const int p = 8 * k4 + 4 * hh;
            const f32x4 nwv = nwq[k4];
            float o[4];
#pragma unroll
            for (int i = 0; i < 4; ++i) { const float yv = y[4 * k4 + i];
                const float z = i == 0 ? bflo(zw[k4].x) : (i == 1 ? bfhi(zw[k4].x) : (i == 2 ? bflo(zw[k4].y) : bfhi(zw[k4].y)));
                const float gz = yv * siluf_(z); ssq += gz * gz; o[i] = gz * nwv[i]; }
            u32x2 w; w.x = pk2(o[0], o[1]); w.y = pk2(o[2], o[3]); *(u32x2*)(YS + p) = w; }
        ssq += __shfl_xor(ssq, 32);
        if (hh == 0) wsp<float>(c, WS_SSQ)[tok * 16 + h * 2 + ph] = ssq;
        __syncthreads();
    }
}
DI float gelu_tanh(float x) { const float u = 0.7978845608028654f * (x + 0.044715f * x * x * x); const float t = 1.0f - 2.0f * frcp(__expf(2.0f * u) + 1.0f); return 0.5f * x * (1.0f + t); }
template <int PASS> DI void s5_gemm_unit(const Ctx& c, int slot) {
    int unit = slot;
    if (c.G == 256) { const int i = slot >> 8, w = slot & 255, x = w & 7, q = i * 32 + (w >> 3); unit = ((q / 18) * 8 + x) * 18 + q % 18; }
    const int g = unit / 18, rem = unit - g * 18, rb = rem >> 1, ch = rem & 1;
    int tid_ = c.tid; asm volatile("" : "+v"(tid_));
    const int tid = tid_, lane = tid & 63, wave = c.wave, r = lane & 31, hh = lane >> 5;
    const int Rt = rb * 8 + wave;
    constexpr int KSW = PASS == 1 ? 16 : 32;
    constexpr int NW = KSW / 2;
    const bf16* Ua = wsp<bf16>(c, WS_UF) + ((size_t)(g * 72 + Rt) * 16 * 64 + lane) * 8;
    bf16* QU = wsp<bf16>(c, WS_QU);
    const bf16* Sa = QU + ((size_t)(g * 72 + Rt) * 16 * 64 + lane) * 8;
    const bf16* Wt = (PASS == 1 ? wsp<bf16>(c, WS_QT) + (size_t)g * 256 * 256 : wsp<bf16>(c, WS_W3T) + (size_t)g * 256 * 512) + (size_t)(ch * 4) * KSW * 512;
    LAS bf16* Ws = (LAS bf16*)c.lds;
    u32x4 wr[NW]; bf16x8 au[16];
#pragma unroll
    for (int i = 0; i < NW; ++i) wr[i] = *(const u32x4*)(Wt + (size_t)(tid + 512 * i) * 8);
#pragma unroll
    for (int k = 0; k < 16; ++k) au[k] = ldg8(Ua + (size_t)k * 512);
#pragma unroll
    for (int i = 0; i < NW; ++i) *(LAS u32x4*)(Ws + (tid + 512 * i) * 8) = wr[i];
    bf16x8 as_[16];
    if (PASS == 3) {
#pragma unroll
        for (int k = 0; k < 16; ++k) as_[k] = ldg8(Sa + (size_t)k * 512); }
    __syncthreads();
    f32x16 acc[4];
#pragma unroll
    for (int ct = 0; ct < 4; ++ct)
#pragma unroll
        for (int e = 0; e < 16; ++e) acc[ct][e] = 0.f;
    LAS bf16* Wl = Ws + lane * 8;
    constexpr int KTOT = PASS == 3 ? 32 : 16;
    bf16x8 bq[2][4];
#define S5_LDB(buf, kk) { _Pragma("unroll") for (int ct = 0; ct < 4; ++ct) bq[buf][ct] = *(LAS bf16x8*)(Wl + (ct * KSW + (kk)) * 512); }
    S5_LDB(0, 0)
#pragma unroll
    for (int k = 0; k < KTOT; ++k) {
        if (k + 1 < KTOT) S5_LDB((k + 1) & 1, k + 1)
        __builtin_amdgcn_sched_barrier(0);
#pragma unroll
        for (int ct = 0; ct < 4; ++ct) acc[ct] = MFMA32(k < 16 ? au[k & 15] : as_[k & 15], bq[k & 1][ct], acc[ct]);
        __builtin_amdgcn_sched_barrier(0);
    }
#undef S5_LDB
    if (PASS == 3) {
        bf16* Y5G = wsp<bf16>(c, WS_Y5G);
#pragma unroll
        for (int ct = 0; ct < 4; ++ct)
#pragma unroll
            for (int e = 0; e < 16; ++e) { const int Ro = rb * 256 + wave * 32 + crow(e, hh); const int t = 2 * (ch * 4 + ct) + (r >> 4), s_ = r & 15;
                Y5G[((size_t)Ro * 16 + t) * 512 + g * 16 + s_] = f2bf(gelu_tanh(acc[ct][e])); }
    } else {
#pragma unroll
        for (int ct = 0; ct < 4; ++ct)
#pragma unroll
            for (int e = 0; e < 16; ++e) { const int col = 32 * (ch * 4 + ct) + r;
                QU[((size_t)((g * 72 + Rt) * 16 + (col >> 4)) * 64 + ((col >> 3) & 1) * 32 + crow(e, hh)) * 8 + (col & 7)] = f2bf(acc[ct][e]); }
    }
    __syncthreads();
}
DI int s5_row_of(int b, int dir, int step) {
    if (dir == 0) return step < 16 ? 16 * b + step : 256 + 128 * b + (step - 16);
    return step < 16 ? 16 * b + (15 - step) : 256 + 128 * b + (127 - (step - 16));
}
DI size_t s5_qidx(int g, int R, int dir, int n) { return ((size_t)((g * 72 + (R >> 5)) * 16 + dir * 8 + (n >> 4)) * 64 + ((n >> 3) & 1) * 32 + (R & 31)) * 8 + (n & 7); }
DI void s5_scan(const Ctx& c, int gt) {
    const int n = gt & 63, dir = (gt >> 6) & 1, g = (gt >> 7) & 31, b = gt >> 12;
    bf16* QU = wsp<bf16>(c, WS_QU);
    const float* A16 = wsp<float>(c, WS_A16) + ((g * 2 + dir) * 64 + n) * 2;
    const float ar = A16[0], ai = A16[1];
    float sr = 0.f, si = 0.f;
#pragma unroll 1
    for (int s0 = 0; s0 < 144; s0 += 48) {
        float qr[48], qi[48];
#pragma unroll
        for (int k = 0; k < 48; ++k) { const size_t o = s5_qidx(g, s5_row_of(b, dir, s0 + k), dir, n); qr[k] = bf2f(QU[o]); qi[k] = bf2f(QU[o + 2048]); }
#pragma unroll
        for (int k = 0; k < 48; ++k) { const size_t o = s5_qidx(g, s5_row_of(b, dir, s0 + k), dir, n); QU[o] = f2bf(sr); QU[o + 2048] = f2bf(si);
            const float nr = ar * sr - ai * si + qr[k], ni = ar * si + ai * sr + qi[k]; sr = nr; si = ni; }
    }
}
DI void merge_sum(const Ctx& c) {
    const bf16* P = wsp<bf16>(c, WS_A); bf16* H = wsp<bf16>(c, WS_H);
    for (size_t it = (size_t)c.bid * 512 + c.tid; it < (size_t)MT * 128; it += (size_t)c.G * 512) {
        const size_t row = it >> 7; const int d8 = (int)(it & 127) * 8;
        const u32x4 a = *(const u32x4*)(P + row * 4096 + d8), b = *(const u32x4*)(P + row * 4096 + 1024 + d8), cc = *(const u32x4*)(P + row * 4096 + 2048 + d8), d = *(const u32x4*)(P + row * 4096 + 3072 + d8);
        u32x4 w;
        w.x = pk2((bflo(a.x) + bflo(b.x)) + (bflo(cc.x) + bflo(d.x)), (bfhi(a.x) + bfhi(b.x)) + (bfhi(cc.x) + bfhi(d.x)));
        w.y = pk2((bflo(a.y) + bflo(b.y)) + (bflo(cc.y) + bflo(d.y)), (bfhi(a.y) + bfhi(b.y)) + (bfhi(cc.y) + bfhi(d.y)));
        w.z = pk2((bflo(a.z) + bflo(b.z)) + (bflo(cc.z) + bflo(d.z)), (bfhi(a.z) + bfhi(b.z)) + (bfhi(cc.z) + bfhi(d.z)));
        w.w = pk2((bflo(a.w) + bflo(b.w)) + (bflo(cc.w) + bflo(d.w)), (bfhi(a.w) + bfhi(b.w)) + (bfhi(cc.w) + bfhi(d.w)));
        *(u32x4*)(H + row * 1024 + d8) = w;
    }
}
DI void top2_of4(float a, float b, float cc, float d, float& m1, float& m2, int& i1, int& i2) {
    m1 = a; i1 = 0; if (b > m1) { m1 = b; i1 = 1; } if (cc > m1) { m1 = cc; i1 = 2; } if (d > m1) { m1 = d; i1 = 3; }
    m2 = -3.0e38f; i2 = 0;
    if (i1 != 0) { m2 = a; i2 = 0; }
    if (i1 != 1 && b > m2) { m2 = b; i2 = 1; }
    if (i1 != 2 && cc > m2) { m2 = cc; i2 = 2; }
    if (i1 != 3 && d > m2) { m2 = d; i2 = 3; }
}
template <int MODE = 0> DI void row_phase_mid(const Ctx& c, int layer) {
    LAS float* rwT = (LAS float*)c.lds;
    {   f32x4 rv[16];
#pragma unroll
        for (int q = 0; q < 16; ++q) { const int i = c.tid + 512 * q; rv[q] = *(const f32x4*)(c.A->in[I_RW] + (i >> 3) * 32 + (i & 7) * 4); }
#pragma unroll
        for (int q = 0; q < 16; ++q) { const int i = c.tid + 512 * q; const int d = i >> 3, e4 = (i & 7) * 4;
            rwT[(e4 + 0) * 1024 + d] = rv[q][0]; rwT[(e4 + 1) * 1024 + d] = rv[q][1]; rwT[(e4 + 2) * 1024 + d] = rv[q][2]; rwT[(e4 + 3) * 1024 + d] = rv[q][3]; } }
    const float* MOD = wsp<float>(c, WS_MOD); const int lane = c.lane;
    const float* g1 = c.A->in[I_LN1G] + layer * 1024; const float* b1 = c.A->in[I_LN1B] + layer * 1024;
    unsigned* cnt = wsp<unsigned>(c, WS_CTL) + CW_CNT + layer * 32;
    constexpr int RCAP = 20;
    LAS float* scs = (LAS float*)(c.lds + LDS_MISC + 2048) + c.wave * RCAP * 32;
    LAS float* rbs = (LAS float*)(c.lds + LDS_MISC + 2048 + 8 * RCAP * 128);
    LAS unsigned* lcnt = (LAS unsigned*)(rbs + 32);
    LAS float* g1L = (LAS float*)(c.lds + LDS_MISC + 24576); LAS float* b1L = g1L + 1024;
    {   const f32x4 gv = *(const f32x4*)((c.tid < 256 ? g1 : b1) + (c.tid & 255) * 4); *(LAS f32x4*)((c.tid < 256 ? g1L : b1L) + (c.tid & 255) * 4) = gv; }
    if (c.tid < 32) { rbs[c.tid] = c.A->in[I_RB][c.tid]; lcnt[c.tid] = 0u; }
    __syncthreads();
    const int qstride = c.G * 8; constexpr int NPAIR = MT / 2;
    int q = c.bid * 8 + c.wave;
    f32x4 xnA[4], xnB[4], gtn[4], scn[4], shn[4]; u32x2 mnA[4], mnB[4];
    if (q < NPAIR) { const int r0 = 2 * q; const float* md = MOD + ((size_t)layer * 17 + row_modidx(r0)) * 6144;
        row_load(wsp<float>(c, WS_XRES) + (size_t)r0 * 1024, lane, xnA); row_load(wsp<float>(c, WS_XRES) + (size_t)(r0 + 1) * 1024, lane, xnB);
        row_load_pk(wsp<bf16>(c, WS_B) + (size_t)r0 * 1024, lane, mnA); row_load_pk(wsp<bf16>(c, WS_B) + (size_t)(r0 + 1) * 1024, lane, mnB);
        row_load(md + 2048, lane, gtn); row_load(md + 4096, lane, scn); row_load(md + 3072, lane, shn); }
    while (q < NPAIR) {
        const int q_first = q; int nloc = 0;
        for (; q < NPAIR && nloc < RCAP / 2; q += qstride, ++nloc) {
            const int r0 = 2 * q;
            f32x4 xA[4], xB[4], hA[4], hB[4];
#pragma unroll
            for (int i = 0; i < 4; ++i) { const f32x4 mvA = {bflo(mnA[i].x), bfhi(mnA[i].x), bflo(mnA[i].y), bfhi(mnA[i].y)}, mvB = {bflo(mnB[i].x), bfhi(mnB[i].x), bflo(mnB[i].y), bfhi(mnB[i].y)};
                xA[i] = xnA[i] * ALPHA + gtn[i] * mvA; xB[i] = xnB[i] * ALPHA + gtn[i] * mvB; }
            const bool more = q + qstride < NPAIR; const int nr = 2 * (more ? q + qstride : q); const float* mdn_ = MOD + ((size_t)layer * 17 + row_modidx(nr)) * 6144;
            if (more) { row_load(wsp<float>(c, WS_XRES) + (size_t)nr * 1024, lane, xnA); row_load(wsp<float>(c, WS_XRES) + (size_t)(nr + 1) * 1024, lane, xnB);
                row_load_pk(wsp<bf16>(c, WS_B) + (size_t)nr * 1024, lane, mnA); row_load_pk(wsp<bf16>(c, WS_B) + (size_t)(nr + 1) * 1024, lane, mnB); row_load(mdn_ + 2048, lane, gtn); }
            row_ln(xA); row_ln(xB);
#pragma unroll
            for (int i = 0; i < 4; ++i) { const f32x4 gg = *(LAS f32x4*)(g1L + lane * 4 + 256 * i), bb = *(LAS f32x4*)(b1L + lane * 4 + 256 * i); xA[i] = xA[i] * gg + bb; xB[i] = xB[i] * gg + bb; }
            if (!(MODE & 2)) { row_store_nt(wsp<float>(c, WS_XRES) + (size_t)r0 * 1024, lane, xA); row_store_nt(wsp<float>(c, WS_XRES) + (size_t)(r0 + 1) * 1024, lane, xB); }
            row_modulate_r(xA, scn, shn, hA); row_modulate_r(xB, scn, shn, hB);
            if (!(MODE & 2)) { row_store_bf16(wsp<bf16>(c, WS_H) + (size_t)r0 * 1024, lane, hA); row_store_bf16(wsp<bf16>(c, WS_H) + (size_t)(r0 + 1) * 1024, lane, hB); }
#define BFLY(acc, n, m) { const bool up_ = (lane & (m)) != 0; _Pragma("unroll") for (int i = 0; i < (n) / 2; ++i) { const float keep_ = up_ ? acc[i + (n) / 2] : acc[i]; const float send_ = up_ ? acc[i] : acc[i + (n) / 2]; acc[i] = keep_ + __shfl_xor(send_, (m)); } }
#pragma unroll
            for (int hq = 0; hq < 2; ++hq) {
                float accA[16], accB[16];
                f32x4 wq[3][4];
#define RW_LOAD(buf, e_) { _Pragma("unroll") for (int i = 0; i < 4; ++i) wq[buf][i] = *(LAS f32x4*)(rwT + (hq * 16 + (e_)) * 1024 + lane * 4 + 256 * i); }
                if (!(MODE & 1)) { RW_LOAD(0, 0) RW_LOAD(1, 1) }
#pragma unroll
                for (int e = 0; e < 16; ++e) { f32x2 aA = {0.f, 0.f}, aB = {0.f, 0.f};
                    if (MODE & 1) { aA.x = hA[e & 3][e >> 2] * (float)(hq + 1); aB.x = hB[e & 3][e >> 2] * (float)(hq + 1); }
                    else {
                        if (e + 2 < 16) RW_LOAD((e + 2) % 3, e + 2)
                        __builtin_amdgcn_sched_barrier(0);
#pragma unroll
                        for (int i = 0; i < 4; ++i) { const f32x4 w = wq[e % 3][i];
                            aA = (f32x2){hA[i][0], hA[i][1]} * (f32x2){w[0], w[1]} + aA; aA = (f32x2){hA[i][2], hA[i][3]} * (f32x2){w[2], w[3]} + aA;
                            aB = (f32x2){hB[i][0], hB[i][1]} * (f32x2){w[0], w[1]} + aB; aB = (f32x2){hB[i][2], hB[i][3]} * (f32x2){w[2], w[3]} + aB; }
                        __builtin_amdgcn_sched_barrier(0);
                    }
                    accA[e] = aA.x + aA.y; accB[e] = aB.x + aB.y; }
#undef RW_LOAD
                BFLY(accA, 16, 32) BFLY(accA, 8, 16) BFLY(accA, 4, 8) BFLY(accA, 2, 4)
                BFLY(accB, 16, 32) BFLY(accB, 8, 16) BFLY(accB, 4, 8) BFLY(accB, 2, 4)
                accA[0] += __shfl_xor(accA[0], 2); accA[0] += __shfl_xor(accA[0], 1);
                accB[0] += __shfl_xor(accB[0], 2); accB[0] += __shfl_xor(accB[0], 1);
                if (!(lane & 3)) { scs[(2 * nloc) * 32 + hq * 16 + (lane >> 2)] = 1.0f / (1.0f + expf(-accA[0])); scs[(2 * nloc + 1) * 32 + hq * 16 + (lane >> 2)] = 1.0f / (1.0f + expf(-accB[0])); }
            }
#undef BFLY
            if (more) { row_load(mdn_ + 4096, lane, scn); row_load(mdn_ + 3072, lane, shn); }
        }
        __builtin_amdgcn_wave_barrier();
        if (lane < 2 * nloc) {
            const int rw_ = 2 * (q_first + (lane >> 1) * qstride) + (lane & 1);
            float best = -3.0e38f; int be0 = 0, be1 = 0; float bw0 = 0.f, bw1 = 0.f;
#pragma unroll 1
            for (int gI = 0; gI < 8; ++gI) {
                const f32x4 scv = *(LAS f32x4*)(scs + lane * 32 + gI * 4); const f32x4 rbv = *(LAS f32x4*)(rbs + gI * 4);
                float m1, m2; int i1, i2; top2_of4(scv[0] + rbv[0], scv[1] + rbv[1], scv[2] + rbv[2], scv[3] + rbv[3], m1, m2, i1, i2);
                const float gs = m1 + m2;
                if (gs > best) { best = gs; be0 = gI * 4 + i1; be1 = gI * 4 + i2;
                    bw0 = i1 == 0 ? scv[0] : (i1 == 1 ? scv[1] : (i1 == 2 ? scv[2] : scv[3]));
                    bw1 = i2 == 0 ? scv[0] : (i2 == 1 ? scv[1] : (i2 == 2 ? scv[2] : scv[3])); }
            }
            const float ws = bw0 + bw1;
            const unsigned p0 = __hip_atomic_fetch_add(lcnt + be0, 1u, __ATOMIC_RELAXED, __HIP_MEMORY_SCOPE_WORKGROUP), p1 = __hip_atomic_fetch_add(lcnt + be1, 1u, __ATOMIC_RELAXED, __HIP_MEMORY_SCOPE_WORKGROUP);
            int* ti = wsp<int>(c, WS_TOKI) + (size_t)rw_ * 4; ti[0] = be0; ti[1] = be1; ti[2] = (int)p0; ti[3] = (int)p1;
            float* tw = wsp<float>(c, WS_TOKW) + (size_t)rw_ * 2; tw[0] = bw0 / ws; tw[1] = bw1 / ws;
        }
        __builtin_amdgcn_wave_barrier();
    }
    __syncthreads();
    if (c.tid < 32) wsp<int>(c, WS_WGBASE)[c.bid * 32 + c.tid] = (int)atomicAdd(cnt + c.tid, lcnt[c.tid]);
    __syncthreads();
}
DI int moe_tables(const Ctx& c, int layer, LAS int* start, LAS int* blk_e) {
    if (c.wave == 0) { const unsigned* cnt = wsp<unsigned>(c, WS_CTL) + CW_CNT + layer * 32; const int lane = c.lane;
        const int cn = lane < 32 ? (int)__hip_atomic_load(cnt + lane, __ATOMIC_RELAXED, __HIP_MEMORY_SCOPE_AGENT) : 0;
        const int k = (cn + 255) >> 8; int incl = k;
#pragma unroll
        for (int off = 1; off < 32; off <<= 1) { const int t_ = __shfl_up(incl, off); if (lane >= off) incl += t_; }
        const int excl = incl - k;
        if (lane < 32) { start[lane] = excl * 256; for (int q = 0; q < k; ++q) blk_e[excl + q] = lane; }
        if (lane == 31) start[32] = incl; }
    __syncthreads();
    return __builtin_amdgcn_readfirstlane(start[32]);
}
DI void moe_gather(const Ctx& c, int layer) {
    LAS int* start = (LAS int*)(c.lds + LDS_MISC + 64); LAS int* blk_e = start + 64;
    moe_tables(c, layer, start, blk_e);
    const bf16* H = wsp<bf16>(c, WS_H); bf16* XS = wsp<bf16>(c, WS_A);
    const int stride = c.G * 8; int row = c.bid * 8 + c.wave;
    u32x4 an = {0u, 0u, 0u, 0u}, bn = an; int tn0 = 0, tn1 = 0, tn2 = 0, tn3 = 0;
    if (row < MT) { an = *(const u32x4*)(H + (size_t)row * 1024 + c.lane * 8); bn = *(const u32x4*)(H + (size_t)row * 1024 + 512 + c.lane * 8);
        const int* ti = wsp<int>(c, WS_TOKI) + (size_t)row * 4; tn0 = ti[0]; tn1 = ti[1]; tn2 = ti[2]; tn3 = ti[3]; }
    for (; row < MT; row += stride) {
        const u32x4 a = an, b = bn; const int* wgb = wsp<int>(c, WS_WGBASE) + (((row >> 1) % stride) >> 3) * 32;
        const int s0 = start[tn0] + wgb[tn0] + tn2, s1 = start[tn1] + wgb[tn1] + tn3;
        if (row + stride < MT) { const size_t nr = (size_t)(row + stride); an = *(const u32x4*)(H + nr * 1024 + c.lane * 8); bn = *(const u32x4*)(H + nr * 1024 + 512 + c.lane * 8);
            const int* ti = wsp<int>(c, WS_TOKI) + nr * 4; tn0 = ti[0]; tn1 = ti[1]; tn2 = ti[2]; tn3 = ti[3]; }
        *(u32x4*)(XS + (size_t)s0 * 1024 + c.lane * 8) = a; *(u32x4*)(XS + (size_t)s0 * 1024 + 512 + c.lane * 8) = b;
        *(u32x4*)(XS + (size_t)s1 * 1024 + c.lane * 8) = a; *(u32x4*)(XS + (size_t)s1 * 1024 + 512 + c.lane * 8) = b;
        if (c.lane == 0) { int* sl = wsp<int>(c, WS_TOKW + 512 * 1024) + (size_t)row * 2; sl[0] = s0; sl[1] = s1; }
    }
    __syncthreads();
}
DI void moe_slots(const Ctx& c, int layer) {
    LAS int* start = (LAS int*)(c.lds + LDS_MISC + 64); LAS int* blk_e = start + 64;
    moe_tables(c, layer, start, blk_e);
    int* S2T = wsp<int>(c, WS_S2T); const int stride = c.G * 8;
    for (int row = c.tid * c.G + c.bid; row < MT; row += 512 * c.G) {
        const int* ti = wsp<int>(c, WS_TOKI) + (size_t)row * 4; const int e0 = ti[0], e1 = ti[1], p0 = ti[2], p1 = ti[3];
        const int* wgb = wsp<int>(c, WS_WGBASE) + (((row >> 1) % stride) >> 3) * 32;
        const int s0 = start[e0] + wgb[e0] + p0, s1 = start[e1] + wgb[e1] + p1;
        S2T[s0] = row; S2T[s1] = row;
        int* sl = wsp<int>(c, WS_TOKW + 512 * 1024) + (size_t)row * 2; sl[0] = s0; sl[1] = s1;
    }
    __syncthreads();
}
DI void row_phase_last(const Ctx& c, int layer) {
    const float* MOD = wsp<float>(c, WS_MOD); const int lane = c.lane;
    const bf16* YE = wsp<bf16>(c, WS_A);
    const int* SLT = wsp<int>(c, WS_TOKW + 512 * 1024); const float* TWT = wsp<float>(c, WS_TOKW);
    const int stride = c.G * 8; int row = c.bid * 8 + c.wave;
    const int ln = layer < DEPTH - 1 ? layer + 1 : layer;
    f32x4 g2v[4], b2v[4];
    row_load(c.A->in[I_LN2G] + layer * 1024, lane, g2v); row_load(c.A->in[I_LN2B] + layer * 1024, lane, b2v);
    int s0n = 0, s1n = 0; float w0n = 0.f, w1n = 0.f;
    int s0c = 0, s1c = 0; float w0c = 0.f, w1c = 0.f;
    f32x4 xn[4], gtn[4], scn[4], shn[4]; u32x2 an[4], bn[4];
    if (row < MT) { s0c = SLT[(size_t)row * 2]; s1c = SLT[(size_t)row * 2 + 1]; w0c = TWT[(size_t)row * 2]; w1c = TWT[(size_t)row * 2 + 1]; }
    if (row + stride < MT) { const size_t r1 = (size_t)(row + stride); s0n = SLT[r1 * 2]; s1n = SLT[r1 * 2 + 1]; w0n = TWT[r1 * 2]; w1n = TWT[r1 * 2 + 1]; }
    if (row < MT) { row_load(wsp<float>(c, WS_XRES) + (size_t)row * 1024, lane, xn);
        row_load(MOD + ((size_t)layer * 17 + row_modidx(row)) * 6144 + 5120, lane, gtn);
        const float* mdn = MOD + ((size_t)ln * 17 + row_modidx(row)) * 6144; row_load(mdn + 1024, lane, scn); row_load(mdn, lane, shn);
#pragma unroll
        for (int i = 0; i < 4; ++i) { an[i] = *(const u32x2*)(YE + (size_t)s0c * 1024 + lane * 4 + 256 * i); bn[i] = *(const u32x2*)(YE + (size_t)s1c * 1024 + lane * 4 + 256 * i); } }
    for (; row < MT; row += stride) {
        float* xr = wsp<float>(c, WS_XRES) + (size_t)row * 1024;
        const float w0 = w0c, w1 = w1c;
        f32x4 x[4], h[4];
#pragma unroll
        for (int i = 0; i < 4; ++i) { const u32x2 a = an[i], b = bn[i];
            f32x4 f; f[0] = w0 * bflo(a.x) + w1 * bflo(b.x); f[1] = w0 * bfhi(a.x) + w1 * bfhi(b.x); f[2] = w0 * bflo(a.y) + w1 * bflo(b.y); f[3] = w0 * bfhi(a.y) + w1 * bfhi(b.y);
            x[i] = xn[i] * ALPHA + gtn[i] * f; }
        s0c = s0n; s1c = s1n; w0c = w0n; w1c = w1n;
        const bool more = row + stride < MT; const int nr = more ? row + stride : row;
        if (more) { row_load(wsp<float>(c, WS_XRES) + (size_t)nr * 1024, lane, xn);
            row_load(MOD + ((size_t)layer * 17 + row_modidx(nr)) * 6144 + 5120, lane, gtn);
#pragma unroll
            for (int i = 0; i < 4; ++i) { an[i] = *(const u32x2*)(YE + (size_t)s0c * 1024 + lane * 4 + 256 * i); bn[i] = *(const u32x2*)(YE + (size_t)s1c * 1024 + lane * 4 + 256 * i); } }
        if (row + 2 * stride < MT) { const size_t r2 = (size_t)(row + 2 * stride); s0n = SLT[r2 * 2]; s1n = SLT[r2 * 2 + 1]; w0n = TWT[r2 * 2]; w1n = TWT[r2 * 2 + 1]; }
        row_ln(x);
#pragma unroll
        for (int i = 0; i < 4; ++i) x[i] = x[i] * g2v[i] + b2v[i];
        if (layer < DEPTH - 1) {
            row_store_nt(xr, lane, x);
            row_modulate_r(x, scn, shn, h);
            if (more) { const float* mdn = MOD + ((size_t)ln * 17 + row_modidx(nr)) * 6144; row_load(mdn + 1024, lane, scn); row_load(mdn, lane, shn); }
            row_store_bf16(wsp<bf16>(c, WS_H) + (size_t)row * 1024, lane, h);
        } else if (row >= MC) row_store(c.A->out + (size_t)(row - MC) * 1024, lane, x);
    }
}
constexpr int NPH = 14;
constexpr int NGP = 2 + DEPTH * NPH;

#ifndef REP_GEMM
#define REP_GEMM 1
#endif
#ifndef REP_ATTN
#define REP_ATTN 1
#endif
#ifndef REP_SSD
#define REP_SSD 1
#endif
#ifndef REP_S5
#define REP_S5 1
#endif
#ifndef REP_MERGE
#define REP_MERGE 1
#endif
#ifndef REP_MOE
#define REP_MOE 1
#endif
#ifndef REP_S2
#define REP_S2 1
#endif
#ifndef REP_S4
#define REP_S4 1
#endif
#ifndef REP_P1
#define REP_P1 1
#endif
#ifndef REP_P3
#define REP_P3 1
#endif
#ifndef REP_PU
#define REP_PU 1
#endif
#ifndef REP_RC
#define REP_RC 1
#endif
#ifndef REP_P0
#define REP_P0 1
#endif
#ifndef REP_PREP
#define REP_PREP 1
#endif
#ifndef REP_CONV
#define REP_CONV 1
#endif
#ifndef REP_BAR
#define REP_BAR 1
#endif
#ifndef ONLY_PHASE
#define ONLY_PHASE -9
#endif
#ifndef PROBE_MODE
#define PROBE_MODE 0
#endif
#ifndef FILL_P2
#define FILL_P2 2
#endif
#ifndef FILL_P3
#define FILL_P3 4
#endif
#ifndef FILL_P4
#define FILL_P4 3
#endif
#define PH_EN(p) (ONLY_PHASE == -9 || ONLY_PHASE == (p))
#define RUN(gp) (lo <= (gp) && (gp) < hi)
#define FRESH() Ctx c = c0; { int t_ = c0.wave * 64 + (int)__builtin_amdgcn_mbcnt_hi(~0u, __builtin_amdgcn_mbcnt_lo(~0u, 0u)); asm volatile("" : "+v"(t_)); const CAS Args* a_ = c0.A; asm volatile("" : "+s"(a_)); c.A = a_; c.tid = t_; c.lane = t_ & 63; c.wave = __builtin_amdgcn_readfirstlane(t_ >> 6); }
#if MK_SPLIT
struct BarT { int dummy; };
#define GRID_BAR() do { } while (0)
#else
typedef XcdBarrier BarT;
#define GRID_BAR() do { for (int rb_ = 0; rb_ < REP_BAR; ++rb_) xcd_barrier(bar); } while (0)
#endif
#define SEAM(gp) do { if ((gp) + 1 < hi) GRID_BAR(); } while (0)
template <int layer> DI void layer_phases(const Ctx& c0, const int lo, const int hi, const BarT& bar) {
        const int gp0 = 2 + layer * NPH;
        if (PH_EN(0) && RUN(gp0 + 0)) { FRESH();
            pg8::Gemm g{wsp<bf16>(c, WS_H), wsp<bf16>(c, WS_WINT), MT, NPROJ, 1024}; pg8::StaticOrder S; S.init(MT, NPROJ, c.G, c.bid);
            pg8::EpiProj E{wsp<bf16>(c, WS_A), NPROJ, wsp<bf16>(c, WS_UF), C_SU / 256};
            for (int rep_ = 0; rep_ < REP_GEMM * REP_P0; ++rep_) pg8::gemm_phase<pg8::EpiProj, pg8::StaticOrder>(c.lds, g, S, E, nullptr, c.tid);
            __syncthreads();
            s5mat_dyn(c, layer, wsp<unsigned>(c, WS_CTL) + CW_TICKET + layer * 16 + 1);
            wconv_dyn<0>(c, layer, wsp<unsigned>(c, WS_CTL) + CW_TICKET + layer * 16 + 2, 960, WSMALL_TILES, 1 << 30);
            SEAM(gp0 + 0);
        }
        if (PH_EN(1) && RUN(gp0 + 1)) { FRESH();
            headvec_tables(c, layer);
            headvec_passes(c, layer);
            for (int rep_ = 0; rep_ < REP_PREP * REP_PU; ++rep_) for (int u = (c.bid + 3 * c.G / 4) % c.G; u < MT / 64; u += c.G) prep_unit(c, layer, u);
            __syncthreads();
            for (int rep_ = 0; rep_ < REP_S5 * REP_P1; ++rep_) for (int u = c.bid; u < 576; u += c.G) s5_gemm_unit<1>(c, u);
            SEAM(gp0 + 1);
        }
        if (PH_EN(2) && RUN(gp0 + 2)) { FRESH();
            for (int rep_ = 0; rep_ < REP_ATTN; ++rep_) {
            attn_units(c, layer);
            }
            __syncthreads();
            for (int rep_ = 0; rep_ < REP_SSD * REP_S2; ++rep_) for (int u = c.bid; u < 576; u += c.G) ssd_states_unit(c, layer, u);
            if (c.tid < 256) for (int gt = c.bid * 256 + c.tid; gt < 65536; gt += c.G * 256) s5_scan(c, gt);
            if (c.bid >= 576 % c.G) { __syncthreads(); wconv_dyn<1>(c, layer, wsp<unsigned>(c, WS_CTL) + CW_TICKET + layer * 16, 0, WMOE_TILES, FILL_P2); }
            SEAM(gp0 + 2);
        }
        if (PH_EN(3) && RUN(gp0 + 3)) { FRESH();
            for (int rep_ = 0; rep_ < REP_PREP * REP_RC; ++rep_) ssd_recur(c, c.bid * 512 + c.tid, c.G * 512);
            for (int rep_ = 0; rep_ < REP_S5 * REP_P3; ++rep_) for (int u = c.bid; u < 576; u += c.G) s5_gemm_unit<3>(c, u);
            if (c.bid >= 576 % c.G) { __syncthreads(); wconv_dyn<1>(c, layer, wsp<unsigned>(c, WS_CTL) + CW_TICKET + layer * 16, 0, WMOE_TILES, FILL_P3); }
            SEAM(gp0 + 3);
        }
        if (PH_EN(4) && RUN(gp0 + 4)) { FRESH();
            for (int rep_ = 0; rep_ < REP_SSD * REP_S4; ++rep_) ssd_out_units(c, layer, c.bid, c.G, 2304);
            __syncthreads();
            pg8::Gemm g{wsp<bf16>(c, WS_Y5G), wsp<bf16>(c, WS_WGLUT), MT, 1024, 512}; pg8::StaticOrder S; S.init(MT, 1024, c.G, c.bid);
            pg8::EpiPair<1> E{wsp<bf16>(c, WS_B) + (size_t)3 * MT * 512};
            for (int rep_ = 0; rep_ < REP_GEMM; ++rep_) pg8::gemm_phase<pg8::EpiPair<1>, pg8::StaticOrder>(c.lds, g, S, E, nullptr, c.tid);
            if (c.bid >= 576 % c.G) { __syncthreads(); wconv_dyn<1>(c, layer, wsp<unsigned>(c, WS_CTL) + CW_TICKET + layer * 16, 0, WMOE_TILES, FILL_P4); }
            SEAM(gp0 + 4);
        }
        if (PH_EN(5) && RUN(gp0 + 5)) { FRESH();
            pg8::Gemm g{wsp<bf16>(c, WS_B), wsp<bf16>(c, WS_WBT), 4 * MT, 4096, 512}; pg8::MergeOrder S{c.G, c.bid, (MT / 256) * 4, MT / 256};
            pg8::EpiMerge E{wsp<bf16>(c, WS_A), wsp<float>(c, WS_SSQ), MT / 256};
            for (int rep_ = 0; rep_ < REP_GEMM * REP_MERGE; ++rep_) pg8::gemm_phase<pg8::EpiMerge, pg8::MergeOrder>(c.lds, g, S, E, nullptr, c.tid);
            SEAM(gp0 + 5);
        }
        if (PH_EN(6) && RUN(gp0 + 6)) { FRESH();
            pg8::Gemm g{wsp<bf16>(c, WS_H), wsp<bf16>(c, WS_WGT), MT, NGATE, 1024}; pg8::StaticOrder S; S.init(MT, NGATE, c.G, c.bid);
            pg8::EpiGateMerge E{wsp<bf16>(c, WS_A), wsp<bf16>(c, WS_D)};
            for (int rep_ = 0; rep_ < REP_GEMM; ++rep_) pg8::gemm_phase<pg8::EpiGateMerge, pg8::StaticOrder>(c.lds, g, S, E, nullptr, c.tid);
            SEAM(gp0 + 6);
        }
        if (PH_EN(7) && RUN(gp0 + 7)) { }
        if (PH_EN(8) && RUN(gp0 + 8)) { FRESH();
            pg8::Gemm g{wsp<bf16>(c, WS_D), wsp<bf16>(c, WS_WOT), MT, 1024, 1024}; pg8::StaticOrder S; S.init(MT, 1024, c.G, c.bid);
            pg8::EpiStoreBf16<0> E{wsp<bf16>(c, WS_B), 1024, 1 << 30};
            for (int rep_ = 0; rep_ < REP_GEMM; ++rep_) pg8::gemm_phase<pg8::EpiStoreBf16<0>, pg8::StaticOrder>(c.lds, g, S, E, nullptr, c.tid);
            __syncthreads();
            wconv_dyn<1>(c, layer, wsp<unsigned>(c, WS_CTL) + CW_TICKET + layer * 16, 0, WMOE_TILES, 1 << 30);
            SEAM(gp0 + 8);
        }
        if (PH_EN(9) && RUN(gp0 + 9)) { FRESH(); row_phase_mid(c, layer); SEAM(gp0 + 9); }
        if (PH_EN(10) && RUN(gp0 + 10)) { FRESH();
            moe_slots(c, layer);
            SEAM(gp0 + 10);
        }
        if (PH_EN(11) && RUN(gp0 + 11)) { FRESH();
            LAS int* start = (LAS int*)(c.lds + LDS_MISC + 64); LAS int* blk_e = start + 64;
            const int nb = moe_tables(c, layer, start, blk_e);
            LAS int* gidx = (LAS int*)(c.lds + LDS_MISC + 2048);
            pg8::Gemm g{wsp<bf16>(c, WS_H), wsp<bf16>(c, WS_MOEW1), MOE_MAXSLOT, 32 * 1024, 1024}; pg8::MoeGatherOrder S{c.G, c.bid, nb * 4, blk_e, gidx};
            {   const int* S2T = wsp<int>(c, WS_S2T); const int r_ = c.tid & 255;
#define GI_LOAD(i) const int pm##i = S.pm_of(i); const bool ok##i = pm##i >= 0 && c.tid < 256; const int tv##i = S2T[(pm##i < 0 ? 0 : pm##i) * 256 + r_];
#define GI_STORE(i) if (ok##i) gidx[i * 256 + r_] = (unsigned)tv##i < (unsigned)MT ? tv##i : MT - 1;
                GI_LOAD(0) GI_LOAD(1) GI_LOAD(2) GI_LOAD(3) GI_LOAD(4)
                GI_STORE(0) GI_STORE(1) GI_STORE(2) GI_STORE(3) GI_STORE(4)
#undef GI_LOAD
#undef GI_STORE
                for (int i = 5; i < 28 && S.pm_of(i) >= 0; ++i) if (c.tid < 256) { const int t_ = S2T[S.pm_of(i) * 256 + r_]; gidx[i * 256 + r_] = (unsigned)t_ < (unsigned)MT ? t_ : MT - 1; }
                __syncthreads(); }
            pg8::EpiPair<0> E{wsp<bf16>(c, WS_A_HID)};
            for (int rep_ = 0; rep_ < REP_GEMM * REP_MOE; ++rep_) pg8::gemm_phase<pg8::EpiPair<0>, pg8::MoeGatherOrder>(c.lds, g, S, E, nullptr, c.tid);
            SEAM(gp0 + 11);
        }
        if (PH_EN(12) && RUN(gp0 + 12)) { FRESH();
            LAS int* start = (LAS int*)(c.lds + LDS_MISC + 64); LAS int* blk_e = start + 64;
            const int nb = moe_tables(c, layer, start, blk_e);
            pg8::Gemm g{wsp<bf16>(c, WS_A_HID), wsp<bf16>(c, WS_MOEW2), MOE_MAXSLOT, 32 * 1024, 512}; pg8::MoeOrder S{c.G, c.bid, nb * 4, blk_e};
            pg8::EpiStoreBf16<0> E{wsp<bf16>(c, WS_A), 1024, 1024};
            for (int rep_ = 0; rep_ < REP_GEMM * REP_MOE; ++rep_) pg8::gemm_phase<pg8::EpiStoreBf16<0>, pg8::MoeOrder>(c.lds, g, S, E, nullptr, c.tid);
            SEAM(gp0 + 12);
        }
        if (PH_EN(13) && RUN(gp0 + 13)) { FRESH();
            row_phase_last(c, layer);
            if (layer + 1 < DEPTH) {
                __syncthreads();
                wconv_run<0>(c, layer + 1, c.bid, c.G, 960);
            }
            SEAM(gp0 + 13);
        }
    }

__global__ void __launch_bounds__(512, 2) mk_fwd(Args args) {
    extern __shared__ __attribute__((aligned(16))) unsigned char lds_raw[];
    Ctx c0;
    c0.A = (const CAS Args*)__builtin_amdgcn_kernarg_segment_ptr();
    c0.lds = (LAS unsigned char*)lds_raw;
    c0.wave = __builtin_amdgcn_readfirstlane((int)threadIdx.x >> 6); c0.tid = 0; c0.lane = 0; c0.G = gridDim.x; c0.bid = blockIdx.x;
    const int tid0 = threadIdx.x;
    const int lo = args.ph_lo, hi = args.ph_hi;
    volatile LAS unsigned* misc = (volatile LAS unsigned*)(c0.lds + LDS_MISC);
    if (tid0 < 4) misc[tid0] = 0u;
    __syncthreads();
#if MK_SPLIT
    BarT bar; bar.dummy = 0;
#else
    BarT bar = xcd_barrier_post(wsp<unsigned>(c0, WS_CTL) + CW_BAR, misc);
#endif
    if (PH_EN(-2) && RUN(0)) { FRESH();
        if (c.bid == c.G - 1) rope_table(c);
        for (int u = c.bid; u < 192; u += c.G) mod_unit(c, u);
        wconv_run<0>(c, 0, c.bid, c.G, 960);
        SEAM(0);
    }
    if (PH_EN(-1) && RUN(1)) { FRESH(); row_phase_first(c); SEAM(1); }

    layer_phases<0>(c0, lo, hi, bar);
    layer_phases<1>(c0, lo, hi, bar);
    layer_phases<2>(c0, lo, hi, bar);
    layer_phases<3>(c0, lo, hi, bar);
#ifdef TAIL_PROBE
    if (hi == NGP) { GRID_BAR(); FRESH();
        for (int rep_ = 0; rep_ < 4; ++rep_) {
            if (TAIL_PROBE == 1) row_phase_mid<PROBE_MODE>(c, 3);
            if (TAIL_PROBE == 2) row_phase_last(c, 2);
            if (TAIL_PROBE == 3) headvec_passes(c, 3);
            if (TAIL_PROBE == 4) { const int gt = ((c.bid + c.G / 2) % c.G) * 512 + c.tid; if (gt < 65536) s5_scan(c, gt); }
            if (TAIL_PROBE == 5) { for (int u = c.bid; u < 192; u += c.G) mod_unit(c, u); for (int u = c.bid; u < 256; u += c.G) s5mat_unit(c, 0, u); wconv_run<0>(c, 0, c.bid, c.G, WSMALL_TILES); }
            if (TAIL_PROBE == 51) for (int u = c.bid; u < 192; u += c.G) mod_unit(c, u);
            if (TAIL_PROBE == 52) for (int u = c.bid; u < 256; u += c.G) s5mat_unit(c, 0, u);
            if (TAIL_PROBE == 53) wconv_run<0>(c, 0, c.bid, c.G, WSMALL_TILES);
            if (TAIL_PROBE == 6) row_phase_first(c);
            GRID_BAR();
        }
    }
#endif
#undef RUN
#undef SEAM
#undef GRID_BAR
}

extern "C" void kernel_launch(void* const* d_in, const int* in_sizes, int n_in, void* d_out, int out_size, void* d_ws, size_t ws_size, hipStream_t stream) {
    static int grid = 0;
    if (grid == 0) {
        if (n_in != N_IN || out_size != ML * DM || ws_size < WS_END) { fprintf(stderr, "kernel_launch: unexpected problem (n_in %d, out %d, ws %zu < %zu)\n", n_in, out_size, ws_size, (size_t)WS_END); grid = -1; return; }
        int dev = 0, cus = 0, per_cu = 0;
        if (hipGetDevice(&dev) != hipSuccess || hipDeviceGetAttribute(&cus, hipDeviceAttributeMultiprocessorCount, dev) != hipSuccess) { grid = -1; return; }
        if (hipFuncSetAttribute((const void*)mk_fwd, hipFuncAttributeMaxDynamicSharedMemorySize, LDS_BYTES) != hipSuccess) { fprintf(stderr, "kernel_launch: hipFuncSetAttribute failed\n"); grid = -1; return; }
        if (hipOccupancyMaxActiveBlocksPerMultiprocessor(&per_cu, (const void*)mk_fwd, 512, LDS_BYTES) != hipSuccess || per_cu < 1) { fprintf(stderr, "kernel_launch: occupancy query says %d\n", per_cu); }
        (void)hipGetLastError();
        grid = cus;
    }
    if (grid < 0) return;
    (void)hipMemsetAsync((char*)d_ws + WS_CTL, 0, CTL_ZERO_BYTES, stream);
    Args a{};
    for (int i = 0; i < N_IN; ++i) a.in[i] = (const float*)d_in[i];
    a.out = (float*)d_out; a.ws = (unsigned char*)d_ws;
#if MK_SPLIT
    for (int gp = 0; gp < NGP; ++gp) { a.ph_lo = gp; a.ph_hi = gp + 1; hipLaunchKernelGGL(mk_fwd, dim3(grid), dim3(512), LDS_BYTES, stream, a); }
#else
    a.ph_lo = 0; a.ph_hi = NGP; hipLaunchKernelGGL(mk_fwd, dim3(grid), dim3(512), LDS_BYTES, stream, a);
#endif
}
```

```cpp
#include <hip/hip_runtime.h>
#include <cstdio>
#include <cstdint>

#ifndef MK_SPLIT
#define MK_SPLIT 0
#endif

#define DI __device__ __forceinline__
typedef unsigned short bf16;
typedef short bf16x8 __attribute__((ext_vector_type(8)));
typedef float f32x4 __attribute__((ext_vector_type(4)));
typedef float f32x2 __attribute__((ext_vector_type(2)));
typedef float f32x16 __attribute__((ext_vector_type(16)));
typedef unsigned u32x4 __attribute__((ext_vector_type(4)));
typedef unsigned u32x2 __attribute__((ext_vector_type(2)));
typedef __bf16 bf16x2_t __attribute__((ext_vector_type(2)));

DI unsigned pk2(float a, float b) { f32x2 v = {a, b}; bf16x2_t r = __builtin_convertvector(v, bf16x2_t); return __builtin_bit_cast(unsigned, r); }
DI bf16 f2bf(float a) { return (bf16)(pk2(a, 0.f) & 0xffffu); }
DI float bf2f(bf16 b) { return __uint_as_float(((unsigned)b) << 16); }
DI float bflo(unsigned u) { return __uint_as_float(u << 16); }
DI float bfhi(unsigned u) { return __uint_as_float(u & 0xffff0000u); }
DI float frcp(float x) { return __builtin_amdgcn_rcpf(x); }
DI float sigmoidf_(float x) { return frcp(1.0f + __expf(-x)); }
DI float siluf_(float x) { return x * frcp(1.0f + __expf(-x)); }
DI int crow(int reg, int h) { return (reg & 3) + 8 * (reg >> 2) + 4 * h; }
#define MFMA32(a, b, c) __builtin_amdgcn_mfma_f32_32x32x16_bf16((a), (b), (c), 0, 0, 0)
DI bf16x8 pack8(float a0, float a1, float a2, float a3, float a4, float a5, float a6, float a7) {
    u32x4 p; p.x = pk2(a0, a1); p.y = pk2(a2, a3); p.z = pk2(a4, a5); p.w = pk2(a6, a7); return __builtin_bit_cast(bf16x8, p);
}
DI float wave_sum(float v) {
    v += __int_as_float(__builtin_amdgcn_update_dpp(0, __float_as_int(v), 0xB1, 0xf, 0xf, true));
    v += __int_as_float(__builtin_amdgcn_update_dpp(0, __float_as_int(v), 0x4E, 0xf, 0xf, true));
    v += __int_as_float(__builtin_amdgcn_update_dpp(0, __float_as_int(v), 0x141, 0xf, 0xf, true));
    v += __int_as_float(__builtin_amdgcn_update_dpp(0, __float_as_int(v), 0x140, 0xf, 0xf, true));
    const float r0 = __int_as_float(__builtin_amdgcn_readlane(__float_as_int(v), 0)), r1 = __int_as_float(__builtin_amdgcn_readlane(__float_as_int(v), 16));
    const float r2 = __int_as_float(__builtin_amdgcn_readlane(__float_as_int(v), 32)), r3 = __int_as_float(__builtin_amdgcn_readlane(__float_as_int(v), 48));
    return (r0 + r1) + (r2 + r3);
}
#define XB_TMO      128
#define XB_XCNT(j)  (256  + 64 * (j))
#define XB_XSUB(j)  (1280 + 64 * (j))
#define XB_XGEN(j)  (2304 + 64 * (j))
#define XB_TOP      3328
#define XB_TOPGEN   3392
#define XCD_BAR_WORDS 3456
#define XB_SPIN_CAP (1u << 18)
#define LAS __attribute__((address_space(3)))

__device__ __forceinline__ unsigned xb_ld(unsigned* p)              { return __hip_atomic_load(p, __ATOMIC_RELAXED, __HIP_MEMORY_SCOPE_AGENT); }
__device__ __forceinline__ unsigned xb_add(unsigned* p, unsigned v) { return __hip_atomic_fetch_add(p, v, __ATOMIC_RELAXED, __HIP_MEMORY_SCOPE_AGENT); }
__device__ __forceinline__ unsigned xb_xcc_id() { return (unsigned)__builtin_amdgcn_s_getreg((3 << 11) | 20) & 0xFu; }
#define XB_SPIN(cond, bar) do { unsigned _sp = 0; while (cond) { __builtin_amdgcn_s_sleep(1); \
    if ((++_sp & 255u) == 0u) { if (xb_ld(&(bar)[XB_TMO])) break; if (_sp > XB_SPIN_CAP) { atomicAdd(&(bar)[XB_TMO], 1u); break; } } } } while (0)

struct XcdBarrier {
    unsigned* bar; unsigned x;
    volatile LAS unsigned* st;
};

__device__ __forceinline__ XcdBarrier xcd_barrier_post(unsigned* bar, volatile LAS unsigned* st) {
    XcdBarrier b; b.bar = bar; b.x = xb_xcc_id(); b.st = st;
    if (threadIdx.x == 0) (void)xb_add(&bar[XB_XCNT(b.x)], 1u);
    return b;
}
__device__ __forceinline__ void xcd_barrier_complete(unsigned* bar, unsigned x, unsigned& nloc, unsigned& nx) {
    const unsigned G = gridDim.x * gridDim.y * gridDim.z;
    unsigned sum, cnt, mine, sp = 0u;
    for (;;) {
        sum = 0u; cnt = 0u; mine = 0u;
#pragma unroll
        for (unsigned j = 0; j < 16; ++j) { const unsigned c = xb_ld(&bar[XB_XCNT(j)]); sum += c; cnt += (c > 0u) ? 1u : 0u; mine = (j == x) ? c : mine; }
        if (sum == G) break;
        __builtin_amdgcn_s_sleep(1);
        if ((++sp & 255u) == 0u) { if (xb_ld(&bar[XB_TMO])) break; if (sp > XB_SPIN_CAP) { atomicAdd(&bar[XB_TMO], 1u); break; } }
    }
    nloc = mine > 0u ? mine : 1u; nx = cnt > 0u ? cnt : 1u;
}

__device__ __forceinline__ void xcd_barrier(const XcdBarrier& b) {
    asm volatile("s_waitcnt vmcnt(0)" ::: "memory");
    __syncthreads();
    if (threadIdx.x == 0) {
        unsigned* bar = b.bar;
        __builtin_amdgcn_s_waitcnt(0);
        unsigned nloc = b.st[0], nx = b.st[1];
        if (nloc == 0u) { xcd_barrier_complete(bar, b.x, nloc, nx); b.st[0] = nloc; b.st[1] = nx; }
        const unsigned old = xb_add(&bar[XB_XSUB(b.x)], 1u);
        const unsigned gen = old / nloc;
        if (old + 1u == (gen + 1u) * nloc) {
            __builtin_amdgcn_fence(__ATOMIC_RELEASE, "agent");
            asm volatile("s_waitcnt vmcnt(0)" ::: "memory");
            const unsigned og = xb_add(&bar[XB_TOP], 1u);
            const unsigned tg = og / nx;
            if (og + 1u == (tg + 1u) * nx) xb_add(&bar[XB_TOPGEN], 1u);
            else XB_SPIN(xb_ld(&bar[XB_TOPGEN]) == tg, bar);
            __builtin_amdgcn_fence(__ATOMIC_ACQUIRE, "agent");
            xb_add(&bar[XB_XGEN(b.x)], 1u);
            asm volatile("s_waitcnt vmcnt(0)" ::: "memory");
        } else {
            XB_SPIN(xb_ld(&bar[XB_XGEN(b.x)]) == gen, bar);
            __builtin_amdgcn_fence(__ATOMIC_ACQUIRE, "agent");
            asm volatile("s_waitcnt vmcnt(0)" ::: "memory");
        }
    }
    __syncthreads();
}
namespace pg8 {
#define PG8_LAS __attribute__((address_space(3)))
typedef unsigned short bf16_t;
typedef short bf16x8 __attribute__((ext_vector_type(8)));
typedef float f32x4 __attribute__((ext_vector_type(4)));
typedef unsigned u32x4 __attribute__((ext_vector_type(4)));
constexpr int BM = 256, BK = 64, HALF = 128, HTB = HALF * BK * 2  , STAGE_BYTES = 8 * HTB, NXCD = 8, WGM = 8;

__host__ __device__ __forceinline__ int lds_byte(int r, int c) { const int st = (r >> 4) * 2 + (c >> 5), rr = r & 15, cc = c & 31, ob = rr * 64 + cc * 2; return st * 1024 + (ob ^ (((ob >> 9) & 1) << 5)); }
__host__ __device__ __forceinline__ void stage_rc(int b, int& R, int& C) { const int st = b / 1024, sb = b % 1024, swz = sb ^ (((sb >> 9) & 1) << 5); R = (st >> 1) * 16 + swz / 64; C = (st & 1) * 32 + (swz % 64) / 2; }
__host__ __device__ __forceinline__ int perm32(int rho) { const int n = rho >> 4, i = rho & 15; return 8 * (i >> 2) + 4 * n + (i & 3); }

struct Unit { int pm, pn; };
struct Gemm { const bf16_t* A; const bf16_t* Bt; int M, N, K; };

struct StaticOrder {
    int nM, nN, nwg, G, c;
    __host__ __device__ void init(int M, int N, int G_, int c_) { nM = M / BM; nN = N / BM; nwg = nM * nN; G = G_; c = c_; }
    __host__ __device__ bool next(int i, Unit& u) const {
        const long L = (long)i * G + c; if (L >= nwg) return false;
        int wgid = (int)L; { const int q = nwg / NXCD, r = nwg % NXCD, xcd = wgid % NXCD, off = wgid / NXCD; wgid = (xcd < r ? xcd * (q + 1) : r * (q + 1) + (xcd - r) * q) + off; }
        const int nig = WGM * nN, gid = wgid / nig, fm = gid * WGM, gsz = (nM - fm) < WGM ? (nM - fm) : WGM;
        u.pm = fm + ((wgid % nig) % gsz); u.pn = (wgid % nig) / gsz; return true;
    }
    __device__ __forceinline__ void a_ready(const Unit&) const {}
    __device__ __forceinline__ void done(const Unit&) const {}
};
template <int ACT> struct EpiStoreBf16 {
    static constexpr bool PERM = true, AFTER_DRAIN = false;
    bf16_t* O; int ldc; int colwrap;
    __device__ __forceinline__ void operator()(const f32x4 (&acc)[2][2][4][2], const Unit& u, int wr, int wc, int fr, int fq) const {
        const int row0 = u.pm * BM + wr * 64 + fr; const int colt = (u.pn * BM) % colwrap;
        const int col0 = colt + wc * 32 + 8 * fq;
#pragma unroll
        for (int ai = 0; ai < 2; ++ai)
#pragma unroll
            for (int m = 0; m < 4; ++m) { bf16_t* rowp = O + (size_t)(row0 + ai * HALF + m * 16) * ldc + col0;
#pragma unroll
                for (int bj = 0; bj < 2; ++bj) { f32x4 v0 = acc[ai][bj][m][0], v1 = acc[ai][bj][m][1];
                    if (ACT == 1) {
#pragma unroll
                        for (int j = 0; j < 4; ++j) { v0[j] = frcp(1.0f + __expf(-v0[j])); v1[j] = frcp(1.0f + __expf(-v1[j])); } }
                    u32x4 w; w.x = pk2(v0[0], v0[1]); w.y = pk2(v0[2], v0[3]); w.z = pk2(v1[0], v1[1]); w.w = pk2(v1[2], v1[3]);
                    *(u32x4*)(rowp + bj * HALF) = w; } }
    }
};
struct EpiProj {
    static constexpr bool PERM = true, AFTER_DRAIN = false;
    bf16_t* O; int ldc; bf16_t* UF; int su_tile0;
    __device__ __forceinline__ void operator()(const f32x4 (&acc)[2][2][4][2], const Unit& u, int wr, int wc, int fr, int fq) const {
        const int row0 = u.pm * BM + wr * 64 + fr; const int col0 = u.pn * BM + wc * 32 + 8 * fq;
        const bool su = (u.pn == su_tile0) || (u.pn == su_tile0 + 1);
#pragma unroll
        for (int ai = 0; ai < 2; ++ai)
#pragma unroll
            for (int m = 0; m < 4; ++m) { const int row = row0 + ai * HALF + m * 16;
#pragma unroll
                for (int bj = 0; bj < 2; ++bj) { const f32x4 v0 = acc[ai][bj][m][0], v1 = acc[ai][bj][m][1];
                    u32x4 w; w.x = pk2(v0[0], v0[1]); w.y = pk2(v0[2], v0[3]); w.z = pk2(v1[0], v1[1]); w.w = pk2(v1[2], v1[3]);
                    if (su) { const int cs = col0 + bj * HALF - su_tile0 * BM; const int g = cs >> 4, hh = (cs >> 3) & 1; const int R = row >> 4;
                        *(u32x4*)(UF + ((size_t)((g * 72 + (R >> 5)) * 16 + (row & 15)) * 64 + hh * 32 + (R & 31)) * 8) = w; }
                    else *(u32x4*)(O + (size_t)row * ldc + col0 + bj * HALF) = w; } }
    }
};
template <int ACT> struct EpiPair {
    static constexpr bool PERM = true, AFTER_DRAIN = false;
    bf16_t* O;
    __device__ __forceinline__ void operator()(const f32x4 (&acc)[2][2][4][2], const Unit& u, int wr, int wc, int fr, int fq) const {
        const int row0 = u.pm * BM + wr * 64 + fr; const int col0 = (u.pn & 3) * 128 + wc * 32 + 8 * fq;
#pragma unroll
        for (int ai = 0; ai < 2; ++ai)
#pragma unroll
            for (int m = 0; m < 4; ++m) { bf16_t* rowp = O + (size_t)(row0 + ai * HALF + m * 16) * 512 + col0;
                float o[8];
#pragma unroll
                for (int n = 0; n < 2; ++n)
#pragma unroll
                    for (int j = 0; j < 4; ++j) { const float a = acc[ai][0][m][n][j], b = acc[ai][1][m][n][j];
                        o[n * 4 + j] = (ACT == 0) ? (a * frcp(1.0f + __expf(-a))) * b : a * frcp(1.0f + __expf(-b)); }
                u32x4 w; w.x = pk2(o[0], o[1]); w.y = pk2(o[2], o[3]); w.z = pk2(o[4], o[5]); w.w = pk2(o[6], o[7]);
                *(u32x4*)rowp = w; }
    }
};
struct EpiF32 {
    static constexpr bool PERM = false, AFTER_DRAIN = false;
    float* C; int ldc;
    __device__ __forceinline__ void operator()(const f32x4 (&acc)[2][2][4][2], const Unit& u, int wr, int wc, int fr, int fq) const {
        const int row0 = u.pm * BM + wr * 64 + fr, col0 = u.pn * BM + wc * 32 + 4 * fq;
#pragma unroll
        for (int ai = 0; ai < 2; ++ai)
#pragma unroll
            for (int m = 0; m < 4; ++m) { float* rowp = C + (size_t)(row0 + ai * HALF + m * 16) * ldc + col0;
#pragma unroll
                for (int bj = 0; bj < 2; ++bj)
#pragma unroll
                    for (int n = 0; n < 2; ++n) *(f32x4*)(rowp + bj * HALF + n * 16) = acc[ai][bj][m][n]; }
    }
};
struct EpiMerge {
    static constexpr bool PERM = true, AFTER_DRAIN = false;
    bf16_t* MB;
    const float* SSQ;
    int MT;
    __device__ __forceinline__ void operator()(const f32x4 (&acc)[2][2][4][2], const Unit& u, int wr, int wc, int fr, int fq) const {
        const int nb = u.pn >> 2, pn = u.pn & 3, pm = u.pm - nb * MT;
        const int row0 = pm * BM + wr * 64 + fr, col0 = nb * 1024 + pn * BM + wc * 32 + 8 * fq;
        float rsv[2][4];
#pragma unroll
        for (int ai = 0; ai < 2; ++ai)
#pragma unroll
            for (int m = 0; m < 4; ++m) rsv[ai][m] = 1.0f;
        if (nb == 1) {
            f32x4 sq[2][4];
#pragma unroll
            for (int ai = 0; ai < 2; ++ai)
#pragma unroll
                for (int m = 0; m < 4; ++m) sq[ai][m] = *(const f32x4*)(SSQ + (size_t)(row0 + ai * HALF + m * 16) * 16 + 4 * fq);
            __builtin_amdgcn_sched_barrier(0);
#pragma unroll
            for (int ai = 0; ai < 2; ++ai)
#pragma unroll
                for (int m = 0; m < 4; ++m) { float ss = (sq[ai][m][0] + sq[ai][m][1]) + (sq[ai][m][2] + sq[ai][m][3]); ss += __shfl_xor(ss, 16); ss += __shfl_xor(ss, 32);
                    rsv[ai][m] = rsqrtf(ss * (1.0f / 512.0f) + 1e-6f); }
        }
#pragma unroll
        for (int ai = 0; ai < 2; ++ai)
#pragma unroll
            for (int m = 0; m < 4; ++m) { const int row = row0 + ai * HALF + m * 16;
                const float rs = rsv[ai][m];
                bf16_t* gp = MB + (size_t)row * 4096 + col0;
#pragma unroll
                for (int bj = 0; bj < 2; ++bj) { const f32x4 v0 = acc[ai][bj][m][0], v1 = acc[ai][bj][m][1];
                    u32x4 w; w.x = pk2(v0[0] * rs, v0[1] * rs); w.y = pk2(v0[2] * rs, v0[3] * rs); w.z = pk2(v1[0] * rs, v1[1] * rs); w.w = pk2(v1[2] * rs, v1[3] * rs);
                    *(u32x4*)(gp + bj * HALF) = w; } }
    }
};
struct EpiGateMerge {
    static constexpr bool PERM = true, AFTER_DRAIN = false;
    const bf16_t* MB;
    bf16_t* OUT;
    __device__ __forceinline__ void operator()(const f32x4 (&acc)[2][2][4][2], const Unit& u, int wr, int wc, int fr, int fq) const {
        const int row0 = u.pm * BM + wr * 64 + fr, d0 = u.pn * 64 + wc * 16 + 4 * fq;
        u32x2 mq[2][4][4];
#pragma unroll
        for (int ai = 0; ai < 2; ++ai)
#pragma unroll
            for (int m = 0; m < 4; ++m) { const bf16_t* mp = MB + (size_t)(row0 + ai * HALF + m * 16) * 4096 + d0;
#pragma unroll
                for (int q = 0; q < 4; ++q) mq[ai][m][q] = *(const u32x2*)(mp + q * 1024); }
        __builtin_amdgcn_sched_barrier(0);
#pragma unroll
        for (int ai = 0; ai < 2; ++ai)
#pragma unroll
            for (int m = 0; m < 4; ++m) { const int row = row0 + ai * HALF + m * 16;
                f32x4 o = {0.f, 0.f, 0.f, 0.f};
#pragma unroll
                for (int bj = 0; bj < 2; ++bj)
#pragma unroll
                    for (int n = 0; n < 2; ++n) { const u32x2 mw = mq[ai][m][2 * bj + n]; const f32x4 g = acc[ai][bj][m][n];
                        o[0] += __uint_as_float(mw.x << 16) * frcp(1.0f + __expf(-g[0])); o[1] += __uint_as_float(mw.x & 0xffff0000u) * frcp(1.0f + __expf(-g[1]));
                        o[2] += __uint_as_float(mw.y << 16) * frcp(1.0f + __expf(-g[2])); o[3] += __uint_as_float(mw.y & 0xffff0000u) * frcp(1.0f + __expf(-g[3])); }
                u32x2 w; w.x = pk2(o[0], o[1]); w.y = pk2(o[2], o[3]); *(u32x2*)(OUT + (size_t)row * 1024 + d0) = w; }
    }
};
struct MergeOrder {
    int G, c, ntiles, MT;
    __device__ bool next(int i, Unit& u) const {
        int P, j;
        if ((G & 31) == 0) { const int x = c & 7, k = c >> 3; P = i * (G >> 2) + x * (G >> 5) + (k >> 2); j = k & 3; }
        else { const int L = i * G + c; P = L >> 2; j = L & 3; }
        if (P >= ntiles) return false;
        const int n = P / MT, pm = P - n * MT; u.pm = n * MT + pm; u.pn = n * 4 + j; return true; }
    __device__ __forceinline__ void a_ready(const Unit&) const {}
    __device__ __forceinline__ void done(const Unit&) const {}
};
struct MoeOrder {
    int G, c, nunits; const PG8_LAS int* blk_e;
    __device__ bool next(int i, Unit& u) const {
        int pm, j;
        if ((G & 31) == 0) { const int x = c & 7, k = c >> 3; pm = i * (G >> 2) + x * (G >> 5) + (k >> 2); j = k & 3; }
        else { const int L = i * G + c; pm = L >> 2; j = L & 3; }
        if (pm * 4 + j >= nunits) return false;
        u.pm = pm; u.pn = __builtin_amdgcn_readfirstlane(blk_e[pm]) * 4 + j; return true; }
    __device__ __forceinline__ void a_ready(const Unit&) const {}
    __device__ __forceinline__ void done(const Unit&) const {}
};
struct MoeGatherOrder {
    int G, c, nunits; const PG8_LAS int* blk_e; const PG8_LAS int* idx;
    __device__ __forceinline__ int pm_of(int i) const {
        int pm, j;
        if ((G & 31) == 0) { const int x = c & 7, k = c >> 3; pm = i * (G >> 2) + x * (G >> 5) + (k >> 2); j = k & 3; }
        else { const int L = i * G + c; pm = L >> 2; j = L & 3; }
        return pm * 4 + j >= nunits ? -1 : pm; }
    __device__ __forceinline__ bool next(int i, Unit& u) const {
        int pm, j;
        if ((G & 31) == 0) { const int x = c & 7, k = c >> 3; pm = i * (G >> 2) + x * (G >> 5) + (k >> 2); j = k & 3; }
        else { const int L = i * G + c; pm = L >> 2; j = L & 3; }
        if (pm * 4 + j >= nunits) return false;
        u.pm = pm; u.pn = __builtin_amdgcn_readfirstlane(blk_e[pm]) * 4 + j; return true; }
    __device__ __forceinline__ void a_ready(const Unit&) const {}
    __device__ __forceinline__ void done(const Unit&) const {}
};
template <class S> struct GatherTrait { static constexpr bool value = false; };
template <> struct GatherTrait<MoeGatherOrder> { static constexpr bool value = true; };
template <class S> __device__ __forceinline__ int gather_row(const S&, int) { return 0; }
__device__ __forceinline__ int gather_row(const MoeGatherOrder& S, int k) { return S.idx[k]; }


template <class Epi, class Sched, bool STAMP = false>
__device__ __forceinline__ void gemm_phase(PG8_LAS unsigned char* lds, const Gemm g, const Sched& S, const Epi& E, unsigned long long* stamps, const int tid_in) {
    int tid_ = tid_in; asm volatile("" : "+v"(tid_));
    const int tid = tid_, wid = __builtin_amdgcn_readfirstlane(tid >> 6), lane = tid & 63, wr = wid >> 2, wc = wid & 3, fr = lane & 15, fq = lane >> 4;
    const int K = g.K, nt = K / BK;
    int ts_lo = 0, ts_hi = 0, nts = 0; const unsigned long long rt_entry = STAMP ? (unsigned long long)wall_clock64() : 0ull;
#define PG8_STAMP() do { if (STAMP && wid == 0 && nts < 64) { const unsigned long long _c = (unsigned long long)clock64(); \
        ts_lo = (lane == nts) ? (int)(unsigned)_c : ts_lo; ts_hi = (lane == nts) ? (int)(unsigned)(_c >> 32) : ts_hi; ++nts; } } while (0)
    PG8_STAMP();
    unsigned voffA[2], voffB[2];
#pragma unroll
    for (int i = 0; i < 2; ++i) { int R, C; stage_rc(tid * 16 + i * 8192, R, C); const int Rb = Epi::PERM ? ((R & ~31) + perm32(R & 31)) : R;
        voffA[i] = (unsigned)(R * K + C) * 2u; voffB[i] = (unsigned)(Rb * K + C) * 2u; }
    constexpr bool GA = GatherTrait<Sched>::value;
    unsigned roC00 = 0u, roC01 = 0u, roC10 = 0u, roC11 = 0u, roN00 = 0u, roN01 = 0u, roN10 = 0u, roN11 = 0u;
    const char* const gA = (const char*)g.A;
#define PG8_GIDX1(ui_, h_, i_, dst) do { int R, C; stage_rc(tid * 16 + (i_) * 8192, R, C); dst = (unsigned)gather_row(S, (ui_) * 256 + R + 128 * (h_)) * (unsigned)(K * 2) + (unsigned)(C * 2); } while (0)
#define PG8_GIDX(ui_, P) do { PG8_GIDX1(ui_, 0, 0, P##00); PG8_GIDX1(ui_, 0, 1, P##01); PG8_GIDX1(ui_, 1, 0, P##10); PG8_GIDX1(ui_, 1, 1, P##11); } while (0)
#define PG8_STAGE_A(bufoff, plainp, gp, o0, o1) do { if constexpr (GA) { \
        __builtin_amdgcn_global_load_lds((const unsigned*)((const char*)(gp) + (o0)), (PG8_LAS unsigned*)(lds + (bufoff) + ldsw), 16, 0, 0); \
        __builtin_amdgcn_global_load_lds((const unsigned*)((const char*)(gp) + (o1)), (PG8_LAS unsigned*)(lds + (bufoff) + ldsw + 8192), 16, 0, 0); } else PG8_STAGE(bufoff, plainp, voffA); } while (0)
    const size_t kstep = (size_t)(BK * 2);
    const size_t hstep = (size_t)HALF * K * 2;
    const size_t tstep = 2 * hstep;
    const unsigned ldsw = (unsigned)wid * 1024u;
    const int aoff = lds_byte(wr * 64 + fr, fq * 8), boff = lds_byte(wc * 32 + fr, fq * 8);
#define PG8_SA(b, h) (((b) * 2 + (h)) * HTB)
#define PG8_SB(b, h) ((4 + (b) * 2 + (h)) * HTB)
#define PG8_STAGE(bufoff, gbase, voff) do { _Pragma("unroll") for (int _i = 0; _i < 2; ++_i) \
        __builtin_amdgcn_global_load_lds((const unsigned*)((const char*)(gbase) + (voff)[_i]), (PG8_LAS unsigned*)(lds + (bufoff) + ldsw + _i * 8192), 16, 0, 0); } while (0)
#define PG8_LDA(dst, b, h) do { _Pragma("unroll") for (int m = 0; m < 4; ++m) _Pragma("unroll") for (int k = 0; k < 2; ++k) dst[m][k] = *(const PG8_LAS bf16x8*)(lds + PG8_SA(b, h) + aoff + m * 2048 + k * 1024); } while (0)
#define PG8_LDB(dst, b, h) do { _Pragma("unroll") for (int n = 0; n < 2; ++n) _Pragma("unroll") for (int k = 0; k < 2; ++k) dst[n][k] = *(const PG8_LAS bf16x8*)(lds + PG8_SB(b, h) + boff + n * 2048 + k * 1024); } while (0)
#define PG8_MMA(ai, bj, At, Bt) do { __builtin_amdgcn_s_setprio(1); _Pragma("unroll") for (int m = 0; m < 4; ++m) _Pragma("unroll") for (int n = 0; n < 2; ++n) _Pragma("unroll") for (int k = 0; k < 2; ++k) \
        acc[ai][bj][m][n] = __builtin_amdgcn_mfma_f32_16x16x32_bf16(Bt[n][k], At[m][k], acc[ai][bj][m][n], 0, 0, 0); __builtin_amdgcn_s_setprio(0); } while (0)
#define PG8_WAIT_V(n) asm volatile("s_waitcnt vmcnt(" #n ")" ::: "memory")
#define PG8_WAIT_L(n) asm volatile("s_waitcnt lgkmcnt(" #n ")" ::: "memory")
#define PG8_BAR __builtin_amdgcn_s_barrier()
#define PG8_SCHED __builtin_amdgcn_sched_barrier(0)
    Unit cur, nxt; int ui = 0;
    if (!S.next(0, cur)) return;
    f32x4 acc[2][2][4][2];
#pragma unroll
    for (int a = 0; a < 2; ++a)
#pragma unroll
        for (int b = 0; b < 2; ++b)
#pragma unroll
            for (int m = 0; m < 4; ++m)
#pragma unroll
                for (int n = 0; n < 2; ++n) acc[a][b][m][n] = (f32x4){0.f, 0.f, 0.f, 0.f};
    bf16x8 At[4][2], B0[2][2], B1[2][2];
    const char* cA = (const char*)g.A + (size_t)cur.pm * tstep; const char* cB = (const char*)g.Bt + (size_t)cur.pn * tstep;
    S.a_ready(cur);
    if constexpr (GA) PG8_GIDX(0, roC);
    PG8_STAGE(PG8_SB(0, 0), cB, voffB); PG8_STAGE_A(PG8_SA(0, 0), cA, gA, roC00, roC01); PG8_STAGE(PG8_SB(0, 1), cB + hstep, voffB); PG8_STAGE_A(PG8_SA(0, 1), cA + hstep, gA, roC10, roC11);
    if (wr == 1) PG8_BAR;
    PG8_WAIT_V(4); PG8_BAR;
    PG8_STAGE(PG8_SB(1, 0), cB + kstep, voffB); PG8_STAGE_A(PG8_SA(1, 0), cA + kstep, gA + kstep, roC00, roC01); PG8_STAGE(PG8_SB(1, 1), cB + hstep + kstep, voffB);
    PG8_WAIT_V(6); PG8_BAR;
    PG8_STAMP();
    for (;;) {
        const bool has_next = S.next(ui + 1, nxt);
        const char* nA = has_next ? (const char*)g.A + (size_t)nxt.pm * tstep : cA; const char* nB = has_next ? (const char*)g.Bt + (size_t)nxt.pn * tstep : cB;
        if constexpr (GA) { if (has_next) PG8_GIDX(ui + 1, roN); else { roN00 = roC00; roN01 = roC01; roN10 = roC10; roN11 = roC11; } }
        for (int t = 0; t < nt; t += 2) {
            const bool last = (t == nt - 2);
            const char* g1 = gA + (size_t)(t + 1) * kstep; const char* g2 = last ? gA : gA + (size_t)(t + 2) * kstep; const char* g3 = g2 + kstep;
            const unsigned roS00 = last ? roN00 : roC00, roS01 = last ? roN01 : roC01, roS10 = last ? roN10 : roC10, roS11 = last ? roN11 : roC11;
            const char* a1 = cA + (size_t)(t + 1) * kstep;
            const char* a2 = last ? nA : cA + (size_t)(t + 2) * kstep; const char* b2 = last ? nB : cB + (size_t)(t + 2) * kstep;
            const char* a3 = a2 + kstep; const char* b3 = b2 + kstep;
            if (last && has_next) S.a_ready(nxt);
            PG8_LDB(B0, 0, 0); PG8_SCHED; PG8_LDA(At, 0, 0); PG8_STAGE_A(PG8_SA(1, 1), a1 + hstep, g1, roC10, roC11);
            PG8_WAIT_L(8); PG8_BAR; PG8_WAIT_L(0); PG8_MMA(0, 0, At, B0); PG8_BAR; PG8_SCHED;
            PG8_LDB(B1, 0, 1); PG8_STAGE(PG8_SB(0, 0), b2, voffB);
            PG8_BAR; PG8_WAIT_L(0); PG8_MMA(0, 1, At, B1); PG8_BAR;
            PG8_LDA(At, 0, 1); PG8_STAGE_A(PG8_SA(0, 0), a2, g2, roS00, roS01);
            PG8_BAR; PG8_WAIT_L(0); PG8_MMA(1, 0, At, B0); PG8_BAR; PG8_SCHED;
            PG8_STAGE(PG8_SB(0, 1), b2 + hstep, voffB);
            PG8_WAIT_V(6); PG8_BAR; PG8_MMA(1, 1, At, B1); PG8_BAR;
            PG8_LDB(B0, 1, 0); PG8_SCHED; PG8_LDA(At, 1, 0); PG8_STAGE_A(PG8_SA(0, 1), a2 + hstep, g2, roS10, roS11);
            PG8_WAIT_L(8); PG8_BAR; PG8_WAIT_L(0); PG8_MMA(0, 0, At, B0); PG8_BAR; PG8_SCHED;
            PG8_LDB(B1, 1, 1); PG8_STAGE(PG8_SB(1, 0), b3, voffB);
            PG8_BAR; PG8_WAIT_L(0); PG8_MMA(0, 1, At, B1); PG8_BAR;
            PG8_LDA(At, 1, 1); PG8_STAGE_A(PG8_SA(1, 0), a3, g3, roS00, roS01);
            PG8_BAR; PG8_WAIT_L(0); PG8_MMA(1, 0, At, B0); PG8_BAR; PG8_SCHED;
            PG8_STAGE(PG8_SB(1, 1), b3 + hstep, voffB);
            PG8_WAIT_V(6); PG8_BAR; PG8_MMA(1, 1, At, B1); PG8_BAR;
        }
        PG8_STAMP();
        if constexpr (!Epi::AFTER_DRAIN) { E(acc, cur, wr, wc, fr, fq); S.done(cur); }
        PG8_STAMP();
        if (!has_next) break;
#pragma unroll
        for (int a = 0; a < 2; ++a)
#pragma unroll
            for (int b = 0; b < 2; ++b)
#pragma unroll
                for (int m = 0; m < 4; ++m)
#pragma unroll
                    for (int n = 0; n < 2; ++n) acc[a][b][m][n] = (f32x4){0.f, 0.f, 0.f, 0.f};
        cur = nxt; cA = nA; cB = nB; ++ui;
        if constexpr (GA) { roC00 = roN00; roC01 = roN01; roC10 = roN10; roC11 = roN11; }
    }
    PG8_WAIT_V(0);
    if (wr == 0) PG8_BAR;
    PG8_BAR;
    if constexpr (Epi::AFTER_DRAIN) { E.fused(acc, cur, wr, wc, fr, fq, lds, wid, lane); S.done(cur); }
    PG8_STAMP();
    if (STAMP && wid == 0) { stamps[lane] = lane < nts ? (((unsigned long long)(unsigned)ts_hi << 32) | (unsigned)ts_lo) : 0ull;
        if (lane == 62) stamps[62] = rt_entry; if (lane == 63) stamps[63] = (unsigned long long)wall_clock64(); }
#undef PG8_STAMP
#undef PG8_SA
#undef PG8_SB
#undef PG8_STAGE
#undef PG8_STAGE_A
#undef PG8_GIDX
#undef PG8_GIDX1
#undef PG8_LDA
#undef PG8_LDB
#undef PG8_MMA
#undef PG8_WAIT_V
#undef PG8_WAIT_L
#undef PG8_BAR
#undef PG8_SCHED
}
}
constexpr int DM = 1024, NBATCH = 16, SEQL = 2048, CTXL = 256, DEPTH = 4;
constexpr int MC = NBATCH * CTXL, ML = NBATCH * SEQL, MT = MC + ML;
constexpr int NPROJ = 3840, NGATE = 4096, DIN = 7696;
constexpr int C_AQ = 0, C_AK = 512, C_AV = 640, C_GQ = 768, C_GK = 1280, C_GV = 1408, C_SX = 1536, C_SZ = 2048, C_SB = 2560, C_SC = 2816, C_SU = 3072, C_DT = 3584;
constexpr int KVPOS = CTXL + SEQL;
constexpr int NCHUNK = MT / 128;
constexpr int NSUB = MT / 16;
constexpr int MOE_MAXBLK = 320, MOE_MAXSLOT = MOE_MAXBLK * 256;
constexpr float ALPHA = 1.6817928305074290f;
constexpr float LN_EPS = 1e-6f;
constexpr float LOG2E = 1.4426950408889634f;
constexpr float QSCALE = 0.125f * LOG2E;

enum { I_X = 0, I_C, I_CTX, I_CCTX, I_MODW, I_MODB, I_WIN, I_SINK, I_GQN, I_GKN, I_CONVW, I_CONVB, I_DTB, I_ALOG, I_SSDD, I_SSDNW,
       I_S5ARE, I_S5AIM, I_S5LDT, I_S5BRE, I_S5BIM, I_S5CRE, I_S5CIM, I_S5D, I_S5GLU, I_WBR, I_WOUT, I_LN1G, I_LN1B, I_LN2G, I_LN2B,
       I_RW, I_RB, I_MWG, I_MWU, I_MWD, N_IN };

constexpr size_t MiB = 1u << 20;
constexpr size_t WS_CTL = 0, CTL_ZERO_BYTES = 128 * 1024;
constexpr size_t WS_MOD = 1 * MiB;
constexpr size_t WS_TOKI = 3 * MiB;
constexpr size_t WS_WGBASE = 3 * MiB + 768 * 1024;
constexpr size_t WS_TOKW = 4 * MiB;
constexpr size_t WS_SSQ = 1146 * MiB;
constexpr size_t WS_ADEC = 7 * MiB;
constexpr size_t WS_ROPE = 7 * MiB + 65536;
constexpr size_t WS_W3T = 8 * MiB;
constexpr size_t WS_QT = 16 * MiB;
constexpr size_t WS_A16 = 20 * MiB;
constexpr size_t WS_DT = 21 * MiB;
constexpr size_t WS_WINT = 24 * MiB;
constexpr size_t WS_WGT = 32 * MiB;
constexpr size_t WS_WBT = 40 * MiB;
constexpr size_t WS_WOT = 44 * MiB;
constexpr size_t WS_WGLUT = 46 * MiB;
constexpr size_t WS_XRES = 48 * MiB;
constexpr size_t WS_H = 192 * MiB;
constexpr size_t WS_A = 264 * MiB;
constexpr size_t WS_A_HID = WS_A + 160 * MiB;
constexpr size_t WS_B = 552 * MiB;
constexpr size_t WS_B_MOED = WS_B + 64 * MiB;
constexpr size_t WS_UF = WS_B + 108 * MiB;
constexpr size_t WS_D = 696 * MiB;
constexpr size_t WS_KALL = 840 * MiB;
constexpr size_t WS_VTALL = 858 * MiB;
constexpr size_t WS_XT = 876 * MiB;
constexpr size_t WS_BROW = 912 * MiB;
constexpr size_t WS_BT = 930 * MiB;
constexpr size_t WS_CROW = 948 * MiB;
constexpr size_t WS_QU = 966 * MiB;
constexpr size_t WS_Y5G = 1038 * MiB;
constexpr size_t WS_HB = 1074 * MiB;
constexpr size_t WS_END = 1149 * MiB;
constexpr size_t WS_MOEW1 = WS_D + 72 * MiB;
constexpr size_t WS_MOEW2 = WS_QU + 36 * MiB;
constexpr size_t WS_S2T = 5 * MiB;
constexpr int CW_TICKET = 16384 + 256;
constexpr int CW_BAR = 4096;
constexpr int CW_CNT = 16384;

constexpr int LDS_BYTES = 163840;
constexpr int LDS_MISC = 131072;

#define GAS __attribute__((address_space(1)))

struct Args { const float* in[N_IN]; float* out; unsigned char* ws; int ph_lo, ph_hi; };
#define CAS __attribute__((address_space(4)))
struct Ctx {
    const CAS Args* A;
    LAS unsigned char* lds;
    int tid, lane, wave, G, bid;
};
template <class T> DI T* wsp(const Ctx& c, size_t off) { return (T*)(c.A->ws + off); }
DI void row_load(const float* p, int lane, f32x4 (&v)[4]) {
#pragma unroll
    for (int i = 0; i < 4; ++i) v[i] = *(const f32x4*)(p + lane * 4 + 256 * i);
}
DI void row_load_nt(const float* p, int lane, f32x4 (&v)[4]) {
#pragma unroll
    for (int i = 0; i < 4; ++i) v[i] = __builtin_nontemporal_load((const f32x4*)(p + lane * 4 + 256 * i));
}
DI void row_load_pk(const bf16* p, int lane, u32x2 (&v)[4]) {
#pragma unroll
    for (int i = 0; i < 4; ++i) v[i] = *(const u32x2*)(p + lane * 4 + 256 * i);
}
DI void row_store(float* p, int lane, const f32x4 (&v)[4]) {
#pragma unroll
    for (int i = 0; i < 4; ++i) *(f32x4*)(p + lane * 4 + 256 * i) = v[i];
}
DI void row_store_nt(float* p, int lane, const f32x4 (&v)[4]) {
#pragma unroll
    for (int i = 0; i < 4; ++i) __builtin_nontemporal_store(v[i], (f32x4*)(p + lane * 4 + 256 * i));
}
DI void row_store_bf16(bf16* p, int lane, const f32x4 (&v)[4]) {
#pragma unroll
    for (int i = 0; i < 4; ++i) { u32x2 w; w.x = pk2(v[i][0], v[i][1]); w.y = pk2(v[i][2], v[i][3]); *(u32x2*)(p + lane * 4 + 256 * i) = w; }
}
DI void row_ln(f32x4 (&v)[4]) {
    float s = 0.f;
#pragma unroll
    for (int i = 0; i < 4; ++i) s += (v[i][0] + v[i][1]) + (v[i][2] + v[i][3]);
    const float mu = wave_sum(s) * (1.0f / 1024.0f);
    float q = 0.f;
#pragma unroll
    for (int i = 0; i < 4; ++i) { v[i] -= mu; q += (v[i][0] * v[i][0] + v[i][1] * v[i][1]) + (v[i][2] * v[i][2] + v[i][3] * v[i][3]); }
    const float rs = rsqrtf(wave_sum(q) * (1.0f / 1024.0f) + LN_EPS);
#pragma unroll
    for (int i = 0; i < 4; ++i) v[i] *= rs;
}
DI int row_modidx(int row) { return row < MC ? 16 : (row - MC) >> 11; }
DI void row_modulate(const f32x4 (&x)[4], const float* scale, const float* shift, int lane, f32x4 (&h)[4]) {
#pragma unroll
    for (int i = 0; i < 4; ++i) h[i] = x[i];
    row_ln(h);
#pragma unroll
    for (int i = 0; i < 4; ++i) { const f32x4 sc = *(const f32x4*)(scale + lane * 4 + 256 * i), sh = *(const f32x4*)(shift + lane * 4 + 256 * i); h[i] = h[i] * (sc + 1.0f) + sh; }
}

DI void row_modulate_r(const f32x4 (&x)[4], const f32x4 (&sc)[4], const f32x4 (&sh)[4], f32x4 (&h)[4]) {
#pragma unroll
    for (int i = 0; i < 4; ++i) h[i] = x[i];
    row_ln(h);
#pragma unroll
    for (int i = 0; i < 4; ++i) h[i] = h[i] * (sc[i] + 1.0f) + sh[i];
}

DI void mod_unit(const Ctx& c, int unit) {
    const int l = unit / 48, cb = unit % 48;
    LAS float* cond = (LAS float*)c.lds;
    {   f32x4 cq[9];
#pragma unroll
        for (int q = 0; q < 9; ++q) { const int i4 = c.tid + 512 * q; const int r = i4 >> 8, k4 = (i4 & 255) * 4;
            cq[q] = (f32x4){0.f, 0.f, 0.f, 0.f}; if (i4 < 17 * 256) cq[q] = *(const f32x4*)(r < 16 ? c.A->in[I_C] + r * 1024 + k4 : c.A->in[I_CCTX] + k4); }
#pragma unroll
        for (int q = 0; q < 9; ++q) { const int i4 = c.tid + 512 * q;
            if (i4 < 17 * 256) { f32x4 o; o[0] = siluf_(cq[q][0]); o[1] = siluf_(cq[q][1]); o[2] = siluf_(cq[q][2]); o[3] = siluf_(cq[q][3]); *(LAS f32x4*)(cond + i4 * 4) = o; } } }
    __syncthreads();
    const int c4 = (c.tid & 31) * 4, kq = c.tid >> 5;
    f32x4 acc[17];
#pragma unroll
    for (int r = 0; r < 17; ++r) acc[r] = (f32x4){0.f, 0.f, 0.f, 0.f};
    const float* w = c.A->in[I_MODW] + (size_t)l * 1024 * 6144 + cb * 128 + c4;
    for (int k = kq * 64; k < kq * 64 + 64; k += 4) {
        const f32x4 w0 = __builtin_nontemporal_load((const f32x4*)(w + (size_t)k * 6144)), w1 = __builtin_nontemporal_load((const f32x4*)(w + (size_t)(k + 1) * 6144)),
                    w2 = __builtin_nontemporal_load((const f32x4*)(w + (size_t)(k + 2) * 6144)), w3 = __builtin_nontemporal_load((const f32x4*)(w + (size_t)(k + 3) * 6144));
#pragma unroll
        for (int r = 0; r < 17; ++r) { const f32x4 cv = *(LAS f32x4*)(cond + r * 1024 + k); acc[r] += (w0 * cv[0] + w1 * cv[1]) + (w2 * cv[2] + w3 * cv[3]); } }
#pragma unroll
    for (int r = 0; r < 17; ++r)
#pragma unroll
        for (int j = 0; j < 4; ++j) acc[r][j] += __shfl_xor(acc[r][j], 32);
    __syncthreads();
    LAS float* red = (LAS float*)c.lds;
    if (c.lane < 32) {
#pragma unroll
        for (int r = 0; r < 17; ++r) *(LAS f32x4*)(red + (c.wave * 17 + r) * 128 + c4) = acc[r]; }
    __syncthreads();
    float* MOD = wsp<float>(c, WS_MOD);
    for (int i = c.tid; i < 17 * 128; i += 512) { const int r = i >> 7, cc = i & 127;
        float s_ = 0.f;
#pragma unroll
        for (int wv = 0; wv < 8; ++wv) s_ += red[(wv * 17 + r) * 128 + cc];
        MOD[((size_t)l * 17 + r) * 6144 + cb * 128 + cc] = s_ + c.A->in[I_MODB][l * 6144 + cb * 128 + cc]; }
    __syncthreads();
}

struct WTile { const float* src; int ld; bf16* dst; int K, nd0, k0, sc; };
DI int map_win(int r) { return r < 3072 ? r : (r < 3584 ? r + 16 : (r < 3600 ? r - 512 : -1)); }
DI int map_gate(int R) { const int pn = R >> 8, rt = R & 255; return 3600 + (2 * (rt >> 7) + ((rt >> 2) & 1)) * 1024 + 64 * pn + 16 * ((rt >> 5) & 3) + 4 * ((rt >> 3) & 3) + (rt & 3); }
DI int map_glu(int r) { const int jt = r >> 8, w = r & 255; return w < 128 ? jt * 128 + w : 512 + jt * 128 + (w - 128); }
DI int map_gu(int r) { return (r >> 8) * 128 + (r & 127); }
constexpr int WSMALL_TILES = 960 + 1024 + 512 + 256 + 128;
DI WTile wsmall_desc(const Ctx& c, int layer, int t, int n4) {
    WTile w;
    if (t < 960) { w.src = c.A->in[I_WIN] + (size_t)layer * 1024 * DIN; w.ld = DIN; w.dst = wsp<bf16>(c, WS_WINT); w.K = 1024; w.nd0 = (t >> 4) * 64; w.k0 = (t & 15) * 64; w.sc = map_win(w.nd0 + n4); return w; }
    t -= 960;
    if (t < 1024) { w.src = c.A->in[I_WIN] + (size_t)layer * 1024 * DIN; w.ld = DIN; w.dst = wsp<bf16>(c, WS_WGT); w.K = 1024; w.nd0 = (t >> 4) * 64; w.k0 = (t & 15) * 64; w.sc = map_gate(w.nd0 + n4); return w; }
    t -= 1024;
    if (t < 512) { const int n = t >> 7, tt = t & 127; w.src = c.A->in[I_WBR] + ((size_t)layer * 4 + n) * 512 * 1024; w.ld = 1024; w.dst = wsp<bf16>(c, WS_WBT) + (size_t)n * 1024 * 512; w.K = 512; w.nd0 = (tt >> 3) * 64; w.k0 = (tt & 7) * 64; w.sc = w.nd0 + n4; return w; }
    t -= 512;
    if (t < 256) { w.src = c.A->in[I_WOUT] + (size_t)layer * 1024 * 1024; w.ld = 1024; w.dst = wsp<bf16>(c, WS_WOT); w.K = 1024; w.nd0 = (t >> 4) * 64; w.k0 = (t & 15) * 64; w.sc = w.nd0 + n4; return w; }
    t -= 256;
    w.src = c.A->in[I_S5GLU] + (size_t)layer * 512 * 1024; w.ld = 1024; w.dst = wsp<bf16>(c, WS_WGLUT); w.K = 512; w.nd0 = (t >> 3) * 64; w.k0 = (t & 7) * 64; w.sc = map_glu(w.nd0 + n4); return w;
}
constexpr int WMOE_TILES = 32 * 384;
DI WTile wmoe_desc(const Ctx& c, int layer, int t, int n4) {
    WTile w; const int e = t / 384, tt = t - e * 384;
    if (tt < 256) { w.nd0 = (tt >> 4) * 64; w.k0 = (tt & 15) * 64; w.src = ((w.nd0 & 128) ? c.A->in[I_MWU] : c.A->in[I_MWG]) + ((size_t)layer * 32 + e) * 1024 * 512; w.ld = 512;
        w.dst = wsp<bf16>(c, WS_MOEW1) + (size_t)e * 1024 * 1024; w.K = 1024; w.sc = map_gu(w.nd0 + n4); }
    else { const int u = tt - 256; w.nd0 = (u >> 3) * 64; w.k0 = (u & 7) * 64; w.src = c.A->in[I_MWD] + ((size_t)layer * 32 + e) * 512 * 1024; w.ld = 1024;
        w.dst = wsp<bf16>(c, WS_MOEW2) + (size_t)e * 1024 * 512; w.K = 512; w.sc = w.nd0 + n4; }
    return w;
}
template <int MOE> DI void wconv_load(const Ctx& c, int layer, int t0, int stride, int ntiles, int kk, int n4, f32x4 (&v)[4][2]) {
#pragma unroll
    for (int q = 0; q < 4; ++q) { const int t = t0 + q * stride;
        v[q][0] = (f32x4){0.f, 0.f, 0.f, 0.f}; v[q][1] = v[q][0];
        if (t < ntiles) { const WTile w = MOE ? wmoe_desc(c, layer, t, n4) : wsmall_desc(c, layer, t, n4);
            if (w.sc >= 0) { v[q][0] = __builtin_nontemporal_load((const f32x4*)(w.src + (size_t)(w.k0 + kk) * w.ld + w.sc)); v[q][1] = __builtin_nontemporal_load((const f32x4*)(w.src + (size_t)(w.k0 + kk + 32) * w.ld + w.sc)); } } }
}
template <int MOE> DI void wconv_run(const Ctx& c, int layer, int first, int stride, int ntiles) {
    LAS float* tiles = (LAS float*)c.lds;
    const int kk = c.tid >> 4, n4 = (c.tid & 15) * 4, n = c.tid >> 3, k8 = (c.tid & 7) * 8;
    f32x4 v[4][2];
    if (first < ntiles) wconv_load<MOE>(c, layer, first, stride, ntiles, kk, n4, v);
    for (int t0 = first; t0 < ntiles; t0 += 4 * stride) {
#pragma unroll
        for (int q = 0; q < 4; ++q)
#pragma unroll
            for (int p2 = 0; p2 < 2; ++p2) { LAS float* tp = tiles + q * 4160 + (kk + 32 * p2) * 65 + n4; tp[0] = v[q][p2][0]; tp[1] = v[q][p2][1]; tp[2] = v[q][p2][2]; tp[3] = v[q][p2][3]; }
        __syncthreads();
        if (t0 + 4 * stride < ntiles) wconv_load<MOE>(c, layer, t0 + 4 * stride, stride, ntiles, kk, n4, v);
#pragma unroll
        for (int q = 0; q < 4; ++q) { const int t = t0 + q * stride;
            if (t < ntiles) { const WTile w = MOE ? wmoe_desc(c, layer, t, n4) : wsmall_desc(c, layer, t, n4);
                LAS float* tp = tiles + q * 4160 + k8 * 65 + n;
                u32x4 o; o.x = pk2(tp[0], tp[65]); o.y = pk2(tp[130], tp[195]); o.z = pk2(tp[260], tp[325]); o.w = pk2(tp[390], tp[455]);
                *(u32x4*)(w.dst + (size_t)(w.nd0 + n) * w.K + w.k0 + k8) = o; } }
        __syncthreads();
    }
}

template <int MOE> DI void wconv_dyn(const Ctx& c, int layer, unsigned* cnt, int tbase, int ntiles, int max_trips) {
    LAS float* tiles = (LAS float*)c.lds;
    volatile LAS int* tk = (volatile LAS int*)(c.lds + LDS_MISC + 1600);
    const int kk = c.tid >> 4, n4 = (c.tid & 15) * 4, n = c.tid >> 3, k8 = (c.tid & 7) * 8;
    f32x4 v[4][2];
    if (c.tid == 0) { tk[0] = (int)__hip_atomic_fetch_add(cnt, 1u, __ATOMIC_RELAXED, __HIP_MEMORY_SCOPE_AGENT); tk[1] = max_trips > 1 ? (int)__hip_atomic_fetch_add(cnt, 1u, __ATOMIC_RELAXED, __HIP_MEMORY_SCOPE_AGENT) : (1 << 24); }
    __syncthreads();
    int cur = tbase + tk[0] * 4;
    if (cur < ntiles) wconv_load<MOE>(c, layer, cur, 1, ntiles, kk, n4, v);
    for (int i = 0; cur < ntiles; ++i) {
#pragma unroll
        for (int q = 0; q < 4; ++q)
#pragma unroll
            for (int p2 = 0; p2 < 2; ++p2) { LAS float* tp = tiles + q * 4160 + (kk + 32 * p2) * 65 + n4; tp[0] = v[q][p2][0]; tp[1] = v[q][p2][1]; tp[2] = v[q][p2][2]; tp[3] = v[q][p2][3]; }
        __syncthreads();
        const int nxt = tbase + tk[(i + 1) & 1] * 4;
        if (nxt < ntiles) wconv_load<MOE>(c, layer, nxt, 1, ntiles, kk, n4, v);
        unsigned t2 = 1u << 24; if (c.tid == 0 && i + 2 < max_trips) t2 = __hip_atomic_fetch_add(cnt, 1u, __ATOMIC_RELAXED, __HIP_MEMORY_SCOPE_AGENT);
#pragma unroll
        for (int q = 0; q < 4; ++q) { const int t = cur + q;
            if (t < ntiles) { const WTile w = MOE ? wmoe_desc(c, layer, t, n4) : wsmall_desc(c, layer, t, n4);
                LAS float* tp = tiles + q * 4160 + k8 * 65 + n;
                u32x4 o; o.x = pk2(tp[0], tp[65]); o.y = pk2(tp[130], tp[195]); o.z = pk2(tp[260], tp[325]); o.w = pk2(tp[390], tp[455]);
                *(u32x4*)(w.dst + (size_t)(w.nd0 + n) * w.K + w.k0 + k8) = o; } }
        if (c.tid == 0) tk[i & 1] = (int)t2;
        __syncthreads();
        cur = nxt;
    }
}

DI size_t w3idx(int col, int k) { return ((size_t)((col >> 5) * 32 + (k >> 4)) * 64 + ((k >> 3) & 1) * 32 + (col & 31)) * 8 + (k & 7); }
DI size_t qtidx(int col, int k) { return ((size_t)((col >> 5) * 16 + (k >> 4)) * 64 + ((k >> 3) & 1) * 32 + (col & 31)) * 8 + (k & 7); }
DI void s5mat_unit(const Ctx& c, int layer, int unit) {
    const int g = unit >> 3, part = unit & 7;
    LAS float* pw = (LAS float*)c.lds;
    LAS float* bb = (LAS float*)(c.lds + 17408);
    LAS float* cc = (LAS float*)(c.lds + 33792);
    LAS float* kt = (LAS float*)(c.lds + 41984);
    const int tid = c.tid;
    for (int i = tid; i < 2 * 64 * 17; i += 512) { const int dir = i / 1088, rem = i - dir * 1088, n = rem / 17, tau = rem - n * 17;
        const float are = fminf(c.A->in[I_S5ARE][((layer * 2 + dir) * 32 + g) * 64 + n], -1e-4f), aim = c.A->in[I_S5AIM][((layer * 2 + dir) * 32 + g) * 64 + n];
        const float dt = expf(c.A->in[I_S5LDT][(layer * 2 + dir) * 32 + g]);
        const float mag = expf(are * dt * tau); float sn, cs; sincosf(aim * dt * tau, &sn, &cs);
        pw[i * 2] = mag * cs; pw[i * 2 + 1] = mag * sn; }
    for (int i = tid; i < 1024; i += 512) { const int s = i >> 6, n = i & 63; cc[i * 2] = c.A->in[I_S5CRE][(((size_t)layer * 32 + g) * 16 + s) * 64 + n]; cc[i * 2 + 1] = c.A->in[I_S5CIM][(((size_t)layer * 32 + g) * 16 + s) * 64 + n]; }
    __syncthreads();
    for (int i = tid; i < 2 * 64 * 16; i += 512) { const int dir = i >> 10, n = (i >> 4) & 63, s = i & 15;
        const float are = fminf(c.A->in[I_S5ARE][((layer * 2 + dir) * 32 + g) * 64 + n], -1e-4f), aim = c.A->in[I_S5AIM][((layer * 2 + dir) * 32 + g) * 64 + n];
        const float abr = pw[((dir * 64 + n) * 17 + 1) * 2] - 1.0f, abi = pw[((dir * 64 + n) * 17 + 1) * 2 + 1];
        const float den = are * are + aim * aim;
        const float cr = (abr * are + abi * aim) / den, ci = (abi * are - abr * aim) / den;
        const float br = c.A->in[I_S5BRE][(((size_t)layer * 32 + g) * 64 + n) * 16 + s], bi = c.A->in[I_S5BIM][(((size_t)layer * 32 + g) * 64 + n) * 16 + s];
        bb[i * 2] = cr * br - ci * bi; bb[i * 2 + 1] = cr * bi + ci * br; }
    __syncthreads();
    {   const int dir = tid >> 8, tau = (tid >> 4) & 15, s0 = ((tid >> 2) & 3) * 4, sp0 = (tid & 3) * 4;
        float acc[4][4];
#pragma unroll
        for (int a_ = 0; a_ < 4; ++a_)
#pragma unroll
            for (int b_ = 0; b_ < 4; ++b_) acc[a_][b_] = 0.f;
#pragma unroll 2
        for (int n = 0; n < 64; ++n) {
            const f32x2 pv = *(LAS f32x2*)(pw + ((dir * 64 + n) * 17 + tau) * 2);
            const f32x4 b01 = *(LAS f32x4*)(bb + ((dir * 64 + n) * 16 + sp0) * 2), b23 = *(LAS f32x4*)(bb + ((dir * 64 + n) * 16 + sp0 + 2) * 2);
#pragma unroll
            for (int a_ = 0; a_ < 4; ++a_) { const f32x2 cv = *(LAS f32x2*)(cc + ((s0 + a_) * 64 + n) * 2);
                const float zr = cv.x * pv.x - cv.y * pv.y, zi = cv.x * pv.y + cv.y * pv.x;
                acc[a_][0] += zr * b01[0] - zi * b01[1]; acc[a_][1] += zr * b01[2] - zi * b01[3]; acc[a_][2] += zr * b23[0] - zi * b23[1]; acc[a_][3] += zr * b23[2] - zi * b23[3]; } }
#pragma unroll
        for (int a_ = 0; a_ < 4; ++a_) *(LAS f32x4*)(kt + ((dir * 16 + tau) * 16 + s0 + a_) * 16 + sp0) = (f32x4){acc[a_][0], acc[a_][1], acc[a_][2], acc[a_][3]};
    }
    __syncthreads();
    bf16* W3T = wsp<bf16>(c, WS_W3T) + (size_t)g * 256 * 512;
    bf16* QT = wsp<bf16>(c, WS_QT) + (size_t)g * 256 * 256;
    const float* dsk = c.A->in[I_S5D] + layer * 512 + g * 16;
    for (int q = tid; q < 1024; q += 512) { const int col = part * 32 + (q >> 5), k0 = (q & 31) * 8; const int t = col >> 4, s_ = col & 15, tp = k0 >> 4, sp0 = k0 & 15;
        float v[8];
#pragma unroll
        for (int j = 0; j < 8; ++j) { float x = 0.f;
            if (t >= tp) x += kt[((0 * 16 + (t - tp)) * 16 + s_) * 16 + sp0 + j];
            if (tp >= t) x += kt[((1 * 16 + (tp - t)) * 16 + s_) * 16 + sp0 + j];
            if (col == k0 + j) x += dsk[s_];
            v[j] = x; }
        u32x4 w; w.x = pk2(v[0], v[1]); w.y = pk2(v[2], v[3]); w.z = pk2(v[4], v[5]); w.w = pk2(v[6], v[7]);
        *(u32x4*)(W3T + w3idx(col, k0)) = w; }
    for (int q = tid; q < 1024; q += 512) { const int col = part * 32 + (q >> 5), kk0 = (q & 31) * 8; const int t = col >> 4, s_ = col & 15, dir = kk0 >> 7, ri = (kk0 >> 6) & 1, n0 = kk0 & 63;
        const int e = dir == 0 ? t + 1 : 16 - t;
        float v[8];
#pragma unroll
        for (int j = 0; j < 8; ++j) { const int n = n0 + j;
            const float cr = cc[(s_ * 64 + n) * 2], ci = cc[(s_ * 64 + n) * 2 + 1], pr = pw[((dir * 64 + n) * 17 + e) * 2], pi = pw[((dir * 64 + n) * 17 + e) * 2 + 1];
            const float zr = cr * pr - ci * pi, zi = cr * pi + ci * pr; v[j] = ri == 0 ? zr : -zi; }
        u32x4 w; w.x = pk2(v[0], v[1]); w.y = pk2(v[2], v[3]); w.z = pk2(v[4], v[5]); w.w = pk2(v[6], v[7]);
        *(u32x4*)(W3T + w3idx(col, 256 + kk0)) = w; }
    for (int q = tid; q < 1024; q += 512) { const int col = part * 32 + (q >> 5), k0 = (q & 31) * 8; const int dir = col >> 7, ri = (col >> 6) & 1, n = col & 63, tp = k0 >> 4, sp0 = k0 & 15;
        const int e = dir == 0 ? 15 - tp : tp;
        const float pr = pw[((dir * 64 + n) * 17 + e) * 2], pi = pw[((dir * 64 + n) * 17 + e) * 2 + 1];
        float v[8];
#pragma unroll
        for (int j = 0; j < 8; ++j) { const float br = bb[((dir * 64 + n) * 16 + sp0 + j) * 2], bi = bb[((dir * 64 + n) * 16 + sp0 + j) * 2 + 1]; v[j] = ri == 0 ? pr * br - pi * bi : pr * bi + pi * br; }
        u32x4 w; w.x = pk2(v[0], v[1]); w.y = pk2(v[2], v[3]); w.z = pk2(v[4], v[5]); w.w = pk2(v[6], v[7]);
        *(u32x4*)(QT + qtidx(col, k0)) = w; }
    if (part == 0 && tid < 128) { const int dir = tid >> 6, n = tid & 63; float* A16 = wsp<float>(c, WS_A16);
        A16[((g * 2 + dir) * 64 + n) * 2] = pw[((dir * 64 + n) * 17 + 16) * 2]; A16[((g * 2 + dir) * 64 + n) * 2 + 1] = pw[((dir * 64 + n) * 17 + 16) * 2 + 1]; }
    __syncthreads();
}

DI void row_phase_first(const Ctx& c) {
    const float* MOD = wsp<float>(c, WS_MOD);
    const int stride = c.G * 8; int row = c.bid * 8 + c.wave;
    f32x4 xn[4];
    if (row < MT) row_load(row < MC ? c.A->in[I_CTX] + (size_t)row * 1024 : c.A->in[I_X] + (size_t)(row - MC) * 1024, c.lane, xn);
    for (; row < MT; row += stride) {
        f32x4 x[4], h[4];
#pragma unroll
        for (int i = 0; i < 4; ++i) x[i] = xn[i];
        const int nr = row + stride;
        if (nr < MT) row_load(nr < MC ? c.A->in[I_CTX] + (size_t)nr * 1024 : c.A->in[I_X] + (size_t)(nr - MC) * 1024, c.lane, xn);
        row_store(wsp<float>(c, WS_XRES) + (size_t)row * 1024, c.lane, x);
        const float* md = MOD + ((size_t)0 * 17 + row_modidx(row)) * 6144;
        row_modulate(x, md + 1024, md, c.lane, h);
        row_store_bf16(wsp<bf16>(c, WS_H) + (size_t)row * 1024, c.lane, h);
    }
}

DI void s5mat_dyn(const Ctx& c, int layer, unsigned* cnt) {
    volatile LAS int* tk = (volatile LAS int*)(c.lds + LDS_MISC + 1616);
    if (c.tid == 0) tk[0] = (int)__hip_atomic_fetch_add(cnt, 1u, __ATOMIC_RELAXED, __HIP_MEMORY_SCOPE_AGENT);
    __syncthreads();
    int cur = tk[0];
    __syncthreads();
    while (cur < 256) {
        unsigned t2 = 0; if (c.tid == 0) t2 = __hip_atomic_fetch_add(cnt, 1u, __ATOMIC_RELAXED, __HIP_MEMORY_SCOPE_AGENT);
        s5mat_unit(c, layer, cur);
        if (c.tid == 0) tk[0] = (int)t2;
        __syncthreads();
        cur = tk[0];
        __syncthreads();
    }
}
DI const bf16* headvec_src(const Ctx& c, int pass) {
    const int item = pass * 512 + c.tid; const int row = item / 20, vec = item - row * 20;
    const int col = vec < 8 ? C_AQ + vec * 64 : (vec < 10 ? C_AK + (vec - 8) * 64 : (vec < 18 ? C_GQ + (vec - 10) * 64 : C_GK + (vec - 18) * 64));
    return wsp<bf16>(c, WS_A) + (size_t)row * NPROJ + col;
}
DI void headvec_load(const Ctx& c, int pass, u32x4 (&raw)[8]) {
    const bf16* p = headvec_src(c, pass);
#pragma unroll
    for (int i = 0; i < 8; ++i) raw[i] = *(const u32x4*)(p + 8 * i);
}
DI void headvec_pass(const Ctx& c, int layer, int pass, const u32x4 (&raw)[8]) {
    const int item = pass * 512 + c.tid; const int row = item / 20, vec = item - row * 20;
    const bool isctx = row < MC;
    const int b = isctx ? row >> 8 : (row - MC) >> 11;
    const int t = isctx ? row & 255 : (row - MC) & 2047;
    int col, kvh = 0, type = 0; bool isq, norm; const float* nw = nullptr;
    if (vec < 8) { col = C_AQ + vec * 64; isq = true; norm = false; }
    else if (vec < 10) { col = C_AK + (vec - 8) * 64; isq = false; norm = false; kvh = vec - 8; type = 0; }
    else if (vec < 18) { col = C_GQ + (vec - 10) * 64; isq = true; norm = true; nw = c.A->in[I_GQN] + layer * 64; }
    else { col = C_GK + (vec - 18) * 64; isq = false; norm = true; nw = c.A->in[I_GKN] + layer * 64; kvh = vec - 18; type = 1; }
    bf16* p = wsp<bf16>(c, WS_A) + (size_t)row * NPROJ + col;
    float x[64];
#pragma unroll
    for (int i = 0; i < 8; ++i) { const u32x4 w = raw[i];
        x[8 * i] = bflo(w.x); x[8 * i + 1] = bfhi(w.x); x[8 * i + 2] = bflo(w.y); x[8 * i + 3] = bfhi(w.y); x[8 * i + 4] = bflo(w.z); x[8 * i + 5] = bfhi(w.z); x[8 * i + 6] = bflo(w.w); x[8 * i + 7] = bfhi(w.w); }
    LAS float* ropeL = (LAS float*)(c.lds + LDS_MISC + 2048);
    if (norm) { float ss = 0.f;
#pragma unroll
        for (int d = 0; d < 64; ++d) ss += x[d] * x[d];
        const float rs = rsqrtf(ss * (1.0f / 64.0f) + LN_EPS);
#pragma unroll
        for (int d4 = 0; d4 < 16; ++d4) { const f32x4 w = *(LAS f32x4*)(ropeL + 2048 + (vec >= 18 ? 64 : 0) + 4 * d4); x[4 * d4] *= rs * w[0]; x[4 * d4 + 1] *= rs * w[1]; x[4 * d4 + 2] *= rs * w[2]; x[4 * d4 + 3] *= rs * w[3]; } }
    if (!isctx) { LAS float* tr = ropeL + (t >> 6) * 32; LAS float* tc = ropeL + (t & 63) * 32;
#pragma unroll
        for (int i2 = 0; i2 < 8; ++i2) { const f32x4 a = *(LAS f32x4*)(tr + 4 * i2), bq = *(LAS f32x4*)(tc + 4 * i2);
#pragma unroll
            for (int u = 0; u < 2; ++u) { const int i = 2 * i2 + u; const float cr = a[2 * u], sr = a[2 * u + 1], cc = bq[2 * u], sc = bq[2 * u + 1];
                const float r0 = x[i] * cr - x[i + 16] * sr, r1 = x[i + 16] * cr + x[i] * sr; x[i] = r0; x[i + 16] = r1;
                const float c0 = x[32 + i] * cc - x[48 + i] * sc, c1 = x[48 + i] * cc + x[32 + i] * sc; x[32 + i] = c0; x[48 + i] = c1; } } }
    bf16* dst = p; float sc_ = QSCALE;
    if (!isq) { dst = wsp<bf16>(c, WS_KALL) + ((size_t)((type * 16 + b) * 2 + kvh) * KVPOS + (isctx ? t : CTXL + t)) * 64; sc_ = 1.0f; }
#pragma unroll
    for (int i = 0; i < 8; ++i) { u32x4 w; w.x = pk2(x[8 * i] * sc_, x[8 * i + 1] * sc_); w.y = pk2(x[8 * i + 2] * sc_, x[8 * i + 3] * sc_); w.z = pk2(x[8 * i + 4] * sc_, x[8 * i + 5] * sc_); w.w = pk2(x[8 * i + 6] * sc_, x[8 * i + 7] * sc_);
        *(u32x4*)(dst + 8 * i) = w; }
}
DI void headvec_passes(const Ctx& c, int layer) {
    constexpr int NPASS = (MT * 20) / 512;
    int u = c.bid; if (u >= NPASS) return;
    u32x4 cur[8], nxt[8];
    headvec_load(c, u, cur);
    for (; u < NPASS; u += c.G) {
        const bool more = u + c.G < NPASS;
        if (more) headvec_load(c, u + c.G, nxt);
        headvec_pass(c, layer, u, cur);
        if (more) {
#pragma unroll
            for (int i = 0; i < 8; ++i) cur[i] = nxt[i]; }
    }
}
DI void headvec_tables(const Ctx& c, int layer) {
    LAS float* ropeL = (LAS float*)(c.lds + LDS_MISC + 2048);
    {   const f32x4 rv = *(const f32x4*)(wsp<float>(c, WS_ROPE) + c.tid * 4);
        float qn = 0.f, kn = 0.f; if (c.tid < 64) { qn = c.A->in[I_GQN][layer * 64 + c.tid]; kn = c.A->in[I_GKN][layer * 64 + c.tid]; }
        *(LAS f32x4*)(ropeL + c.tid * 4) = rv;
        if (c.tid < 64) { ropeL[2048 + c.tid] = qn; ropeL[2048 + 64 + c.tid] = kn; } }
    __syncthreads();
}
DI void rope_table(const Ctx& c) {
    for (int i = c.tid; i < 1024; i += 512) { const int v = i >> 4, f = i & 15; const float ang = (float)v * exp2f(-(float)f * (13.287712379549449f / 16.0f)); float sn, cs; sincosf(ang, &sn, &cs);
        wsp<float>(c, WS_ROPE)[i * 2] = cs; wsp<float>(c, WS_ROPE)[i * 2 + 1] = sn; }
}
DI void prep_unit(const Ctx& c, int layer, int unit) {
    const int tok0 = unit * 64;
    const bool isctx = tok0 < MC;
    const int b = isctx ? tok0 >> 8 : (tok0 - MC) >> 11;
    const int t0 = isctx ? tok0 & 255 : (tok0 - MC) & 2047;
    const int L = isctx ? CTXL : SEQL;
    const int kpos0 = isctx ? t0 : CTXL + t0;
    bf16* PROJ = wsp<bf16>(c, WS_A);
    const int tid = c.tid, lane = c.lane, wave = c.wave;
    {
        LAS bf16* vt = (LAS bf16*)c.lds;
        const int tr = tid >> 3, c8 = (tid & 7) * 8;
#pragma unroll
        for (int q = 0; q < 4; ++q) { const int vcol = ((q >> 1) ? C_GV : C_AV) + (q & 1) * 64;
            *(LAS u32x4*)(vt + (q * 64 + tr) * 72 + c8) = *(const u32x4*)(PROJ + (size_t)(tok0 + tr) * NPROJ + vcol + c8); }
        __syncthreads();
#pragma unroll
        for (int q = 0; q < 4; ++q) { const int d = tr, t8 = c8;
            LAS bf16* s = vt + (q * 64 + t8) * 72 + d;
            u32x4 w; w.x = (unsigned)s[0] | ((unsigned)s[72] << 16); w.y = (unsigned)s[144] | ((unsigned)s[216] << 16); w.z = (unsigned)s[288] | ((unsigned)s[360] << 16); w.w = (unsigned)s[432] | ((unsigned)s[504] << 16);
            *(u32x4*)(wsp<bf16>(c, WS_VTALL) + ((size_t)(((q >> 1) * 16 + b) * 2 + (q & 1)) * 64 + d) * KVPOS + kpos0 + t8) = w; }
        __syncthreads();
    }
    {
        LAS bf16* tin = (LAS bf16*)c.lds;
        LAS bf16* tout = (LAS bf16*)(c.lds + 66 * 264 * 2);
        const int cg = tok0 >> 7, s0 = tok0 & 127;
        const float* cw = c.A->in[I_CONVW] + (size_t)layer * 3 * 1024;
        const float* cb_ = c.A->in[I_CONVB] + (size_t)layer * 1024;
#define PREP_LOADBLK(cbi) { const int scol_ = (cbi) == 0 ? C_SX : ((cbi) == 1 ? C_SX + 256 : ((cbi) == 2 ? C_SB : C_SC)); _Pragma("unroll") for (int q = 0; q < 5; ++q) { const int i = tid + 512 * q; const int rr = i >> 5, ch = (i & 31) * 8; const int pos = t0 - 1 + rr; \
            pvv[q] = (u32x4){0u, 0u, 0u, 0u}; if (i < 66 * 32 && pos >= 0 && pos < L) pvv[q] = *(const u32x4*)(PROJ + (size_t)(tok0 - 1 + rr) * NPROJ + scol_ + ch); } }
        u32x4 pvv[5];
        PREP_LOADBLK(0)
#pragma unroll 1
        for (int cb = 0; cb < 4; ++cb) {
#pragma unroll
            for (int q = 0; q < 5; ++q) { const int i = tid + 512 * q; if (i < 66 * 32) *(LAS u32x4*)(tin + (i >> 5) * 264 + (i & 31) * 8) = pvv[q]; }
            const int c2 = tid & 127, tq = tid >> 7; const int ch = cb * 256 + 2 * c2;
            const float w0a = cw[ch], w0b = cw[ch + 1], w1a = cw[1024 + ch], w1b = cw[1024 + ch + 1], w2a = cw[2048 + ch], w2b = cw[2048 + ch + 1], ba = cb_[ch], bbv = cb_[ch + 1];
            __syncthreads();
            if (cb < 3) PREP_LOADBLK(cb + 1)
            {
                unsigned pv = *(LAS unsigned*)(tin + (tq * 16) * 264 + 2 * c2), cv = *(LAS unsigned*)(tin + (tq * 16 + 1) * 264 + 2 * c2);
#pragma unroll 4
                for (int t = 0; t < 16; ++t) { const unsigned nv = *(LAS unsigned*)(tin + (tq * 16 + t + 2) * 264 + 2 * c2);
                    const float ya = w0a * bflo(pv) + w1a * bflo(cv) + w2a * bflo(nv) + ba, yb = w0b * bfhi(pv) + w1b * bfhi(cv) + w2b * bfhi(nv) + bbv;
                    *(LAS unsigned*)(tout + (tq * 16 + t) * 264 + 2 * c2) = pk2(siluf_(ya), siluf_(yb)); pv = cv; cv = nv; } }
            __syncthreads();
            if (cb >= 2) {
                bf16* dst = wsp<bf16>(c, cb == 2 ? WS_BROW : WS_CROW) + (size_t)(cg * 4 + (s0 >> 5)) * 16 * 512;
#pragma unroll
                for (int i = 0; i < 4; ++i) { const int pc = tid + 512 * i; const int t = pc & 63, kq = pc >> 6;
                    *(u32x4*)(dst + ((size_t)((t >> 5) * 16 + (kq >> 1)) * 64 + (kq & 1) * 32 + (t & 31)) * 8) = *(LAS u32x4*)(tout + t * 264 + kq * 8); } }
            if (cb <= 2) {
                bf16* dst = cb == 2 ? wsp<bf16>(c, WS_BT) + (size_t)cg * 8 * 8 * 512 : wsp<bf16>(c, WS_XT) + (size_t)(cg * 16 + cb * 8) * 8 * 512;
#pragma unroll
                for (int i = 0; i < 4; ++i) { const int pc = tid + 512 * i; const int ch = pc & 255, hh = (pc >> 8) & 1, ksl = pc >> 9;
                    LAS bf16* sp = tout + (16 * ksl + 4 * hh) * 264 + ch;
                    u32x4 w; w.x = (unsigned)sp[0] | ((unsigned)sp[264] << 16); w.y = (unsigned)sp[528] | ((unsigned)sp[792] << 16);
                    w.z = (unsigned)sp[8 * 264] | ((unsigned)sp[9 * 264] << 16); w.w = (unsigned)sp[10 * 264] | ((unsigned)sp[11 * 264] << 16);
                    *(u32x4*)(dst + ((size_t)((ch >> 5) * 8 + (s0 >> 4) + ksl) * 64 + hh * 32 + (ch & 31)) * 8) = w; } }
            __syncthreads();
        }
    }
    for (int i = tid; i < 64 * 16; i += 512) { const int tok = i >> 4, k = i & 15;
        const float x = bf2f(PROJ[(size_t)(tok0 + tok) * NPROJ + C_DT + k]) + c.A->in[I_DTB][layer * 16 + k];
        wsp<float>(c, WS_DT)[(size_t)(tok0 + tok) * 16 + k] = fmaxf(x, 0.f) + log1pf(__expf(-fabsf(x))); }
}
struct AttnJob {
    const bf16* q; int q_row0; int qcol;
    const bf16* k; const bf16* vt;
    int ntile, lt_lo;
    int window, qpos0;
    const float* sink;
    bf16* out; int out_col;
};
DI int attn_tile_pos(int i, int lt_lo) { return i < 4 ? 64 * i : CTXL + 64 * (lt_lo + i - 4); }
struct AttnPre { bf16x8 qf[4]; u32x4 k0, v0; float sink; };
DI void attn_preload(const Ctx& c, const AttnJob& J, AttnPre& P) {
    const int tid = c.tid, lane = c.lane, wave = c.wave;
    const int g = wave >> 1, qs = (wave & 1) * 32, r = lane & 31, hh = lane >> 5;
    const int qrow = J.q_row0 + qs + r;
#pragma unroll
    for (int s = 0; s < 4; ++s) P.qf[s] = *(const bf16x8*)(J.q + (size_t)qrow * NPROJ + J.qcol + g * 64 + 16 * s + 8 * hh);
    const int srow = tid >> 3, sch = (tid & 7) * 8; const int p0 = attn_tile_pos(0, J.lt_lo);
    P.k0 = *(const u32x4*)(J.k + (size_t)(p0 + srow) * 64 + sch); P.v0 = *(const u32x4*)(J.vt + (size_t)srow * KVPOS + p0 + sch);
    P.sink = J.sink ? J.sink[g] : 0.f;
}
DI void attn_unit(const Ctx& c, const AttnJob& J, AttnPre& P, const AttnJob& JN, const bool has_next) {
    LAS bf16* Ks = (LAS bf16*)c.lds;
    LAS bf16* Vs = (LAS bf16*)(c.lds + 2 * 64 * 72 * 2);
    const int tid = c.tid, lane = c.lane, wave = c.wave;
    const int g = wave >> 1, qs = (wave & 1) * 32, r = lane & 31, hh = lane >> 5;
    const int qrow = J.q_row0 + qs + r;
    bf16x8 qf[4];
#pragma unroll
    for (int s = 0; s < 4; ++s) qf[s] = P.qf[s];
    float m_run = J.sink ? P.sink * LOG2E : -1e30f;
    float l_run = (J.sink && hh == 0) ? 1.0f : 0.0f;
    f32x16 O0, O1;
#pragma unroll
    for (int i = 0; i < 16; ++i) { O0[i] = 0.f; O1[i] = 0.f; }
    const int srow = tid >> 3, sch = (tid & 7) * 8;
    u32x4 kreg = P.k0, vreg = P.v0;
    *(LAS u32x4*)(Ks + srow * 72 + sch) = kreg; *(LAS u32x4*)(Vs + srow * 72 + sch) = vreg;
    __syncthreads();
    if (has_next) attn_preload(c, JN, P);
#pragma unroll 1
    for (int i = 0; i < J.ntile; ++i) {
        const int cur = i & 1;
        const bool more = (i + 1 < J.ntile);
        if (more) { const int p1 = attn_tile_pos(i + 1, J.lt_lo); kreg = *(const u32x4*)(J.k + (size_t)(p1 + srow) * 64 + sch); vreg = *(const u32x4*)(J.vt + (size_t)srow * KVPOS + p1 + sch); }
        LAS bf16* Kc = Ks + cur * 64 * 72; LAS bf16* Vc = Vs + cur * 64 * 72;
        f32x16 S0, S1;
#pragma unroll
        for (int e = 0; e < 16; ++e) { S0[e] = 0.f; S1[e] = 0.f; }
#pragma unroll
        for (int s = 0; s < 4; ++s) {
            const bf16x8 a0 = *(LAS bf16x8*)(Kc + r * 72 + 16 * s + 8 * hh), a1 = *(LAS bf16x8*)(Kc + (32 + r) * 72 + 16 * s + 8 * hh);
            S0 = MFMA32(a0, qf[s], S0); S1 = MFMA32(a1, qf[s], S1);
        }
        if (J.window && i >= 4) {
            const int kbase = 64 * (J.lt_lo + i - 4) - (J.qpos0 + qs + r);
#pragma unroll
            for (int e = 0; e < 16; ++e) { const int d0 = kbase + crow(e, hh), d1 = d0 + 32;
                if (d0 > 128 || d0 < -128) S0[e] = -1e30f;
                if (d1 > 128 || d1 < -128) S1[e] = -1e30f; }
        }
        float mx = S0[0];
#pragma unroll
        for (int e = 1; e < 16; ++e) mx = fmaxf(mx, S0[e]);
#pragma unroll
        for (int e = 0; e < 16; ++e) mx = fmaxf(mx, S1[e]);
        mx = fmaxf(mx, __shfl_xor(mx, 32));
        if (__builtin_amdgcn_ballot_w64(mx > m_run + 8.0f) != 0ull) {
            const float m_new = fmaxf(m_run, mx);
            const float alpha = __builtin_amdgcn_exp2f(m_run - m_new);
            m_run = m_new; l_run *= alpha;
#pragma unroll
            for (int e = 0; e < 16; ++e) { O0[e] *= alpha; O1[e] *= alpha; }
        }
        {
            const f32x2 mm = {m_run, m_run}; f32x2 ps2 = {0.f, 0.f};
#pragma unroll
            for (int e = 0; e < 8; ++e) {
                f32x2 a = (f32x2){S0[2 * e], S0[2 * e + 1]} - mm, b2 = (f32x2){S1[2 * e], S1[2 * e + 1]} - mm;
                a.x = __builtin_amdgcn_exp2f(a.x); a.y = __builtin_amdgcn_exp2f(a.y); b2.x = __builtin_amdgcn_exp2f(b2.x); b2.y = __builtin_amdgcn_exp2f(b2.y);
                ps2 += a; ps2 += b2;
                S0[2 * e] = a.x; S0[2 * e + 1] = a.y; S1[2 * e] = b2.x; S1[2 * e + 1] = b2.y;
            }
            l_run += ps2.x + ps2.y;
        }
        bf16x8 pf[2][2];
        pf[0][0] = pack8(S0[0], S0[1], S0[2], S0[3], S0[4], S0[5], S0[6], S0[7]); pf[0][1] = pack8(S0[8], S0[9], S0[10], S0[11], S0[12], S0[13], S0[14], S0[15]);
        pf[1][0] = pack8(S1[0], S1[1], S1[2], S1[3], S1[4], S1[5], S1[6], S1[7]); pf[1][1] = pack8(S1[8], S1[9], S1[10], S1[11], S1[12], S1[13], S1[14], S1[15]);
#pragma unroll
        for (int kh = 0; kh < 2; ++kh)
#pragma unroll
            for (int s2 = 0; s2 < 2; ++s2) {
                const int ko = 32 * kh + 16 * s2 + 4 * hh;
                { const u32x2 lo = *(LAS u32x2*)(Vc + r * 72 + ko), hi = *(LAS u32x2*)(Vc + r * 72 + ko + 8); u32x4 w = {lo.x, lo.y, hi.x, hi.y}; O0 = MFMA32(__builtin_bit_cast(bf16x8, w), pf[kh][s2], O0); }
                { const u32x2 lo = *(LAS u32x2*)(Vc + (32 + r) * 72 + ko), hi = *(LAS u32x2*)(Vc + (32 + r) * 72 + ko + 8); u32x4 w = {lo.x, lo.y, hi.x, hi.y}; O1 = MFMA32(__builtin_bit_cast(bf16x8, w), pf[kh][s2], O1); }
            }
        if (more) { *(LAS u32x4*)(Ks + (cur ^ 1) * 64 * 72 + srow * 72 + sch) = kreg; *(LAS u32x4*)(Vs + (cur ^ 1) * 64 * 72 + srow * 72 + sch) = vreg; }
        __syncthreads();
    }
    l_run += __shfl_xor(l_run, 32);
    const float inv = 1.0f / l_run;
    bf16* op = J.out + (size_t)qrow * 512 + J.out_col + g * 64 + 4 * hh;
#pragma unroll
    for (int k4 = 0; k4 < 4; ++k4) {
        u32x2 w0; w0.x = pk2(O0[4 * k4] * inv, O0[4 * k4 + 1] * inv); w0.y = pk2(O0[4 * k4 + 2] * inv, O0[4 * k4 + 3] * inv); *(u32x2*)(op + 8 * k4) = w0;
        u32x2 w1; w1.x = pk2(O1[4 * k4] * inv, O1[4 * k4 + 1] * inv); w1.y = pk2(O1[4 * k4 + 2] * inv, O1[4 * k4 + 3] * inv); *(u32x2*)(op + 32 + 8 * k4) = w1;
    }
}
DI AttnJob attn_job(const Ctx& c, int layer, int jl) {
    int j = jl;
    if (c.G == 256 && jl < 2048) { const int i = (jl >> 8) & 3, w = jl & 255; j = (jl & ~1023) + ((i * 8 + (w & 7)) << 5) + (w >> 3); }
    AttnJob J; J.q = wsp<bf16>(c, WS_A); J.window = 0; J.qpos0 = 0; J.lt_lo = 0; J.sink = nullptr;
    if (j < 1024) { const int b = j >> 6, kvh = (j >> 5) & 1, qb = j & 31;
        J.q_row0 = MC + b * SEQL + 64 * qb; J.qcol = C_GQ + kvh * 256;
        J.k = wsp<bf16>(c, WS_KALL) + (size_t)((16 + b) * 2 + kvh) * KVPOS * 64; J.vt = wsp<bf16>(c, WS_VTALL) + (size_t)((16 + b) * 2 + kvh) * 64 * KVPOS;
        J.ntile = 36; J.out = wsp<bf16>(c, WS_B) + (size_t)2 * MT * 512; J.out_col = kvh * 256; }
    else if (j < 2048) { const int idx = j - 1024; const int b = idx >> 6, kvh = (idx >> 5) & 1, qb = idx & 31;
        J.q_row0 = MC + b * SEQL + 64 * qb; J.qcol = C_AQ + kvh * 256;
        J.k = wsp<bf16>(c, WS_KALL) + (size_t)(b * 2 + kvh) * KVPOS * 64; J.vt = wsp<bf16>(c, WS_VTALL) + (size_t)(b * 2 + kvh) * 64 * KVPOS;
        const int lo = qb - 2 < 0 ? 0 : qb - 2, hi = qb + 3 > 32 ? 32 : qb + 3;
        J.ntile = 4 + hi - lo; J.lt_lo = lo; J.window = 1; J.qpos0 = 64 * qb; J.sink = c.A->in[I_SINK] + layer * 8 + kvh * 4; J.out = wsp<bf16>(c, WS_B); J.out_col = kvh * 256; }
    else { const int idx = j - 2048; const int type = idx >> 7, b = (idx >> 3) & 15, kvh = (idx >> 2) & 1, qb = idx & 3;
        J.q_row0 = b * CTXL + 64 * qb; J.qcol = (type ? C_GQ : C_AQ) + kvh * 256;
        J.k = wsp<bf16>(c, WS_KALL) + (size_t)((type * 16 + b) * 2 + kvh) * KVPOS * 64; J.vt = wsp<bf16>(c, WS_VTALL) + (size_t)((type * 16 + b) * 2 + kvh) * 64 * KVPOS;
        J.ntile = 4; J.sink = type ? nullptr : c.A->in[I_SINK] + layer * 8 + kvh * 4; J.out = wsp<bf16>(c, WS_B) + (size_t)(type ? 2 : 0) * MT * 512; J.out_col = kvh * 256; }
    return J;
}
DI void attn_units(const Ctx& c, int layer) {
    int j = c.bid; if (j >= 2304) return;
    AttnJob J = attn_job(c, layer, j); AttnPre P; attn_preload(c, J, P);
    for (; j < 2304; j += c.G) {
        const bool has_next = j + c.G < 2304;
        AttnJob JN = attn_job(c, layer, has_next ? j + c.G : j);
        attn_unit(c, J, P, JN, has_next);
        J = JN;
    }
}
DI float wave_incl_scan(float v, int lane) {
#pragma unroll
    for (int off = 1; off < 64; off <<= 1) { const float t = __shfl_up(v, off); if (lane >= off) v += t; }
    return v;
}
DI bf16x8 ldg8(const bf16* p) { return *(const bf16x8*)p; }
DI float ssd_cum(const Ctx& c, int layer, int cg, int h, int dir, LAS float* cum, LAS float* dtv) {
    const int lane = c.lane;
    const float a = -__expf(c.A->in[I_ALOG][(layer * 2 + dir) * 8 + h]);
    const float* DT = wsp<float>(c, WS_DT) + (size_t)cg * 128 * 16 + dir * 8 + h;
    const float d0 = DT[(2 * lane) * 16], d1 = DT[(2 * lane + 1) * 16];
    const float da0 = d0 * a, da1 = d1 * a;
    const float incl = wave_incl_scan(da0 + da1, lane);
    const float tot = __shfl(incl, 63);
    float c0, c1;
    if (dir == 0) { c0 = incl - da1; c1 = incl; }
    else { c1 = tot - incl + da1; c0 = c1 + da0; }
    cum[2 * lane] = c0; cum[2 * lane + 1] = c1; dtv[2 * lane] = d0; dtv[2 * lane + 1] = d1;
    return tot;
}
DI void ssd_states_unit(const Ctx& c, int layer, int unit) {
    const int cg = unit >> 1, g = unit & 1;
    const int tid = c.tid, lane = c.lane, wave = c.wave, hh = lane >> 5;
    const int j = wave & 3, dir = wave >> 2, h = 4 * g + j;
    LAS bf16* XTs = (LAS bf16*)c.lds;
    LAS bf16* BTs = (LAS bf16*)(c.lds + 65536);
    LAS float* cum = (LAS float*)(c.lds + 98304) + wave * 256; LAS float* dtv = cum + 128;
    {
        const bf16* xs = wsp<bf16>(c, WS_XT) + (size_t)(cg * 16 + 8 * g) * 8 * 512;
        const bf16* bs = wsp<bf16>(c, WS_BT) + (size_t)(cg * 8 + 4 * g) * 8 * 512;
        u32x4 v[12];
#pragma unroll
        for (int i = 0; i < 8; ++i) v[i] = *(const u32x4*)(xs + (size_t)(tid + 512 * i) * 8);
#pragma unroll
        for (int i = 0; i < 4; ++i) v[8 + i] = *(const u32x4*)(bs + (size_t)(tid + 512 * i) * 8);
        const float tot = ssd_cum(c, layer, cg, h, dir, cum, dtv);
        { const float w0 = dtv[2 * lane] * __expf(tot - cum[2 * lane]), w1 = dtv[2 * lane + 1] * __expf(tot - cum[2 * lane + 1]); cum[2 * lane] = w0; cum[2 * lane + 1] = w1; }
        if (lane == 0) wsp<float>(c, WS_ADEC)[cg * 16 + dir * 8 + h] = tot;
#pragma unroll
        for (int i = 0; i < 8; ++i) *(LAS u32x4*)(XTs + (tid + 512 * i) * 8) = v[i];
#pragma unroll
        for (int i = 0; i < 4; ++i) *(LAS u32x4*)(BTs + (tid + 512 * i) * 8) = v[8 + i];
    }
    __syncthreads();
    f32x16 acc[2][4];
#pragma unroll
    for (int a_ = 0; a_ < 2; ++a_)
#pragma unroll
        for (int b_ = 0; b_ < 4; ++b_)
#pragma unroll
            for (int e = 0; e < 16; ++e) acc[a_][b_][e] = 0.f;
#pragma unroll 2
    for (int ks = 0; ks < 8; ++ks) {
        const f32x4 wa = *(LAS f32x4*)(cum + 16 * ks + 4 * hh), wb = *(LAS f32x4*)(cum + 16 * ks + 8 + 4 * hh);
        bf16x8 af[2];
#pragma unroll
        for (int ph = 0; ph < 2; ++ph) { const u32x4 raw = *(LAS u32x4*)(XTs + (((2 * j + ph) * 8 + ks) * 64 + lane) * 8);
            af[ph] = pack8(bflo(raw.x) * wa[0], bfhi(raw.x) * wa[1], bflo(raw.y) * wa[2], bfhi(raw.y) * wa[3], bflo(raw.z) * wb[0], bfhi(raw.z) * wb[1], bflo(raw.w) * wb[2], bfhi(raw.w) * wb[3]); }
#pragma unroll
        for (int nt = 0; nt < 4; ++nt) { const bf16x8 bfr = *(LAS bf16x8*)(BTs + ((nt * 8 + ks) * 64 + lane) * 8);
            acc[0][nt] = MFMA32(af[0], bfr, acc[0][nt]); acc[1][nt] = MFMA32(af[1], bfr, acc[1][nt]); }
    }
    const int r = lane & 31;
    bf16* SL = wsp<bf16>(c, WS_D) + (size_t)(cg * 16 + dir * 8 + h) * 8192;
#pragma unroll
    for (int ph = 0; ph < 2; ++ph)
#pragma unroll
        for (int nt = 0; nt < 4; ++nt)
#pragma unroll
            for (int e = 0; e < 16; ++e) SL[(32 * ph + crow(e, hh)) * 128 + 32 * nt + r] = f2bf(acc[ph][nt][e]);
    __syncthreads();
}
DI int ssd_chunk_of(int b, int dir, int step) {
    if (dir == 0) return step < 2 ? 2 * b + step : 32 + 16 * b + (step - 2);
    return step < 2 ? 2 * b + (1 - step) : 32 + 16 * b + (15 - (step - 2));
}
DI void ssd_recur_load(const Ctx& c, int it, u32x2 (&loc)[18], float (&dec)[18]) {
    const bf16* SL = wsp<bf16>(c, WS_D); const float* ADEC = wsp<float>(c, WS_ADEC);
    const int e4 = it & 2047, dh = (it >> 11) & 15, b = it >> 15; const int dir = dh >> 3;
#pragma unroll
    for (int s = 0; s < 18; ++s) { const int cg = ssd_chunk_of(b, dir, s); loc[s] = *(const u32x2*)(SL + (size_t)(cg * 16 + dh) * 8192 + e4 * 4); dec[s] = ADEC[cg * 16 + dh]; }
}
DI void ssd_recur(const Ctx& c, int first, int stride) {
    bf16* HB = wsp<bf16>(c, WS_HB);
    constexpr int NIT = 16 * 16 * 2048;
    u32x2 loc[18], locn[18]; float dec[18], decn[18];
    if (first < NIT) ssd_recur_load(c, first, loc, dec);
    for (int it = first; it < NIT; it += stride) {
        const int e4 = it & 2047, dh = (it >> 11) & 15, b = it >> 15; const int dir = dh >> 3;
        const int p = e4 >> 5, n = (e4 & 31) * 4;
        const size_t fo = ((size_t)((p >> 5) * 8 + (n >> 4)) * 64 + ((n >> 3) & 1) * 32 + (p & 31)) * 8 + (n & 7);
        const bool more = it + stride < NIT;
        if (more) ssd_recur_load(c, it + stride, locn, decn);
        f32x4 st = {0.f, 0.f, 0.f, 0.f};
#pragma unroll
        for (int s = 0; s < 18; ++s) { const int cg = ssd_chunk_of(b, dir, s);
            u32x2 w; w.x = pk2(st[0], st[1]); w.y = pk2(st[2], st[3]); *(u32x2*)(HB + (size_t)(cg * 16 + dh) * 8192 + fo) = w;
            st = st * __expf(dec[s]) + (f32x4){bflo(loc[s].x), bfhi(loc[s].x), bflo(loc[s].y), bfhi(loc[s].y)}; }
        if (more) {
#pragma unroll
            for (int s = 0; s < 18; ++s) { loc[s] = locn[s]; dec[s] = decn[s]; } }
    }
}
struct SsdStage { u32x4 v[14]; u32x2 zw[4]; };
DI int ssd_out_unit_of(int slot_linear, int G) {
    if (G != 256) return slot_linear;
    const int k = slot_linear >> 8, w = slot_linear & 255, x = w & 7, j = w >> 3;
    const int sl = k * 32 + j, q = (sl >> 2) * 8 + x;
    return (q >> 1) * 8 + (q & 1) * 4 + (sl & 3);
}
DI void ssd_out_load(const Ctx& c, int slot, SsdStage& S) {
    const int unit = ssd_out_unit_of(slot, c.G);
    const int cg = unit >> 3, h = unit & 7, g = h >> 2;
    const int tid = c.tid, lane = c.lane, wave = c.wave, r = lane & 31, hh = lane >> 5;
    const int lb = wave & 3, ph = wave >> 2, l = 32 * lb + r;
    const bf16* cs = wsp<bf16>(c, WS_CROW) + (size_t)(cg * 64 + g * 8) * 512;
    const bf16* bs = wsp<bf16>(c, WS_BROW) + (size_t)(cg * 64 + g * 8) * 512;
    const bf16* xs = wsp<bf16>(c, WS_XT) + (size_t)(cg * 16 + 2 * h) * 8 * 512;
    const bf16* hs = wsp<bf16>(c, WS_HB) + (size_t)(cg * 16 + h) * 8192;
#pragma unroll
    for (int i = 0; i < 4; ++i) S.v[i] = *(const u32x4*)(cs + (size_t)i * 16 * 512 + (size_t)tid * 8);
#pragma unroll
    for (int i = 0; i < 4; ++i) S.v[4 + i] = *(const u32x4*)(bs + (size_t)i * 16 * 512 + (size_t)tid * 8);
#pragma unroll
    for (int i = 0; i < 2; ++i) S.v[8 + i] = *(const u32x4*)(xs + (size_t)(tid + 512 * i) * 8);
#pragma unroll
    for (int i = 0; i < 4; ++i) S.v[10 + i] = *(const u32x4*)(hs + (size_t)(i >> 1) * 8 * 8192 + (size_t)(tid + 512 * (i & 1)) * 8);
    const size_t tok = (size_t)cg * 128 + l;
#pragma unroll
    for (int k4 = 0; k4 < 4; ++k4) S.zw[k4] = *(const u32x2*)(wsp<bf16>(c, WS_A) + tok * NPROJ + C_SZ + h * 64 + 32 * ph + 8 * k4 + 4 * hh);
}
DI void ssd_out_units(const Ctx& c, int layer, int first, int stride, int nunits) {
    const int tid = c.tid, lane = c.lane, wave = c.wave, r = lane & 31, hh = lane >> 5;
    const int lb = wave & 3, ph = wave >> 2, l = 32 * lb + r;
    LAS bf16* CFs = (LAS bf16*)c.lds;
    LAS bf16* BFs = (LAS bf16*)(c.lds + 32768);
    LAS bf16* XTs = (LAS bf16*)(c.lds + 65536);
    LAS bf16* HBs = (LAS bf16*)(c.lds + 81920);
    LAS float* cumf = (LAS float*)(c.lds + 114688); LAS float* dtf = cumf + 128; LAS float* cumb = cumf + 256; LAS float* dtb = cumf + 384;
    SsdStage S;
    if (first < nunits) ssd_out_load(c, first, S);
    for (int slot = first; slot < nunits; slot += stride) {
        const int unit = ssd_out_unit_of(slot, c.G); const int cg = unit >> 3, h = unit & 7;
        u32x2 zw[4];
#pragma unroll
        for (int k4 = 0; k4 < 4; ++k4) zw[k4] = S.zw[k4];
        if (wave == 0) ssd_cum(c, layer, cg, h, 0, cumf, dtf);
        if (wave == 1) ssd_cum(c, layer, cg, h, 1, cumb, dtb);
#pragma unroll
        for (int i = 0; i < 4; ++i) *(LAS u32x4*)(CFs + (i * 512 + tid) * 8) = S.v[i];
#pragma unroll
        for (int i = 0; i < 4; ++i) *(LAS u32x4*)(BFs + (i * 512 + tid) * 8) = S.v[4 + i];
#pragma unroll
        for (int i = 0; i < 2; ++i) *(LAS u32x4*)(XTs + (i * 512 + tid) * 8) = S.v[8 + i];
#pragma unroll
        for (int i = 0; i < 4; ++i) *(LAS u32x4*)(HBs + (i * 512 + tid) * 8) = S.v[10 + i];
        const float Dh = c.A->in[I_SSDD][layer * 8 + h];
        f32x4 nwq[4];
#pragma unroll
        for (int k4 = 0; k4 < 4; ++k4) nwq[k4] = *(const f32x4*)(c.A->in[I_SSDNW] + layer * 512 + h * 64 + 32 * ph + 8 * k4 + 4 * hh);
        __syncthreads();
        if (slot + stride < nunits) ssd_out_load(c, slot + stride, S);
        const size_t tok = (size_t)cg * 128 + l;
        bf16x8 cf[8];
#pragma unroll
        for (int ks = 0; ks < 8; ++ks) cf[ks] = *(LAS bf16x8*)(CFs + ((lb * 8 + ks) * 64 + lane) * 8);
        f32x16 y;
#pragma unroll
        for (int e = 0; e < 16; ++e) y[e] = 0.f;
#pragma unroll
        for (int dir = 0; dir < 2; ++dir) {
            f32x16 t;
#pragma unroll
            for (int e = 0; e < 16; ++e) t[e] = 0.f;
            {   bf16x8 af[8];
#pragma unroll
                for (int ks = 0; ks < 8; ++ks) af[ks] = *(LAS bf16x8*)(HBs + ((dir * 16 + ph * 8 + ks) * 64 + lane) * 8);
                __builtin_amdgcn_sched_barrier(0);
#pragma unroll
                for (int ks = 0; ks < 8; ++ks) t = MFMA32(af[ks], cf[ks], t); }
            const float ed = __expf(dir == 0 ? cumf[l] : cumb[l]);
#pragma unroll
            for (int e = 0; e < 16; ++e) y[e] += t[e] * ed;
        }
        const float cfl = cumf[l], cbl = cumb[l];
#pragma unroll 1
        for (int sb = 0; sb < 4; ++sb) {
            f32x16 X;
#pragma unroll
            for (int e = 0; e < 16; ++e) X[e] = 0.f;
            {   bf16x8 af[8];
#pragma unroll
                for (int ks = 0; ks < 8; ++ks) af[ks] = *(LAS bf16x8*)(BFs + ((sb * 8 + ks) * 64 + lane) * 8);
                __builtin_amdgcn_sched_barrier(0);
#pragma unroll
                for (int ks = 0; ks < 8; ++ks) X = MFMA32(af[ks], cf[ks], X); }
#pragma unroll
            for (int dir = 0; dir < 2; ++dir) {
                if (dir == 0 ? (sb > lb) : (sb < lb)) continue;
                LAS float* cum = dir == 0 ? cumf : cumb; LAS float* dtv = dir == 0 ? dtf : dtb; const float cl = dir == 0 ? cfl : cbl;
                float mv[16];
#pragma unroll
                for (int q = 0; q < 4; ++q) { const int sq = 32 * sb + 8 * q + 4 * hh; const f32x4 cs = *(LAS f32x4*)(cum + sq), ds = *(LAS f32x4*)(dtv + sq);
#pragma unroll
                    for (int i = 0; i < 4; ++i) { const int s_ = sq + i; const bool valid = dir == 0 ? (s_ <= l) : (s_ >= l);
                        float v = valid ? X[4 * q + i] * ds[i] * __expf(cl - cs[i]) : 0.f;
                        if (dir == 0 && s_ == l) v += Dh;
                        mv[4 * q + i] = v; } }
                const bf16x8 p0 = pack8(mv[0], mv[1], mv[2], mv[3], mv[4], mv[5], mv[6], mv[7]), p1 = pack8(mv[8], mv[9], mv[10], mv[11], mv[12], mv[13], mv[14], mv[15]);
                y = MFMA32(*(LAS bf16x8*)(XTs + ((ph * 8 + 2 * sb) * 64 + lane) * 8), p0, y);
                y = MFMA32(*(LAS bf16x8*)(XTs + ((ph * 8 + 2 * sb + 1) * 64 + lane) * 8), p1, y);
            }
        }
        bf16* YS = wsp<bf16>(c, WS_B) + (size_t)1 * MT * 512 + tok * 512 + h * 64 + 32 * ph;
        float ssq = 0.f;
#pragma unroll
        for (int k4 = 0; k4 < 4; ++k4) { const int p = 8 * k4 + 4 * hh;
            const f32x4 nwv = nwq[k4];
            float o[4];
#pragma unroll
            for (int i = 0; i < 4; ++i) { const float yv = y[4 * k4 + i];
                const float z = i == 0 ? bflo(zw[k4].x) : (i == 1 ? bfhi(zw[k4].x) : (i == 2 ? bflo(zw[k4].y) : bfhi(zw[k4].y)));
                const float gz = yv * siluf_(z); ssq += gz * gz; o[i] = gz * nwv[i]; }
            u32x2 w; w.x = pk2(o[0], o[1]); w.y = pk2(o[2], o[3]); *(u32x2*)(YS + p) = w; }
        ssq += __shfl_xor(ssq, 32);
        if (hh == 0) wsp<float>(c, WS_SSQ)[tok * 16 + h * 2 + ph] = ssq;
        __syncthreads();
    }
}
DI float gelu_tanh(float x) { const float u = 0.7978845608028654f * (x + 0.044715f * x * x * x); const float t = 1.0f - 2.0f * frcp(__expf(2.0f * u) + 1.0f); return 0.5f * x * (1.0f + t); }
template <int PASS> DI void s5_gemm_unit(const Ctx& c, int slot) {
    int unit = slot;
    if (c.G == 256) { const int i = slot >> 8, w = slot & 255, x = w & 7, q = i * 32 + (w >> 3); unit = ((q / 18) * 8 + x) * 18 + q % 18; }
    const int g = unit / 18, rem = unit - g * 18, rb = rem >> 1, ch = rem & 1;
    int tid_ = c.tid; asm volatile("" : "+v"(tid_));
    const int tid = tid_, lane = tid & 63, wave = c.wave, r = lane & 31, hh = lane >> 5;
    const int Rt = rb * 8 + wave;
    constexpr int KSW = PASS == 1 ? 16 : 32;
    constexpr int NW = KSW / 2;
    const bf16* Ua = wsp<bf16>(c, WS_UF) + ((size_t)(g * 72 + Rt) * 16 * 64 + lane) * 8;
    bf16* QU = wsp<bf16>(c, WS_QU);
    const bf16* Sa = QU + ((size_t)(g * 72 + Rt) * 16 * 64 + lane) * 8;
    const bf16* Wt = (PASS == 1 ? wsp<bf16>(c, WS_QT) + (size_t)g * 256 * 256 : wsp<bf16>(c, WS_W3T) + (size_t)g * 256 * 512) + (size_t)(ch * 4) * KSW * 512;
    LAS bf16* Ws = (LAS bf16*)c.lds;
    u32x4 wr[NW]; bf16x8 au[16];
#pragma unroll
    for (int i = 0; i < NW; ++i) wr[i] = *(const u32x4*)(Wt + (size_t)(tid + 512 * i) * 8);
#pragma unroll
    for (int k = 0; k < 16; ++k) au[k] = ldg8(Ua + (size_t)k * 512);
#pragma unroll
    for (int i = 0; i < NW; ++i) *(LAS u32x4*)(Ws + (tid + 512 * i) * 8) = wr[i];
    bf16x8 as_[16];
    if (PASS == 3) {
#pragma unroll
        for (int k = 0; k < 16; ++k) as_[k] = ldg8(Sa + (size_t)k * 512); }
    __syncthreads();
    f32x16 acc[4];
#pragma unroll
    for (int ct = 0; ct < 4; ++ct)
#pragma unroll
        for (int e = 0; e < 16; ++e) acc[ct][e] = 0.f;
    LAS bf16* Wl = Ws + lane * 8;
    constexpr int KTOT = PASS == 3 ? 32 : 16;
    bf16x8 bq[2][4];
#define S5_LDB(buf, kk) { _Pragma("unroll") for (int ct = 0; ct < 4; ++ct) bq[buf][ct] = *(LAS bf16x8*)(Wl + (ct * KSW + (kk)) * 512); }
    S5_LDB(0, 0)
#pragma unroll
    for (int k = 0; k < KTOT; ++k) {
        if (k + 1 < KTOT) S5_LDB((k + 1) & 1, k + 1)
        __builtin_amdgcn_sched_barrier(0);
#pragma unroll
        for (int ct = 0; ct < 4; ++ct) acc[ct] = MFMA32(k < 16 ? au[k & 15] : as_[k & 15], bq[k & 1][ct], acc[ct]);
        __builtin_amdgcn_sched_barrier(0);
    }
#undef S5_LDB
    if (PASS == 3) {
        bf16* Y5G = wsp<bf16>(c, WS_Y5G);
#pragma unroll
        for (int ct = 0; ct < 4; ++ct)
#pragma unroll
            for (int e = 0; e < 16; ++e) { const int Ro = rb * 256 + wave * 32 + crow(e, hh); const int t = 2 * (ch * 4 + ct) + (r >> 4), s_ = r & 15;
                Y5G[((size_t)Ro * 16 + t) * 512 + g * 16 + s_] = f2bf(gelu_tanh(acc[ct][e])); }
    } else {
#pragma unroll
        for (int ct = 0; ct < 4; ++ct)
#pragma unroll
            for (int e = 0; e < 16; ++e) { const int col = 32 * (ch * 4 + ct) + r;
                QU[((size_t)((g * 72 + Rt) * 16 + (col >> 4)) * 64 + ((col >> 3) & 1) * 32 + crow(e, hh)) * 8 + (col & 7)] = f2bf(acc[ct][e]); }
    }
    __syncthreads();
}
DI int s5_row_of(int b, int dir, int step) {
    if (dir == 0) return step < 16 ? 16 * b + step : 256 + 128 * b + (step - 16);
    return step < 16 ? 16 * b + (15 - step) : 256 + 128 * b + (127 - (step - 16));
}
DI size_t s5_qidx(int g, int R, int dir, int n) { return ((size_t)((g * 72 + (R >> 5)) * 16 + dir * 8 + (n >> 4)) * 64 + ((n >> 3) & 1) * 32 + (R & 31)) * 8 + (n & 7); }
DI void s5_scan(const Ctx& c, int gt) {
    const int n = gt & 63, dir = (gt >> 6) & 1, g = (gt >> 7) & 31, b = gt >> 12;
    bf16* QU = wsp<bf16>(c, WS_QU);
    const float* A16 = wsp<float>(c, WS_A16) + ((g * 2 + dir) * 64 + n) * 2;
    const float ar = A16[0], ai = A16[1];
    float sr = 0.f, si = 0.f;
#pragma unroll 1
    for (int s0 = 0; s0 < 144; s0 += 48) {
        float qr[48], qi[48];
#pragma unroll
        for (int k = 0; k < 48; ++k) { const size_t o = s5_qidx(g, s5_row_of(b, dir, s0 + k), dir, n); qr[k] = bf2f(QU[o]); qi[k] = bf2f(QU[o + 2048]); }
#pragma unroll
        for (int k = 0; k < 48; ++k) { const size_t o = s5_qidx(g, s5_row_of(b, dir, s0 + k), dir, n); QU[o] = f2bf(sr); QU[o + 2048] = f2bf(si);
            const float nr = ar * sr - ai * si + qr[k], ni = ar * si + ai * sr + qi[k]; sr = nr; si = ni; }
    }
}
DI void merge_sum(const Ctx& c) {
    const bf16* P = wsp<bf16>(c, WS_A); bf16* H = wsp<bf16>(c, WS_H);
    for (size_t it = (size_t)c.bid * 512 + c.tid; it < (size_t)MT * 128; it += (size_t)c.G * 512) {
        const size_t row = it >> 7; const int d8 = (int)(it & 127) * 8;
        const u32x4 a = *(const u32x4*)(P + row * 4096 + d8), b = *(const u32x4*)(P + row * 4096 + 1024 + d8), cc = *(const u32x4*)(P + row * 4096 + 2048 + d8), d = *(const u32x4*)(P + row * 4096 + 3072 + d8);
        u32x4 w;
        w.x = pk2((bflo(a.x) + bflo(b.x)) + (bflo(cc.x) + bflo(d.x)), (bfhi(a.x) + bfhi(b.x)) + (bfhi(cc.x) + bfhi(d.x)));
        w.y = pk2((bflo(a.y) + bflo(b.y)) + (bflo(cc.y) + bflo(d.y)), (bfhi(a.y) + bfhi(b.y)) + (bfhi(cc.y) + bfhi(d.y)));
        w.z = pk2((bflo(a.z) + bflo(b.z)) + (bflo(cc.z) + bflo(d.z)), (bfhi(a.z) + bfhi(b.z)) + (bfhi(cc.z) + bfhi(d.z)));
        w.w = pk2((bflo(a.w) + bflo(b.w)) + (bflo(cc.w) + bflo(d.w)), (bfhi(a.w) + bfhi(b.w)) + (bfhi(cc.w) + bfhi(d.w)));
        *(u32x4*)(H + row * 1024 + d8) = w;
    }
}
DI void top2_of4(float a, float b, float cc, float d, float& m1, float& m2, int& i1, int& i2) {
    m1 = a; i1 = 0; if (b > m1) { m1 = b; i1 = 1; } if (cc > m1) { m1 = cc; i1 = 2; } if (d > m1) { m1 = d; i1 = 3; }
    m2 = -3.0e38f; i2 = 0;
    if (i1 != 0) { m2 = a; i2 = 0; }
    if (i1 != 1 && b > m2) { m2 = b; i2 = 1; }
    if (i1 != 2 && cc > m2) { m2 = cc; i2 = 2; }
    if (i1 != 3 && d > m2) { m2 = d; i2 = 3; }
}
template <int MODE = 0> DI void row_phase_mid(const Ctx& c, int layer) {
    LAS float* rwT = (LAS float*)c.lds;
    {   f32x4 rv[16];
#pragma unroll
        for (int q = 0; q < 16; ++q) { const int i = c.tid + 512 * q; rv[q] = *(const f32x4*)(c.A->in[I_RW] + (i >> 3) * 32 + (i & 7) * 4); }
#pragma unroll
        for (int q = 0; q < 16; ++q) { const int i = c.tid + 512 * q; const int d = i >> 3, e4 = (i & 7) * 4;
            rwT[(e4 + 0) * 1024 + d] = rv[q][0]; rwT[(e4 + 1) * 1024 + d] = rv[q][1]; rwT[(e4 + 2) * 1024 + d] = rv[q][2]; rwT[(e4 + 3) * 1024 + d] = rv[q][3]; } }
    const float* MOD = wsp<float>(c, WS_MOD); const int lane = c.lane;
    const float* g1 = c.A->in[I_LN1G] + layer * 1024; const float* b1 = c.A->in[I_LN1B] + layer * 1024;
    unsigned* cnt = wsp<unsigned>(c, WS_CTL) + CW_CNT + layer * 32;
    constexpr int RCAP = 20;
    LAS float* scs = (LAS float*)(c.lds + LDS_MISC + 2048) + c.wave * RCAP * 32;
    LAS float* rbs = (LAS float*)(c.lds + LDS_MISC + 2048 + 8 * RCAP * 128);
    LAS unsigned* lcnt = (LAS unsigned*)(rbs + 32);
    LAS float* g1L = (LAS float*)(c.lds + LDS_MISC + 24576); LAS float* b1L = g1L + 1024;
    {   const f32x4 gv = *(const f32x4*)((c.tid < 256 ? g1 : b1) + (c.tid & 255) * 4); *(LAS f32x4*)((c.tid < 256 ? g1L : b1L) + (c.tid & 255) * 4) = gv; }
    if (c.tid < 32) { rbs[c.tid] = c.A->in[I_RB][c.tid]; lcnt[c.tid] = 0u; }
    __syncthreads();
    const int qstride = c.G * 8; constexpr int NPAIR = MT / 2;
    int q = c.bid * 8 + c.wave;
    f32x4 xnA[4], xnB[4], gtn[4], scn[4], shn[4]; u32x2 mnA[4], mnB[4];
    if (q < NPAIR) { const int r0 = 2 * q; const float* md = MOD + ((size_t)layer * 17 + row_modidx(r0)) * 6144;
        row_load_nt(wsp<float>(c, WS_XRES) + (size_t)r0 * 1024, lane, xnA); row_load_nt(wsp<float>(c, WS_XRES) + (size_t)(r0 + 1) * 1024, lane, xnB);
        row_load_pk(wsp<bf16>(c, WS_B) + (size_t)r0 * 1024, lane, mnA); row_load_pk(wsp<bf16>(c, WS_B) + (size_t)(r0 + 1) * 1024, lane, mnB);
        row_load(md + 2048, lane, gtn); row_load(md + 4096, lane, scn); row_load(md + 3072, lane, shn); }
    while (q < NPAIR) {
        const int q_first = q; int nloc = 0;
        for (; q < NPAIR && nloc < RCAP / 2; q += qstride, ++nloc) {
            const int r0 = 2 * q;
            f32x4 xA[4], xB[4], hA[4], hB[4];
#pragma unroll
            for (int i = 0; i < 4; ++i) { const f32x4 mvA = {bflo(mnA[i].x), bfhi(mnA[i].x), bflo(mnA[i].y), bfhi(mnA[i].y)}, mvB = {bflo(mnB[i].x), bfhi(mnB[i].x), bflo(mnB[i].y), bfhi(mnB[i].y)};
                xA[i] = xnA[i] * ALPHA + gtn[i] * mvA; xB[i] = xnB[i] * ALPHA + gtn[i] * mvB; }
            const bool more = q + qstride < NPAIR; const int nr = 2 * (more ? q + qstride : q); const float* mdn_ = MOD + ((size_t)layer * 17 + row_modidx(nr)) * 6144;
            if (more) { row_load_nt(wsp<float>(c, WS_XRES) + (size_t)nr * 1024, lane, xnA); row_load_nt(wsp<float>(c, WS_XRES) + (size_t)(nr + 1) * 1024, lane, xnB);
                row_load_pk(wsp<bf16>(c, WS_B) + (size_t)nr * 1024, lane, mnA); row_load_pk(wsp<bf16>(c, WS_B) + (size_t)(nr + 1) * 1024, lane, mnB); row_load(mdn_ + 2048, lane, gtn); }
            row_ln(xA); row_ln(xB);
#pragma unroll
            for (int i = 0; i < 4; ++i) { const f32x4 gg = *(LAS f32x4*)(g1L + lane * 4 + 256 * i), bb = *(LAS f32x4*)(b1L + lane * 4 + 256 * i); xA[i] = xA[i] * gg + bb; xB[i] = xB[i] * gg + bb; }
            if (!(MODE & 2)) { row_store_nt(wsp<float>(c, WS_XRES) + (size_t)r0 * 1024, lane, xA); row_store_nt(wsp<float>(c, WS_XRES) + (size_t)(r0 + 1) * 1024, lane, xB); }
            row_modulate_r(xA, scn, shn, hA); row_modulate_r(xB, scn, shn, hB);
            if (!(MODE & 2)) { row_store_bf16(wsp<bf16>(c, WS_H) + (size_t)r0 * 1024, lane, hA); row_store_bf16(wsp<bf16>(c, WS_H) + (size_t)(r0 + 1) * 1024, lane, hB); }
#define BFLY(acc, n, m) { const bool up_ = (lane & (m)) != 0; _Pragma("unroll") for (int i = 0; i < (n) / 2; ++i) { const float keep_ = up_ ? acc[i + (n) / 2] : acc[i]; const float send_ = up_ ? acc[i] : acc[i + (n) / 2]; acc[i] = keep_ + __shfl_xor(send_, (m)); } }
#pragma unroll
            for (int hq = 0; hq < 2; ++hq) {
                float accA[16], accB[16];
                f32x4 wq[3][4];
#define RW_LOAD(buf, e_) { _Pragma("unroll") for (int i = 0; i < 4; ++i) wq[buf][i] = *(LAS f32x4*)(rwT + (hq * 16 + (e_)) * 1024 + lane * 4 + 256 * i); }
                if (!(MODE & 1)) { RW_LOAD(0, 0) RW_LOAD(1, 1) }
#pragma unroll
                for (int e = 0; e < 16; ++e) { f32x2 aA = {0.f, 0.f}, aB = {0.f, 0.f};
                    if (MODE & 1) { aA.x = hA[e & 3][e >> 2] * (float)(hq + 1); aB.x = hB[e & 3][e >> 2] * (float)(hq + 1); }
                    else {
                        if (e + 2 < 16) RW_LOAD((e + 2) % 3, e + 2)
                        __builtin_amdgcn_sched_barrier(0);
#pragma unroll
                        for (int i = 0; i < 4; ++i) { const f32x4 w = wq[e % 3][i];
                            aA = (f32x2){hA[i][0], hA[i][1]} * (f32x2){w[0], w[1]} + aA; aA = (f32x2){hA[i][2], hA[i][3]} * (f32x2){w[2], w[3]} + aA;
                            aB = (f32x2){hB[i][0], hB[i][1]} * (f32x2){w[0], w[1]} + aB; aB = (f32x2){hB[i][2], hB[i][3]} * (f32x2){w[2], w[3]} + aB; }
                        __builtin_amdgcn_sched_barrier(0);
                    }
                    accA[e] = aA.x + aA.y; accB[e] = aB.x + aB.y; }
#undef RW_LOAD
                BFLY(accA, 16, 32) BFLY(accA, 8, 16) BFLY(accA, 4, 8) BFLY(accA, 2, 4)
                BFLY(accB, 16, 32) BFLY(accB, 8, 16) BFLY(accB, 4, 8) BFLY(accB, 2, 4)
                accA[0] += __shfl_xor(accA[0], 2); accA[0] += __shfl_xor(accA[0], 1);
                accB[0] += __shfl_xor(accB[0], 2); accB[0] += __shfl_xor(accB[0], 1);
                if (!(lane & 3)) { scs[(2 * nloc) * 32 + hq * 16 + (lane >> 2)] = 1.0f / (1.0f + expf(-accA[0])); scs[(2 * nloc + 1) * 32 + hq * 16 + (lane >> 2)] = 1.0f / (1.0f + expf(-accB[0])); }
            }
#undef BFLY
            if (more) { row_load(mdn_ + 4096, lane, scn); row_load(mdn_ + 3072, lane, shn); }
        }
        __builtin_amdgcn_wave_barrier();
        if (lane < 2 * nloc) {
            const int rw_ = 2 * (q_first + (lane >> 1) * qstride) + (lane & 1);
            float best = -3.0e38f; int be0 = 0, be1 = 0; float bw0 = 0.f, bw1 = 0.f;
#pragma unroll 1
            for (int gI = 0; gI < 8; ++gI) {
                const f32x4 scv = *(LAS f32x4*)(scs + lane * 32 + gI * 4); const f32x4 rbv = *(LAS f32x4*)(rbs + gI * 4);
                float m1, m2; int i1, i2; top2_of4(scv[0] + rbv[0], scv[1] + rbv[1], scv[2] + rbv[2], scv[3] + rbv[3], m1, m2, i1, i2);
                const float gs = m1 + m2;
                if (gs > best) { best = gs; be0 = gI * 4 + i1; be1 = gI * 4 + i2;
                    bw0 = i1 == 0 ? scv[0] : (i1 == 1 ? scv[1] : (i1 == 2 ? scv[2] : scv[3]));
                    bw1 = i2 == 0 ? scv[0] : (i2 == 1 ? scv[1] : (i2 == 2 ? scv[2] : scv[3])); }
            }
            const float ws = bw0 + bw1;
            const unsigned p0 = __hip_atomic_fetch_add(lcnt + be0, 1u, __ATOMIC_RELAXED, __HIP_MEMORY_SCOPE_WORKGROUP), p1 = __hip_atomic_fetch_add(lcnt + be1, 1u, __ATOMIC_RELAXED, __HIP_MEMORY_SCOPE_WORKGROUP);
            int* ti = wsp<int>(c, WS_TOKI) + (size_t)rw_ * 4; ti[0] = be0; ti[1] = be1; ti[2] = (int)p0; ti[3] = (int)p1;
            float* tw = wsp<float>(c, WS_TOKW) + (size_t)rw_ * 2; tw[0] = bw0 / ws; tw[1] = bw1 / ws;
        }
        __builtin_amdgcn_wave_barrier();
    }
    __syncthreads();
    if (c.tid < 32) wsp<int>(c, WS_WGBASE)[c.bid * 32 + c.tid] = (int)atomicAdd(cnt + c.tid, lcnt[c.tid]);
    __syncthreads();
}
DI int moe_tables(const Ctx& c, int layer, LAS int* start, LAS int* blk_e) {
    if (c.wave == 0) { const unsigned* cnt = wsp<unsigned>(c, WS_CTL) + CW_CNT + layer * 32; const int lane = c.lane;
        const int cn = lane < 32 ? (int)__hip_atomic_load(cnt + lane, __ATOMIC_RELAXED, __HIP_MEMORY_SCOPE_AGENT) : 0;
        const int k = (cn + 255) >> 8; int incl = k;
#pragma unroll
        for (int off = 1; off < 32; off <<= 1) { const int t_ = __shfl_up(incl, off); if (lane >= off) incl += t_; }
        const int excl = incl - k;
        if (lane < 32) { start[lane] = excl * 256; for (int q = 0; q < k; ++q) blk_e[excl + q] = lane; }
        if (lane == 31) start[32] = incl; }
    __syncthreads();
    return __builtin_amdgcn_readfirstlane(start[32]);
}
DI void moe_gather(const Ctx& c, int layer) {
    LAS int* start = (LAS int*)(c.lds + LDS_MISC + 64); LAS int* blk_e = start + 64;
    moe_tables(c, layer, start, blk_e);
    const bf16* H = wsp<bf16>(c, WS_H); bf16* XS = wsp<bf16>(c, WS_A);
    const int stride = c.G * 8; int row = c.bid * 8 + c.wave;
    u32x4 an = {0u, 0u, 0u, 0u}, bn = an; int tn0 = 0, tn1 = 0, tn2 = 0, tn3 = 0;
    if (row < MT) { an = *(const u32x4*)(H + (size_t)row * 1024 + c.lane * 8); bn = *(const u32x4*)(H + (size_t)row * 1024 + 512 + c.lane * 8);
        const int* ti = wsp<int>(c, WS_TOKI) + (size_t)row * 4; tn0 = ti[0]; tn1 = ti[1]; tn2 = ti[2]; tn3 = ti[3]; }
    for (; row < MT; row += stride) {
        const u32x4 a = an, b = bn; const int* wgb = wsp<int>(c, WS_WGBASE) + (((row >> 1) % stride) >> 3) * 32;
        const int s0 = start[tn0] + wgb[tn0] + tn2, s1 = start[tn1] + wgb[tn1] + tn3;
        if (row + stride < MT) { const size_t nr = (size_t)(row + stride); an = *(const u32x4*)(H + nr * 1024 + c.lane * 8); bn = *(const u32x4*)(H + nr * 1024 + 512 + c.lane * 8);
            const int* ti = wsp<int>(c, WS_TOKI) + nr * 4; tn0 = ti[0]; tn1 = ti[1]; tn2 = ti[2]; tn3 = ti[3]; }
        *(u32x4*)(XS + (size_t)s0 * 1024 + c.lane * 8) = a; *(u32x4*)(XS + (size_t)s0 * 1024 + 512 + c.lane * 8) = b;
        *(u32x4*)(XS + (size_t)s1 * 1024 + c.lane * 8) = a; *(u32x4*)(XS + (size_t)s1 * 1024 + 512 + c.lane * 8) = b;
        if (c.lane == 0) { int* sl = wsp<int>(c, WS_TOKW + 512 * 1024) + (size_t)row * 2; sl[0] = s0; sl[1] = s1; }
    }
    __syncthreads();
}
DI void moe_slots(const Ctx& c, int layer) {
    LAS int* start = (LAS int*)(c.lds + LDS_MISC + 64); LAS int* blk_e = start + 64;
    moe_tables(c, layer, start, blk_e);
    int* S2T = wsp<int>(c, WS_S2T); const int stride = c.G * 8;
    for (int row = c.tid * c.G + c.bid; row < MT; row += 512 * c.G) {
        const int* ti = wsp<int>(c, WS_TOKI) + (size_t)row * 4; const int e0 = ti[0], e1 = ti[1], p0 = ti[2], p1 = ti[3];
        const int* wgb = wsp<int>(c, WS_WGBASE) + (((row >> 1) % stride) >> 3) * 32;
        const int s0 = start[e0] + wgb[e0] + p0, s1 = start[e1] + wgb[e1] + p1;
        S2T[s0] = row; S2T[s1] = row;
        int* sl = wsp<int>(c, WS_TOKW + 512 * 1024) + (size_t)row * 2; sl[0] = s0; sl[1] = s1;
    }
    __syncthreads();
}
DI void row_phase_last(const Ctx& c, int layer) {
    const float* MOD = wsp<float>(c, WS_MOD); const int lane = c.lane;
    const bf16* YE = wsp<bf16>(c, WS_A);
    const int* SLT = wsp<int>(c, WS_TOKW + 512 * 1024); const float* TWT = wsp<float>(c, WS_TOKW);
    const int stride = c.G * 8; int row = c.bid * 8 + c.wave;
    const int ln = layer < DEPTH - 1 ? layer + 1 : layer;
    f32x4 g2v[4], b2v[4];
    row_load(c.A->in[I_LN2G] + layer * 1024, lane, g2v); row_load(c.A->in[I_LN2B] + layer * 1024, lane, b2v);
    int s0n = 0, s1n = 0; float w0n = 0.f, w1n = 0.f;
    int s0c = 0, s1c = 0; float w0c = 0.f, w1c = 0.f;
    f32x4 xn[4], gtn[4], scn[4], shn[4]; u32x2 an[4], bn[4];
    if (row < MT) { s0c = SLT[(size_t)row * 2]; s1c = SLT[(size_t)row * 2 + 1]; w0c = TWT[(size_t)row * 2]; w1c = TWT[(size_t)row * 2 + 1]; }
    if (row + stride < MT) { const size_t r1 = (size_t)(row + stride); s0n = SLT[r1 * 2]; s1n = SLT[r1 * 2 + 1]; w0n = TWT[r1 * 2]; w1n = TWT[r1 * 2 + 1]; }
    if (row < MT) { row_load_nt(wsp<float>(c, WS_XRES) + (size_t)row * 1024, lane, xn);
        row_load(MOD + ((size_t)layer * 17 + row_modidx(row)) * 6144 + 5120, lane, gtn);
        const float* mdn = MOD + ((size_t)ln * 17 + row_modidx(row)) * 6144; row_load(mdn + 1024, lane, scn); row_load(mdn, lane, shn);
#pragma unroll
        for (int i = 0; i < 4; ++i) { an[i] = *(const u32x2*)(YE + (size_t)s0c * 1024 + lane * 4 + 256 * i); bn[i] = *(const u32x2*)(YE + (size_t)s1c * 1024 + lane * 4 + 256 * i); } }
    for (; row < MT; row += stride) {
        float* xr = wsp<float>(c, WS_XRES) + (size_t)row * 1024;
        const float w0 = w0c, w1 = w1c;
        f32x4 x[4], h[4];
#pragma unroll
        for (int i = 0; i < 4; ++i) { const u32x2 a = an[i], b = bn[i];
            f32x4 f; f[0] = w0 * bflo(a.x) + w1 * bflo(b.x); f[1] = w0 * bfhi(a.x) + w1 * bfhi(b.x); f[2] = w0 * bflo(a.y) + w1 * bflo(b.y); f[3] = w0 * bfhi(a.y) + w1 * bfhi(b.y);
            x[i] = xn[i] * ALPHA + gtn[i] * f; }
        s0c = s0n; s1c = s1n; w0c = w0n; w1c = w1n;
        const bool more = row + stride < MT; const int nr = more ? row + stride : row;
        if (more) { row_load_nt(wsp<float>(c, WS_XRES) + (size_t)nr * 1024, lane, xn);
            row_load(MOD + ((size_t)layer * 17 + row_modidx(nr)) * 6144 + 5120, lane, gtn);
#pragma unroll
            for (int i = 0; i < 4; ++i) { an[i] = *(const u32x2*)(YE + (size_t)s0c * 1024 + lane * 4 + 256 * i); bn[i] = *(const u32x2*)(YE + (size_t)s1c * 1024 + lane * 4 + 256 * i); } }
        if (row + 2 * stride < MT) { const size_t r2 = (size_t)(row + 2 * stride); s0n = SLT[r2 * 2]; s1n = SLT[r2 * 2 + 1]; w0n = TWT[r2 * 2]; w1n = TWT[r2 * 2 + 1]; }
        row_ln(x);
#pragma unroll
        for (int i = 0; i < 4; ++i) x[i] = x[i] * g2v[i] + b2v[i];
        if (layer < DEPTH - 1) {
            row_store_nt(xr, lane, x);
            row_modulate_r(x, scn, shn, h);
            if (more) { const float* mdn = MOD + ((size_t)ln * 17 + row_modidx(nr)) * 6144; row_load(mdn + 1024, lane, scn); row_load(mdn, lane, shn); }
            row_store_bf16(wsp<bf16>(c, WS_H) + (size_t)row * 1024, lane, h);
        } else if (row >= MC) row_store(c.A->out + (size_t)(row - MC) * 1024, lane, x);
    }
}
constexpr int NPH = 14;
constexpr int NGP = 2 + DEPTH * NPH;

#ifndef REP_GEMM
#define REP_GEMM 1
#endif
#ifndef REP_ATTN
#define REP_ATTN 1
#endif
#ifndef REP_SSD
#define REP_SSD 1
#endif
#ifndef REP_S5
#define REP_S5 1
#endif
#ifndef REP_MERGE
#define REP_MERGE 1
#endif
#ifndef REP_MOE
#define REP_MOE 1
#endif
#ifndef REP_S2
#define REP_S2 1
#endif
#ifndef REP_S4
#define REP_S4 1
#endif
#ifndef REP_P1
#define REP_P1 1
#endif
#ifndef REP_P3
#define REP_P3 1
#endif
#ifndef REP_PU
#define REP_PU 1
#endif
#ifndef REP_RC
#define REP_RC 1
#endif
#ifndef REP_P0
#define REP_P0 1
#endif
#ifndef REP_PREP
#define REP_PREP 1
#endif
#ifndef REP_CONV
#define REP_CONV 1
#endif
#ifndef REP_BAR
#define REP_BAR 1
#endif
#ifndef ONLY_PHASE
#define ONLY_PHASE -9
#endif
#ifndef PROBE_MODE
#define PROBE_MODE 0
#endif
#ifndef FILL_P2
#define FILL_P2 2
#endif
#ifndef FILL_P3
#define FILL_P3 4
#endif
#ifndef FILL_P4
#define FILL_P4 3
#endif
#define PH_EN(p) (ONLY_PHASE == -9 || ONLY_PHASE == (p))
#define RUN(gp) (lo <= (gp) && (gp) < hi)
#define FRESH() Ctx c = c0; { int t_ = c0.wave * 64 + (int)__builtin_amdgcn_mbcnt_hi(~0u, __builtin_amdgcn_mbcnt_lo(~0u, 0u)); asm volatile("" : "+v"(t_)); const CAS Args* a_ = c0.A; asm volatile("" : "+s"(a_)); c.A = a_; c.tid = t_; c.lane = t_ & 63; c.wave = __builtin_amdgcn_readfirstlane(t_ >> 6); }
#if MK_SPLIT
struct BarT { int dummy; };
#define GRID_BAR() do { } while (0)
#else
typedef XcdBarrier BarT;
#define GRID_BAR() do { for (int rb_ = 0; rb_ < REP_BAR; ++rb_) xcd_barrier(bar); } while (0)
#endif
#define SEAM(gp) do { if ((gp) + 1 < hi) GRID_BAR(); } while (0)
template <int layer> DI void layer_phases(const Ctx& c0, const int lo, const int hi, const BarT& bar) {
        const int gp0 = 2 + layer * NPH;
        if (PH_EN(0) && RUN(gp0 + 0)) { FRESH();
            pg8::Gemm g{wsp<bf16>(c, WS_H), wsp<bf16>(c, WS_WINT), MT, NPROJ, 1024}; pg8::StaticOrder S; S.init(MT, NPROJ, c.G, c.bid);
            pg8::EpiProj E{wsp<bf16>(c, WS_A), NPROJ, wsp<bf16>(c, WS_UF), C_SU / 256};
            for (int rep_ = 0; rep_ < REP_GEMM * REP_P0; ++rep_) pg8::gemm_phase<pg8::EpiProj, pg8::StaticOrder>(c.lds, g, S, E, nullptr, c.tid);
            __syncthreads();
            s5mat_dyn(c, layer, wsp<unsigned>(c, WS_CTL) + CW_TICKET + layer * 16 + 1);
            wconv_dyn<0>(c, layer, wsp<unsigned>(c, WS_CTL) + CW_TICKET + layer * 16 + 2, 960, WSMALL_TILES, 1 << 30);
            SEAM(gp0 + 0);
        }
        if (PH_EN(1) && RUN(gp0 + 1)) { FRESH();
            headvec_tables(c, layer);
            headvec_passes(c, layer);
            for (int rep_ = 0; rep_ < REP_PREP * REP_PU; ++rep_) for (int u = (c.bid + 3 * c.G / 4) % c.G; u < MT / 64; u += c.G) prep_unit(c, layer, u);
            __syncthreads();
            for (int rep_ = 0; rep_ < REP_S5 * REP_P1; ++rep_) for (int u = c.bid; u < 576; u += c.G) s5_gemm_unit<1>(c, u);
            SEAM(gp0 + 1);
        }
        if (PH_EN(2) && RUN(gp0 + 2)) { FRESH();
            for (int rep_ = 0; rep_ < REP_ATTN; ++rep_) {
            attn_units(c, layer);
            }
            __syncthreads();
            for (int rep_ = 0; rep_ < REP_SSD * REP_S2; ++rep_) for (int u = c.bid; u < 576; u += c.G) ssd_states_unit(c, layer, u);
            if (c.tid < 256) for (int gt = c.bid * 256 + c.tid; gt < 65536; gt += c.G * 256) s5_scan(c, gt);
            if (c.bid >= 576 % c.G) { __syncthreads(); wconv_dyn<1>(c, layer, wsp<unsigned>(c, WS_CTL) + CW_TICKET + layer * 16, 0, WMOE_TILES, FILL_P2); }
            SEAM(gp0 + 2);
        }
        if (PH_EN(3) && RUN(gp0 + 3)) { FRESH();
            for (int rep_ = 0; rep_ < REP_PREP * REP_RC; ++rep_) ssd_recur(c, c.bid * 512 + c.tid, c.G * 512);
            for (int rep_ = 0; rep_ < REP_S5 * REP_P3; ++rep_) for (int u = c.bid; u < 576; u += c.G) s5_gemm_unit<3>(c, u);
            if (c.bid >= 576 % c.G) { __syncthreads(); wconv_dyn<1>(c, layer, wsp<unsigned>(c, WS_CTL) + CW_TICKET + layer * 16, 0, WMOE_TILES, FILL_P3); }
            SEAM(gp0 + 3);
        }
        if (PH_EN(4) && RUN(gp0 + 4)) { FRESH();
            for (int rep_ = 0; rep_ < REP_SSD * REP_S4; ++rep_) ssd_out_units(c, layer, c.bid, c.G, 2304);
            __syncthreads();
            pg8::Gemm g{wsp<bf16>(c, WS_Y5G), wsp<bf16>(c, WS_WGLUT), MT, 1024, 512}; pg8::StaticOrder S; S.init(MT, 1024, c.G, c.bid);
            pg8::EpiPair<1> E{wsp<bf16>(c, WS_B) + (size_t)3 * MT * 512};
            for (int rep_ = 0; rep_ < REP_GEMM; ++rep_) pg8::gemm_phase<pg8::EpiPair<1>, pg8::StaticOrder>(c.lds, g, S, E, nullptr, c.tid);
            if (c.bid >= 576 % c.G) { __syncthreads(); wconv_dyn<1>(c, layer, wsp<unsigned>(c, WS_CTL) + CW_TICKET + layer * 16, 0, WMOE_TILES, FILL_P4); }
            SEAM(gp0 + 4);
        }
        if (PH_EN(5) && RUN(gp0 + 5)) { FRESH();
            pg8::Gemm g{wsp<bf16>(c, WS_B), wsp<bf16>(c, WS_WBT), 4 * MT, 4096, 512}; pg8::MergeOrder S{c.G, c.bid, (MT / 256) * 4, MT / 256};
            pg8::EpiMerge E{wsp<bf16>(c, WS_A), wsp<float>(c, WS_SSQ), MT / 256};
            for (int rep_ = 0; rep_ < REP_GEMM * REP_MERGE; ++rep_) pg8::gemm_phase<pg8::EpiMerge, pg8::MergeOrder>(c.lds, g, S, E, nullptr, c.tid);
            SEAM(gp0 + 5);
        }
        if (PH_EN(6) && RUN(gp0 + 6)) { FRESH();
            pg8::Gemm g{wsp<bf16>(c, WS_H), wsp<bf16>(c, WS_WGT), MT, NGATE, 1024}; pg8::StaticOrder S; S.init(MT, NGATE, c.G, c.bid);
            pg8::EpiGateMerge E{wsp<bf16>(c, WS_A), wsp<bf16>(c, WS_D)};
            for (int rep_ = 0; rep_ < REP_GEMM; ++rep_) pg8::gemm_phase<pg8::EpiGateMerge, pg8::StaticOrder>(c.lds, g, S, E, nullptr, c.tid);
            SEAM(gp0 + 6);
        }
        if (PH_EN(7) && RUN(gp0 + 7)) { }
        if (PH_EN(8) && RUN(gp0 + 8)) { FRESH();
            pg8::Gemm g{wsp<bf16>(c, WS_D), wsp<bf16>(c, WS_WOT), MT, 1024, 1024}; pg8::StaticOrder S; S.init(MT, 1024, c.G, c.bid);
            pg8::EpiStoreBf16<0> E{wsp<bf16>(c, WS_B), 1024, 1 << 30};
            for (int rep_ = 0; rep_ < REP_GEMM; ++rep_) pg8::gemm_phase<pg8::EpiStoreBf16<0>, pg8::StaticOrder>(c.lds, g, S, E, nullptr, c.tid);
            __syncthreads();
            wconv_dyn<1>(c, layer, wsp<unsigned>(c, WS_CTL) + CW_TICKET + layer * 16, 0, WMOE_TILES, 1 << 30);
            SEAM(gp0 + 8);
        }
        if (PH_EN(9) && RUN(gp0 + 9)) { FRESH(); row_phase_mid(c, layer); SEAM(gp0 + 9); }
        if (PH_EN(10) && RUN(gp0 + 10)) { FRESH();
            moe_slots(c, layer);
            SEAM(gp0 + 10);
        }
        if (PH_EN(11) && RUN(gp0 + 11)) { FRESH();
            LAS int* start = (LAS int*)(c.lds + LDS_MISC + 64); LAS int* blk_e = start + 64;
            const int nb = moe_tables(c, layer, start, blk_e);
            LAS int* gidx = (LAS int*)(c.lds + LDS_MISC + 2048);
            pg8::Gemm g{wsp<bf16>(c, WS_H), wsp<bf16>(c, WS_MOEW1), MOE_MAXSLOT, 32 * 1024, 1024}; pg8::MoeGatherOrder S{c.G, c.bid, nb * 4, blk_e, gidx};
            {   const int* S2T = wsp<int>(c, WS_S2T); const int r_ = c.tid & 255;
#define GI_LOAD(i) const int pm##i = S.pm_of(i); const bool ok##i = pm##i >= 0 && c.tid < 256; const int tv##i = S2T[(pm##i < 0 ? 0 : pm##i) * 256 + r_];
#define GI_STORE(i) if (ok##i) gidx[i * 256 + r_] = (unsigned)tv##i < (unsigned)MT ? tv##i : MT - 1;
                GI_LOAD(0) GI_LOAD(1) GI_LOAD(2) GI_LOAD(3) GI_LOAD(4)
                GI_STORE(0) GI_STORE(1) GI_STORE(2) GI_STORE(3) GI_STORE(4)
#undef GI_LOAD
#undef GI_STORE
                for (int i = 5; i < 28 && S.pm_of(i) >= 0; ++i) if (c.tid < 256) { const int t_ = S2T[S.pm_of(i) * 256 + r_]; gidx[i * 256 + r_] = (unsigned)t_ < (unsigned)MT ? t_ : MT - 1; }
                __syncthreads(); }
            pg8::EpiPair<0> E{wsp<bf16>(c, WS_A_HID)};
            for (int rep_ = 0; rep_ < REP_GEMM * REP_MOE; ++rep_) pg8::gemm_phase<pg8::EpiPair<0>, pg8::MoeGatherOrder>(c.lds, g, S, E, nullptr, c.tid);
            SEAM(gp0 + 11);
        }
        if (PH_EN(12) && RUN(gp0 + 12)) { FRESH();
            LAS int* start = (LAS int*)(c.lds + LDS_MISC + 64); LAS int* blk_e = start + 64;
            const int nb = moe_tables(c, layer, start, blk_e);
            pg8::Gemm g{wsp<bf16>(c, WS_A_HID), wsp<bf16>(c, WS_MOEW2), MOE_MAXSLOT, 32 * 1024, 512}; pg8::MoeOrder S{c.G, c.bid, nb * 4, blk_e};
            pg8::EpiStoreBf16<0> E{wsp<bf16>(c, WS_A), 1024, 1024};
            for (int rep_ = 0; rep_ < REP_GEMM * REP_MOE; ++rep_) pg8::gemm_phase<pg8::EpiStoreBf16<0>, pg8::MoeOrder>(c.lds, g, S, E, nullptr, c.tid);
            SEAM(gp0 + 12);
        }
        if (PH_EN(13) && RUN(gp0 + 13)) { FRESH();
            row_phase_last(c, layer);
            if (layer + 1 < DEPTH) {
                __syncthreads();
                wconv_run<0>(c, layer + 1, c.bid, c.G, 960);
            }
            SEAM(gp0 + 13);
        }
    }

__global__ void __launch_bounds__(512, 2) mk_fwd(Args args) {
    extern __shared__ __attribute__((aligned(16))) unsigned char lds_raw[];
    Ctx c0;
    c0.A = (const CAS Args*)__builtin_amdgcn_kernarg_segment_ptr();
    c0.lds = (LAS unsigned char*)lds_raw;
    c0.wave = __builtin_amdgcn_readfirstlane((int)threadIdx.x >> 6); c0.tid = 0; c0.lane = 0; c0.G = gridDim.x; c0.bid = blockIdx.x;
    const int tid0 = threadIdx.x;
    const int lo = args.ph_lo, hi = args.ph_hi;
    volatile LAS unsigned* misc = (volatile LAS unsigned*)(c0.lds + LDS_MISC);
    if (tid0 < 4) misc[tid0] = 0u;
    __syncthreads();
#if MK_SPLIT
    BarT bar; bar.dummy = 0;
#else
    BarT bar = xcd_barrier_post(wsp<unsigned>(c0, WS_CTL) + CW_BAR, misc);
#endif
    if (PH_EN(-2) && RUN(0)) { FRESH();
        if (c.bid == c.G - 1) rope_table(c);
        for (int u = c.bid; u < 192; u += c.G) mod_unit(c, u);
        wconv_run<0>(c, 0, c.bid, c.G, 960);
        SEAM(0);
    }
    if (PH_EN(-1) && RUN(1)) { FRESH(); row_phase_first(c); SEAM(1); }

    layer_phases<0>(c0, lo, hi, bar);
    layer_phases<1>(c0, lo, hi, bar);
    layer_phases<2>(c0, lo, hi, bar);
    layer_phases<3>(c0, lo, hi, bar);
#ifdef TAIL_PROBE
    if (hi == NGP) { GRID_BAR(); FRESH();
        for (int rep_ = 0; rep_ < 4; ++rep_) {
            if (TAIL_PROBE == 1) row_phase_mid<PROBE_MODE>(c, 3);
            if (TAIL_PROBE == 2) row_phase_last(c, 2);
            if (TAIL_PROBE == 3) headvec_passes(c, 3);
            if (TAIL_PROBE == 4) { const int gt = ((c.bid + c.G / 2) % c.G) * 512 + c.tid; if (gt < 65536) s5_scan(c, gt); }
            if (TAIL_PROBE == 5) { for (int u = c.bid; u < 192; u += c.G) mod_unit(c, u); for (int u = c.bid; u < 256; u += c.G) s5mat_unit(c, 0, u); wconv_run<0>(c, 0, c.bid, c.G, WSMALL_TILES); }
            if (TAIL_PROBE == 51) for (int u = c.bid; u < 192; u += c.G) mod_unit(c, u);
            if (TAIL_PROBE == 52) for (int u = c.bid; u < 256; u += c.G) s5mat_unit(c, 0, u);
            if (TAIL_PROBE == 53) wconv_run<0>(c, 0, c.bid, c.G, WSMALL_TILES);
            if (TAIL_PROBE == 6) row_phase_first(c);
            GRID_BAR();
        }
    }
#endif
#undef RUN
#undef SEAM
#undef GRID_BAR
}

extern "C" void kernel_launch(void* const* d_in, const int* in_sizes, int n_in, void* d_out, int out_size, void* d_ws, size_t ws_size, hipStream_t stream) {
    static int grid = 0;
    if (grid == 0) {
        if (n_in != N_IN || out_size != ML * DM || ws_size < WS_END) { fprintf(stderr, "kernel_launch: unexpected problem (n_in %d, out %d, ws %zu < %zu)\n", n_in, out_size, ws_size, (size_t)WS_END); grid = -1; return; }
        int dev = 0, cus = 0, per_cu = 0;
        if (hipGetDevice(&dev) != hipSuccess || hipDeviceGetAttribute(&cus, hipDeviceAttributeMultiprocessorCount, dev) != hipSuccess) { grid = -1; return; }
        if (hipFuncSetAttribute((const void*)mk_fwd, hipFuncAttributeMaxDynamicSharedMemorySize, LDS_BYTES) != hipSuccess) { fprintf(stderr, "kernel_launch: hipFuncSetAttribute failed\n"); grid = -1; return; }
        if (hipOccupancyMaxActiveBlocksPerMultiprocessor(&per_cu, (const void*)mk_fwd, 512, LDS_BYTES) != hipSuccess || per_cu < 1) { fprintf(stderr, "kernel_launch: occupancy query says %d\n", per_cu); }
        (void)hipGetLastError();
        grid = cus;
    }
    if (grid < 0) return;
    (void)hipMemsetAsync((char*)d_ws + WS_CTL, 0, CTL_ZERO_BYTES, stream);
    Args a{};
    for (int i = 0; i < N_IN; ++i) a.in[i] = (const float*)d_in[i];
    a.out = (float*)d_out; a.ws = (unsigned char*)d_ws;
#if MK_SPLIT
    for (int gp = 0; gp < NGP; ++gp) { a.ph_lo = gp; a.ph_hi = gp + 1; hipLaunchKernelGGL(mk_fwd, dim3(grid), dim3(512), LDS_BYTES, stream, a); }
#else
    a.ph_lo = 0; a.ph_hi = NGP; hipLaunchKernelGGL(mk_fwd, dim3(grid), dim3(512), LDS_BYTES, stream, a);
#endif
}
```
